# Optimizing an MI355X kernel written in HIP

```python
import jax, jax.numpy as jnp
from jax import lax
import numpy as np

D_MODEL = 1024
BATCH = 16
SEQ = 4096
DEPTH = 4

N_EVEN = (DEPTH + 1) // 2
N_ODD = DEPTH // 2
EPS = 1e-6
OUT_SCALE = 0.5
CONV_DIM = D_MODEL // 2
CONV_WIDTH = 31
HGRN_DIM = D_MODEL // 2
HGRN_HEAD_DIM = 128
HGRN_HEADS = HGRN_DIM // HGRN_HEAD_DIM
HGRN_CHUNK = 64
SGU_DIM = D_MODEL // 2
SGU_GROUPS = 4
SGU_CHUNK = 128
ATTN_HEAD_DIM = 64
DIL_CONFIGS = ((128, 1), (512, 4), (2048, 16))
ATTN_HEADS_PER_CFG = 4
ATTN_HEADS = ATTN_HEADS_PER_CFG * len(DIL_CONFIGS)
ATTN_DIM = ATTN_HEADS * ATTN_HEAD_DIM
ATTN_BLOCK = 128
ROPE_THETA = 500000.0
ROT_DIM = ATTN_HEAD_DIM // 4
MEM_LEN = 256
XATTN_HEADS = 4
XATTN_HEAD_DIM = D_MODEL // XATTN_HEADS
D_FF = 4 * D_MODEL
EVEN_IN = 2 * CONV_DIM + 4 * HGRN_DIM
EVEN_MIX = CONV_DIM + HGRN_DIM
ODD_IN = 2 * SGU_DIM + 3 * ATTN_DIM
ODD_MIX = SGU_DIM + ATTN_DIM

kernel_name = "hybrid_conv_hgrn2_sgu_dilated_trunk"


def rmsnorm(x, g):
    x32 = x.astype(jnp.float32)
    y = x32 * lax.rsqrt(jnp.mean(x32 * x32, axis=-1, keepdims=True) + EPS)
    return (y * g.astype(jnp.float32)).astype(x.dtype)


def layernorm(x, g, b):
    x32 = x.astype(jnp.float32)
    mu = jnp.mean(x32, axis=-1, keepdims=True)
    xc = x32 - mu
    y = xc * lax.rsqrt(jnp.mean(xc * xc, axis=-1, keepdims=True) + EPS)
    return (y * g.astype(jnp.float32) + b.astype(jnp.float32)).astype(x.dtype)


def apply_partial_rope(x):
    T = x.shape[1]
    half = ROT_DIM // 2
    inv_freq = jnp.power(ROPE_THETA, -jnp.arange(half, dtype=jnp.float32) / half)
    ang = jnp.arange(T, dtype=jnp.float32)[:, None] * inv_freq[None, :]
    cos = jnp.cos(ang)[None, :, None, :]
    sin = jnp.sin(ang)[None, :, None, :]
    xr = x[..., :ROT_DIM].astype(jnp.float32)
    x1, x2 = xr[..., :half], xr[..., half:]
    rot = jnp.concatenate([x1 * cos - x2 * sin, x2 * cos + x1 * sin], axis=-1).astype(x.dtype)
    return jnp.concatenate([rot, x[..., ROT_DIM:]], axis=-1)


def conformer_conv(a_in, dw_w, dw_b, ln_g, ln_b):
    a, gate = jnp.split(a_in, 2, axis=-1)
    h = a * jax.nn.sigmoid(gate)
    h = lax.conv_general_dilated(h, dw_w[:, None, :], window_strides=(1,),
                                 padding=[(CONV_WIDTH - 1, 0)],
                                 dimension_numbers=('NWC', 'WIO', 'NWC'),
                                 feature_group_count=CONV_DIM) + dw_b
    h = layernorm(h, ln_g, ln_b)
    return jax.nn.silu(h)


def hgrn2(q, f_pre, i, g, lb, onorm_g):
    B, T, _ = q.shape
    H, K, C = HGRN_HEADS, HGRN_HEAD_DIM, HGRN_CHUNK
    n = T // C
    f = lb + (1.0 - lb) * jax.nn.sigmoid(f_pre.astype(jnp.float32))
    logf = jnp.log(f)
    k = 1.0 - f

    def chunks(a):
        return a.astype(jnp.float32).reshape(B, n, C, H, K).transpose(1, 0, 3, 2, 4)

    causal = jnp.tril(jnp.ones((C, C), dtype=bool))

    def step(S, inp):
        qc, kc, vc, gc = inp
        b = jnp.cumsum(gc, axis=2)
        o_inter = jnp.einsum('bhck,bhkv->bhcv', qc * jnp.exp(b), S)
        diff = b[:, :, :, None, :] - b[:, :, None, :, :]
        decay = jnp.exp(jnp.where(causal[:, :, None], diff, -jnp.inf))
        scores = jnp.einsum('bhtk,bhsk,bhtsk->bhts', qc, kc, decay)
        o_intra = jnp.einsum('bhts,bhsv->bhtv', scores, vc)
        b_last = b[:, :, -1:, :]
        S = jnp.exp(b_last[:, :, 0, :])[..., None] * S + jnp.einsum(
            'bhsk,bhsv->bhkv', kc * jnp.exp(b_last - b), vc)
        return S, o_inter + o_intra

    S0 = jnp.zeros((B, H, K, K), jnp.float32)
    _, o = lax.scan(step, S0, (chunks(q), chunks(k), chunks(i), chunks(logf)))
    o = o.transpose(1, 0, 3, 2, 4).reshape(B, T, H, K)
    o = rmsnorm(o, onorm_g).reshape(B, T, H * K)
    o = o * jax.nn.silu(g.astype(jnp.float32))
    return o.astype(q.dtype)


def chunked_sgu(z, ln_g, ln_b, w_s, b_s):
    z = jax.nn.gelu(z, approximate=False)
    u, v = jnp.split(z, 2, axis=-1)
    v = layernorm(v, ln_g, ln_b)
    B, T, _ = v.shape
    n = T // SGU_CHUNK
    dg = SGU_DIM // SGU_GROUPS
    vb = v.reshape(B, n, SGU_CHUNK, SGU_GROUPS, dg)
    mask = jnp.tril(jnp.ones((SGU_CHUNK, SGU_CHUNK), dtype=bool))
    w = jnp.where(mask[None], w_s, jnp.zeros_like(w_s))
    mixed = jnp.einsum('gts,bnsgc->bntgc', w, vb) + b_s.T[None, None, :, :, None]
    return u * mixed.reshape(B, T, SGU_DIM)


def dilated_window_attention(q, k, v, window, dilation):
    B, T, H, E = q.shape
    L = T // dilation
    span = window // dilation
    Lp = -(-L // ATTN_BLOCK) * ATTN_BLOCK
    nb = Lp // ATTN_BLOCK

    def to_blocks(a):
        a = a.reshape(B, L, dilation, H, E).transpose(0, 2, 3, 1, 4)
        a = jnp.pad(a, ((0, 0), (0, 0), (0, 0), (0, Lp - L), (0, 0)))
        return a.reshape(B, dilation, H, nb, ATTN_BLOCK, E)

    def with_prev(a):
        prev = jnp.pad(a, ((0, 0), (0, 0), (0, 0), (1, 0), (0, 0), (0, 0)))[:, :, :, :-1]
        return jnp.concatenate([prev, a], axis=4)

    qb = to_blocks(q)
    kc = with_prev(to_blocks(k))
    vc = with_prev(to_blocks(v))
    s = jnp.einsum('bdhnqe,bdhnke->bdhnqk', qb, kc,
                   preferred_element_type=jnp.float32) * (E ** -0.5)
    qi = jnp.arange(ATTN_BLOCK)[:, None]
    kj = jnp.arange(2 * ATTN_BLOCK)[None, :] - ATTN_BLOCK
    dist = qi - kj
    blk = jnp.arange(nb)[:, None, None]
    valid = (dist >= 0) & (dist <= span) & (blk * ATTN_BLOCK + kj >= 0)
    s = jnp.where(valid, s, -jnp.inf)
    m = jnp.max(s, axis=-1, keepdims=True)
    p = jnp.exp(s - m)
    denom = jnp.sum(p, axis=-1, keepdims=True)
    o = jnp.einsum('bdhnqk,bdhnke->bdhnqe', (p / denom).astype(v.dtype), vc)
    lse = (m + jnp.log(denom))[..., 0]
    o = o.reshape(B, dilation, H, Lp, E)[:, :, :, :L].transpose(0, 3, 1, 2, 4).reshape(B, T, H, E)
    lse = lse.reshape(B, dilation, H, Lp)[..., :L].transpose(0, 3, 1, 2).reshape(B, T, H)
    return o, lse


def even_mixer(h, w_in, dw_w, dw_b, ln_g, ln_b, lb, onorm_g, w_out):
    p = h @ w_in
    c0 = 2 * CONV_DIM
    a_in, q, f_pre, i, g = jnp.split(
        p, [c0, c0 + HGRN_DIM, c0 + 2 * HGRN_DIM, c0 + 3 * HGRN_DIM], axis=-1)
    a_out = conformer_conv(a_in, dw_w, dw_b, ln_g, ln_b)
    b_out = hgrn2(q, f_pre, i, g, lb, onorm_g)
    return jnp.concatenate([a_out, b_out], axis=-1) @ w_out


def odd_mixer(h, w_in, sgu_ln_g, sgu_ln_b, sgu_w, sgu_b, qn_g, kn_g, w_out):
    B, T, _ = h.shape
    p = h @ w_in
    c0 = 2 * SGU_DIM
    z, q, k, v = jnp.split(p, [c0, c0 + ATTN_DIM, c0 + 2 * ATTN_DIM], axis=-1)
    c_out = chunked_sgu(z, sgu_ln_g, sgu_ln_b, sgu_w, sgu_b)
    q = apply_partial_rope(rmsnorm(q.reshape(B, T, ATTN_HEADS, ATTN_HEAD_DIM), qn_g))
    k = apply_partial_rope(rmsnorm(k.reshape(B, T, ATTN_HEADS, ATTN_HEAD_DIM), kn_g))
    v = v.reshape(B, T, ATTN_HEADS, ATTN_HEAD_DIM)
    outs, lses = [], []
    for gi, (window, dilation) in enumerate(DIL_CONFIGS):
        sl = slice(gi * ATTN_HEADS_PER_CFG, (gi + 1) * ATTN_HEADS_PER_CFG)
        o, lse = dilated_window_attention(q[:, :, sl], k[:, :, sl], v[:, :, sl], window, dilation)
        outs.append(o)
        lses.append(lse)
    alpha = jax.nn.softmax(jnp.stack(lses, axis=0), axis=0)
    d_out = jnp.concatenate(
        [o * alpha[gi][..., None].astype(o.dtype) for gi, o in enumerate(outs)], axis=2)
    d_out = d_out.reshape(B, T, ATTN_DIM)
    return jnp.concatenate([c_out, d_out], axis=-1) @ w_out


def memory_cross_attention(h, mem_h, wq, wkv, qn_g, kn_g, wo):
    B, T, _ = h.shape
    M = mem_h.shape[1]
    q = rmsnorm((h @ wq).reshape(B, T, XATTN_HEADS, XATTN_HEAD_DIM), qn_g)
    k, v = jnp.split(mem_h @ wkv, 2, axis=-1)
    k = rmsnorm(k.reshape(B, M, XATTN_HEADS, XATTN_HEAD_DIM), kn_g)
    v = v.reshape(B, M, XATTN_HEADS, XATTN_HEAD_DIM)
    s = jnp.einsum('bthe,bmhe->bhtm', q, k,
                   preferred_element_type=jnp.float32) * (XATTN_HEAD_DIM ** -0.5)
    pr = jax.nn.softmax(s, axis=-1).astype(v.dtype)
    o = jnp.einsum('bhtm,bmhe->bthe', pr, v).reshape(B, T, XATTN_HEADS * XATTN_HEAD_DIM)
    return o @ wo


def squared_relu_mlp(h, w1, w2):
    return jnp.square(jax.nn.relu(h @ w1)) @ w2


def setup_inputs(seed: int = 0) -> dict:
    key = jax.random.key(seed)
    kit = iter(list(jax.random.split(key, 32)))

    def nrm(shape, scale):
        return scale * jax.random.normal(next(kit), shape, jnp.float32)

    def gain(shape):
        return 1.0 + nrm(shape, 0.02)

    return {
        'x': nrm((BATCH, SEQ, D_MODEL), 1.0),
        'mem': nrm((BATCH, MEM_LEN, D_MODEL), 1.0),
        'norm_mix_g': gain((DEPTH, D_MODEL)),
        'ev_w_in': nrm((N_EVEN, D_MODEL, EVEN_IN), D_MODEL ** -0.5),
        'conv_dw_w': nrm((N_EVEN, CONV_WIDTH, CONV_DIM), CONV_WIDTH ** -0.5),
        'conv_dw_b': nrm((N_EVEN, CONV_DIM), 0.02),
        'conv_ln_g': gain((N_EVEN, CONV_DIM)),
        'conv_ln_b': nrm((N_EVEN, CONV_DIM), 0.02),
        'hgrn_lb_logits': nrm((N_EVEN, HGRN_DIM), 0.5),
        'hgrn_onorm_g': gain((N_EVEN, HGRN_HEAD_DIM)),
        'ev_w_out': nrm((N_EVEN, EVEN_MIX, D_MODEL), OUT_SCALE * EVEN_MIX ** -0.5),
        'od_w_in': nrm((N_ODD, D_MODEL, ODD_IN), D_MODEL ** -0.5),
        'sgu_ln_g': gain((N_ODD, SGU_DIM)),
        'sgu_ln_b': nrm((N_ODD, SGU_DIM), 0.02),
        'sgu_w': nrm((N_ODD, SGU_GROUPS, SGU_CHUNK, SGU_CHUNK), SGU_CHUNK ** -0.5),
        'sgu_b': gain((N_ODD, SGU_GROUPS, SGU_CHUNK)),
        'attn_qnorm_g': gain((N_ODD, ATTN_HEAD_DIM)),
        'attn_knorm_g': gain((N_ODD, ATTN_HEAD_DIM)),
        'od_w_out': nrm((N_ODD, ODD_MIX, D_MODEL), OUT_SCALE * ODD_MIX ** -0.5),
        'norm_xattn_g': gain((DEPTH, D_MODEL)),
        'norm_mem_g': gain((DEPTH, D_MODEL)),
        'xattn_wq': nrm((DEPTH, D_MODEL, XATTN_HEADS * XATTN_HEAD_DIM), D_MODEL ** -0.5),
        'xattn_wkv': nrm((DEPTH, D_MODEL, 2 * XATTN_HEADS * XATTN_HEAD_DIM), D_MODEL ** -0.5),
        'xattn_qnorm_g': gain((DEPTH, XATTN_HEAD_DIM)),
        'xattn_knorm_g': gain((DEPTH, XATTN_HEAD_DIM)),
        'xattn_wo': nrm((DEPTH, XATTN_HEADS * XATTN_HEAD_DIM, D_MODEL),
                        OUT_SCALE * (XATTN_HEADS * XATTN_HEAD_DIM) ** -0.5),
        'norm_mlp_g': gain((DEPTH, D_MODEL)),
        'mlp_w1': nrm((DEPTH, D_MODEL, D_FF), D_MODEL ** -0.5),
        'mlp_w2': nrm((DEPTH, D_FF, D_MODEL), OUT_SCALE * D_FF ** -0.5),
    }


def reference(x, mem, norm_mix_g, ev_w_in, conv_dw_w, conv_dw_b, conv_ln_g, conv_ln_b,
              hgrn_lb_logits, hgrn_onorm_g, ev_w_out, od_w_in, sgu_ln_g, sgu_ln_b, sgu_w,
              sgu_b, attn_qnorm_g, attn_knorm_g, od_w_out, norm_xattn_g, norm_mem_g,
              xattn_wq, xattn_wkv, xattn_qnorm_g, xattn_knorm_g, xattn_wo, norm_mlp_g,
              mlp_w1, mlp_w2):
    lb_all = jnp.cumsum(jax.nn.softmax(hgrn_lb_logits.astype(jnp.float32), axis=0), axis=0)
    lb_all = lb_all - lb_all[0]
    for l in range(DEPTH):
        h = rmsnorm(x, norm_mix_g[l])
        if l % 2 == 0:
            e = l // 2
            x = x + even_mixer(h, ev_w_in[e], conv_dw_w[e], conv_dw_b[e], conv_ln_g[e],
                               conv_ln_b[e], lb_all[e], hgrn_onorm_g[e], ev_w_out[e])
        else:
            o = l // 2
            x = x + odd_mixer(h, od_w_in[o], sgu_ln_g[o], sgu_ln_b[o], sgu_w[o], sgu_b[o],
                              attn_qnorm_g[o], attn_knorm_g[o], od_w_out[o])
        h = rmsnorm(x, norm_xattn_g[l])
        mem_h = rmsnorm(mem, norm_mem_g[l])
        x = x + memory_cross_attention(h, mem_h, xattn_wq[l], xattn_wkv[l], xattn_qnorm_g[l],
                                       xattn_knorm_g[l], xattn_wo[l])
        h = rmsnorm(x, norm_mlp_g[l])
        x = x + squared_relu_mlp(h, mlp_w1[l], mlp_w2[l])
    return x
```

```cpp
#include <hip/hip_runtime.h>
#include <hip/hip_cooperative_groups.h>
#include <cstdio>
#include <cstdint>
namespace cg = cooperative_groups;

#ifndef MK_MULTI
#define MK_MULTI 0
#endif

#define LAS __attribute__((address_space(3)))
typedef unsigned short bf16_t;
typedef short bf16x8 __attribute__((ext_vector_type(8)));
typedef float f32x4 __attribute__((ext_vector_type(4)));
typedef float f32x2 __attribute__((ext_vector_type(2)));
typedef unsigned u32x4 __attribute__((ext_vector_type(4)));
typedef unsigned u32x2 __attribute__((ext_vector_type(2)));
typedef __bf16 bf16x2_t __attribute__((ext_vector_type(2)));
typedef short v4i16_t __attribute__((ext_vector_type(4)));

constexpr int NTOK = 65536, DM = 1024, SEQ = 4096, NBATCH = 16;
constexpr float EPSF = 1e-6f;
constexpr size_t MiB = 1u << 20;
typedef unsigned long long u64;
constexpr float SC_SS = 1048576.0f, SC_L = 16777216.0f;
constexpr size_t ST_SXZ = 0;
constexpr size_t ST_QST = 11 * 512 * 1024;
constexpr size_t ST_LSUM = ST_QST + 8 * MiB;
constexpr size_t ST_KST = ST_LSUM + 8 * MiB;
constexpr size_t ST_ZERO_BYTES = ST_KST + 1 * MiB;
constexpr size_t ST_SX0 = ST_ZERO_BYTES;
constexpr size_t ST_SMEM = ST_SX0 + 512 * 1024;
constexpr size_t ST_BAR = ST_SX0 + 768 * 1024;
constexpr size_t ST_LSE = 24 * MiB;
constexpr size_t ST_ROPE = 27 * MiB;
constexpr size_t WB = 16 * MiB;
constexpr size_t WS_EVWIN = WB + 16 * MiB, WS_ODWIN = WB + 28 * MiB, WS_EVWOUT = WB + 41 * MiB, WS_ODWOUT = WB + 45 * MiB, WS_WQ = WB + 50 * MiB, WS_WKV = WB + 58 * MiB,
                 WS_WO = WB + 74 * MiB, WS_W1 = WB + 82 * MiB, WS_W2 = WB + 114 * MiB, WS_MEMB = WB + 146 * MiB, WS_KT = WB + 154 * MiB, WS_VT = WB + 186 * MiB, WS_XB = WB + 218 * MiB,
                 WS_A = WB + 346 * MiB;
constexpr size_t WS_P = WS_A, WS_MIX = WS_A + 416 * MiB, WS_KVRAW = WS_A, WS_QX = WS_A, WS_PB = WS_A + 128 * MiB, WS_AO = WS_A + 256 * MiB, WS_HMID = WS_A;
constexpr size_t WS_VP = WS_A + 576 * MiB;
constexpr size_t WS_END = WS_VP + 32 * MiB;
constexpr int LDS_BYTES = 147456;

__device__ __forceinline__ unsigned pk_bf16(float lo, float hi) { f32x2 v = {lo, hi}; bf16x2_t b = __builtin_convertvector(v, bf16x2_t); return __builtin_bit_cast(unsigned, b); }
__device__ __forceinline__ float bf_lo(unsigned u) { return __uint_as_float(u << 16); }
__device__ __forceinline__ float bf_hi(unsigned u) { return __uint_as_float(u & 0xffff0000u); }
__device__ __forceinline__ void unpack8(const u32x4 v, float* f) { f[0] = bf_lo(v.x); f[1] = bf_hi(v.x); f[2] = bf_lo(v.y); f[3] = bf_hi(v.y); f[4] = bf_lo(v.z); f[5] = bf_hi(v.z); f[6] = bf_lo(v.w); f[7] = bf_hi(v.w); }
__device__ __forceinline__ u32x4 pack8(const float* f) { u32x4 w; w.x = pk_bf16(f[0], f[1]); w.y = pk_bf16(f[2], f[3]); w.z = pk_bf16(f[4], f[5]); w.w = pk_bf16(f[6], f[7]); return w; }
__device__ __forceinline__ float sigmoidf_(float x) { return __builtin_amdgcn_rcpf(1.0f + __expf(-x)); }
__device__ __forceinline__ float wave_sum(float v) {
#pragma unroll
    for (int o = 1; o < 64; o <<= 1) v += __shfl_xor(v, o);
    return v;
}
template <int CTRL> __device__ __forceinline__ float dppf(float v) { return __int_as_float(__builtin_amdgcn_update_dpp(0, __float_as_int(v), CTRL, 0xf, 0xf, true)); }
__device__ __forceinline__ float row16_sum(float v) { v += dppf<0x128>(v); v += dppf<0x124>(v); v += dppf<0x122>(v); v += dppf<0x121>(v); return v; }
__device__ __forceinline__ f32x2 gelu_pk(f32x2 v) {
    const f32x2 av = __builtin_elementwise_abs(v), d = av * 0.2316418882f + 1.0f;
    f32x2 t; t.x = __builtin_amdgcn_rcpf(d.x); t.y = __builtin_amdgcn_rcpf(d.y);
    f32x2 q = t * 0.5307027145f + (-0.7265760135f); q = q * t + 0.7107068705f; q = q * t + (-0.142248368f); q = q * t + 0.127414796f; q = q * t;
    const f32x2 s = (v * v) * (-0.72134752044f);
    f32x2 e; e.x = __builtin_amdgcn_exp2f(s.x); e.y = __builtin_amdgcn_exp2f(s.y);
    const f32x2 m = v * (q * e), r = v - m;
    f32x2 o; o.x = v.x < 0.f ? m.x : r.x; o.y = v.y < 0.f ? m.y : r.y; return o;
}

namespace pg8 {
constexpr int BM = 256, BK = 64, HALF = 128, HTB = HALF * BK * 2, STAGE_BYTES = 8 * HTB, WGM = 8;
__host__ __device__ __forceinline__ int lds_byte(int r, int c) { const int st = (r >> 4) * 2 + (c >> 5), rr = r & 15, cc = c & 31, ob = rr * 64 + cc * 2; return st * 1024 + (ob ^ (((ob >> 9) & 1) << 5)); }
__host__ __device__ __forceinline__ void stage_rc(int b, int& R, int& C) { const int st = b / 1024, sb = b % 1024, swz = sb ^ (((sb >> 9) & 1) << 5); R = (st >> 1) * 16 + swz / 64; C = (st & 1) * 32 + (swz % 64) / 2; }
__host__ __device__ __forceinline__ int perm32(int rho) { const int n = rho >> 4, i = rho & 15; return 8 * (i >> 2) + 4 * n + (i & 3); }

struct Unit { int pm, pn, z; };
struct Gemm { const bf16_t* A; const bf16_t* Bt; int lda, ldb, K, nM, nN, nZ, ZL; int sAh, sAl, sBh, sBl; int rev; };
struct Order {
    int nM, nN, per, nwg, G, c, rev;
    __device__ __forceinline__ void init(const Gemm& g, int G_, int c_) { nM = g.nM; nN = g.nN; per = nM * nN; nwg = per * g.nZ; G = G_; c = c_; rev = g.rev; }
    __device__ __forceinline__ bool next(int i, Unit& u) const {
        const long L = (long)i * G + c; if (L >= nwg) return false;
        int w = (int)L;
        if ((nwg & 7) == 0) { const int ch = nwg >> 3, off = w >> 3; w = (w & 7) * ch + (rev ? ch - 1 - off : off); }
        u.z = w / per; const int t = w % per;
        const int nig = WGM * nN, gid = t / nig, fm = gid * WGM, gsz = (nM - fm) < WGM ? (nM - fm) : WGM;
        u.pm = fm + ((t % nig) % gsz); u.pn = (t % nig) / gsz; return true;
    }
};
__device__ __forceinline__ const char* a_ptr(const Gemm& g, const Unit& u) { return (const char*)(g.A + ((u.z / g.ZL) * g.sAh + (u.z % g.ZL) * g.sAl + u.pm * BM * g.lda)); }
__device__ __forceinline__ const char* b_ptr(const Gemm& g, const Unit& u) { return (const char*)(g.Bt + ((u.z / g.ZL) * g.sBh + (u.z % g.ZL) * g.sBl + u.pn * BM * g.ldb)); }

struct EpiP {
    static constexpr bool PERM = true;
    bf16_t* O; int ldc; int Mz; const u64* rstat; float rinv; int act; u64* hstat; int hs_ld; int ZLo; int zcol;
    __device__ __forceinline__ void operator()(f32x4 (&acc)[2][2][4][2], const Unit& u, int wr, int wc, int fr, int fq) const {
        const int row0 = u.pm * BM + wr * 64 + fr, col0 = u.pn * BM + wc * 32 + 8 * fq;
        const bool do_gelu = (act == 1) && (u.pn < 4);
#pragma unroll
        for (int ai = 0; ai < 2; ++ai)
#pragma unroll
            for (int m = 0; m < 4; ++m) {
                const int row = row0 + ai * HALF + m * 16;
                float rs = 1.f; if (rstat) rs = rsqrtf((float)rstat[row] * rinv + EPSF);
                float hs = 0.f;
                bf16_t* rowp = O + ((long)(u.z / ZLo) * Mz + row) * ldc + (u.z % ZLo) * zcol + col0;
#pragma unroll
                for (int bj = 0; bj < 2; ++bj) {
                    f32x4 v0 = acc[ai][bj][m][0] * rs, v1 = acc[ai][bj][m][1] * rs;
                    if (do_gelu) { f32x2 a = gelu_pk((f32x2){v0[0], v0[1]}), b = gelu_pk((f32x2){v0[2], v0[3]}), c = gelu_pk((f32x2){v1[0], v1[1]}), d = gelu_pk((f32x2){v1[2], v1[3]});
                        v0 = (f32x4){a.x, a.y, b.x, b.y}; v1 = (f32x4){c.x, c.y, d.x, d.y}; }
                    else if (act == 2) {
#pragma unroll
                        for (int i = 0; i < 4; ++i) { const float a = fmaxf(v0[i], 0.f), b = fmaxf(v1[i], 0.f); v0[i] = a * a; v1[i] = b * b; } }
                    hs += (v0[0] * v0[0] + v0[1] * v0[1]) + (v0[2] * v0[2] + v0[3] * v0[3]) + (v1[0] * v1[0] + v1[1] * v1[1]) + (v1[2] * v1[2] + v1[3] * v1[3]);
                    u32x4 w; w.x = pk_bf16(v0[0], v0[1]); w.y = pk_bf16(v0[2], v0[3]); w.z = pk_bf16(v1[0], v1[1]); w.w = pk_bf16(v1[2], v1[3]);
                    *(u32x4*)(rowp + bj * HALF) = w;
                }
                if (hstat) { hs += __shfl_xor(hs, 16); hs += __shfl_xor(hs, 32); if (fq == 0) atomicAdd(hstat + ((long)u.z * Mz + row) * hs_ld + u.pn, (u64)(hs * SC_SS + 0.5f)); }
            }
    }
};
struct EpiS {
    static constexpr bool PERM = true;
    bf16_t* P; const u64* qstat; LAS float* xch;
    __device__ __forceinline__ void operator()(f32x4 (&acc)[2][2][4][2], const Unit& u, int wr, int wc, int fr, int fq) const {
        const int b = u.z >> 2, h = u.z & 3;
        const int row0 = b * SEQ + u.pm * BM + wr * 64 + fr, col0 = h * 256 + wc * 32 + 8 * fq;
#pragma unroll
        for (int ai = 0; ai < 2; ++ai)
#pragma unroll
            for (int m = 0; m < 4; ++m) {
                const int row = row0 + ai * HALF + m * 16, rl = ai * HALF + wr * 64 + m * 16 + fr;
                const float rs = rsqrtf((float)qstat[(long)row * 4 + h] * (1.0f / (256.0f * SC_SS)) + EPSF) * 1.4426950408889634f;
                float sum = 0.f;
#pragma unroll
                for (int bj = 0; bj < 2; ++bj)
#pragma unroll
                    for (int n = 0; n < 2; ++n)
#pragma unroll
                        for (int i = 0; i < 4; ++i) { const float e = __builtin_amdgcn_exp2f(acc[ai][bj][m][n][i] * rs); acc[ai][bj][m][n][i] = e; sum += e; }
                sum += __shfl_xor(sum, 16); sum += __shfl_xor(sum, 32);
                if (fq == 0) xch[rl * 4 + wc] = sum;
            }
        asm volatile("s_waitcnt lgkmcnt(0)" ::: "memory"); __builtin_amdgcn_s_barrier(); asm volatile("" ::: "memory");
#pragma unroll
        for (int ai = 0; ai < 2; ++ai)
#pragma unroll
            for (int m = 0; m < 4; ++m) {
                const int row = row0 + ai * HALF + m * 16, rl = ai * HALF + wr * 64 + m * 16 + fr;
                const f32x4 t = *(const LAS f32x4*)(xch + rl * 4);
                const float inv = 1.0f / ((t[0] + t[1]) + (t[2] + t[3]));
                bf16_t* rowp = P + (long)row * 1024 + col0;
#pragma unroll
                for (int bj = 0; bj < 2; ++bj) {
                    const f32x4 v0 = acc[ai][bj][m][0] * inv, v1 = acc[ai][bj][m][1] * inv;
                    u32x4 w; w.x = pk_bf16(v0[0], v0[1]); w.y = pk_bf16(v0[2], v0[3]); w.z = pk_bf16(v1[0], v1[1]); w.w = pk_bf16(v1[2], v1[3]);
                    *(u32x4*)(rowp + bj * HALF) = w;
                }
            }
    }
};
struct EpiO {
    static constexpr bool PERM = true;
    bf16_t* O; const u64* lsum;
    __device__ __forceinline__ void operator()(f32x4 (&acc)[2][2][4][2], const Unit& u, int wr, int wc, int fr, int fq) const {
        const int b = u.z >> 2, h = u.z & 3;
        const int row0 = b * SEQ + u.pm * BM + wr * 64 + fr, col0 = h * 256 + wc * 32 + 8 * fq;
#pragma unroll
        for (int ai = 0; ai < 2; ++ai)
#pragma unroll
            for (int m = 0; m < 4; ++m) {
                const int row = row0 + ai * HALF + m * 16;
                const float inv = SC_L / (float)lsum[(long)row * 4 + h];
                bf16_t* rowp = O + (long)row * 1024 + col0;
#pragma unroll
                for (int bj = 0; bj < 2; ++bj) {
                    const f32x4 v0 = acc[ai][bj][m][0] * inv, v1 = acc[ai][bj][m][1] * inv;
                    u32x4 w; w.x = pk_bf16(v0[0], v0[1]); w.y = pk_bf16(v0[2], v0[3]); w.z = pk_bf16(v1[0], v1[1]); w.w = pk_bf16(v1[2], v1[3]);
                    *(u32x4*)(rowp + bj * HALF) = w;
                }
            }
    }
};
struct EpiR {
    static constexpr bool PERM = true;
    float* out; bf16_t* xb; u64* stat; int Mz;
    __device__ __forceinline__ void operator()(f32x4 (&acc)[2][2][4][2], const Unit& u, int wr, int wc, int fr, int fq) const {
        const int row0 = u.z * Mz + u.pm * BM + wr * 64 + fr, col0 = u.pn * BM + wc * 32 + 8 * fq;
#pragma unroll
        for (int ai = 0; ai < 2; ++ai)
#pragma unroll
            for (int m = 0; m < 4; ++m) {
                const int row = row0 + ai * HALF + m * 16; const size_t off = (size_t)row * DM + col0;
                float ss = 0.f;
#pragma unroll
                for (int bj = 0; bj < 2; ++bj) {
                    const u32x4 xv = *(const u32x4*)(xb + off + bj * HALF); float f[8]; unpack8(xv, f);
#pragma unroll
                    for (int i = 0; i < 4; ++i) { f[i] += acc[ai][bj][m][0][i]; f[4 + i] += acc[ai][bj][m][1][i]; }
#pragma unroll
                    for (int i = 0; i < 8; ++i) ss += f[i] * f[i];
                    *(u32x4*)(xb + off + bj * HALF) = pack8(f);
                    if (out) { *(f32x4*)(out + off + bj * HALF) = (f32x4){f[0], f[1], f[2], f[3]}; *(f32x4*)(out + off + bj * HALF + 4) = (f32x4){f[4], f[5], f[6], f[7]}; }
                }
                ss += __shfl_xor(ss, 16); ss += __shfl_xor(ss, 32);
                if (fq == 0) atomicAdd(stat + row, (u64)(ss * SC_SS + 0.5f));
                asm volatile("" ::: "memory");
            }
    }
};

template <class Epi>
__device__ __forceinline__ void gemm_phase(LAS unsigned char* lds, const int tid, const Gemm g, const int G, const int cidx, const Epi& E) {
    const int wid = __builtin_amdgcn_readfirstlane(tid >> 6), lane = tid & 63, wr = wid >> 2, wc = wid & 3, fr = lane & 15, fq = lane >> 4;
    Order S; S.init(g, G, cidx);
    const int K = g.K, nt = K / BK;
    unsigned voffA[2], voffB[2];
#pragma unroll
    for (int i = 0; i < 2; ++i) { int R, C; stage_rc(tid * 16 + i * 8192, R, C); const int Rb = Epi::PERM ? ((R & ~31) + perm32(R & 31)) : R;
        voffA[i] = (unsigned)(R * g.lda + C) * 2u; voffB[i] = (unsigned)(Rb * g.ldb + C) * 2u; }
    const size_t kstep = (size_t)(BK * 2);
    const size_t hstepA = (size_t)HALF * g.lda * 2, hstepB = (size_t)HALF * g.ldb * 2;
    const unsigned ldsw = (unsigned)wid * 1024u;
    const int aoff = lds_byte(wr * 64 + fr, fq * 8), boff = lds_byte(wc * 32 + fr, fq * 8);
#define PG8_SA(b, h) (((b) * 2 + (h)) * HTB)
#define PG8_SB(b, h) ((4 + (b) * 2 + (h)) * HTB)
#define PG8_STAGE(bufoff, gbase, voff) do { _Pragma("unroll") for (int _i = 0; _i < 2; ++_i) \
        __builtin_amdgcn_global_load_lds((const unsigned*)((const char*)(gbase) + (voff)[_i]), (LAS unsigned*)(lds + (bufoff) + ldsw + _i * 8192), 16, 0, 0); } while (0)
#define PG8_LDA(dst, b, h) do { _Pragma("unroll") for (int m = 0; m < 4; ++m) _Pragma("unroll") for (int k = 0; k < 2; ++k) dst[m][k] = *(const LAS bf16x8*)(lds + PG8_SA(b, h) + aoff + m * 2048 + k * 1024); } while (0)
#define PG8_LDB(dst, b, h) do { _Pragma("unroll") for (int n = 0; n < 2; ++n) _Pragma("unroll") for (int k = 0; k < 2; ++k) dst[n][k] = *(const LAS bf16x8*)(lds + PG8_SB(b, h) + boff + n * 2048 + k * 1024); } while (0)
#define PG8_MMA(ai, bj, At, Bt) do { __builtin_amdgcn_s_setprio(1); _Pragma("unroll") for (int m = 0; m < 4; ++m) _Pragma("unroll") for (int n = 0; n < 2; ++n) _Pragma("unroll") for (int k = 0; k < 2; ++k) \
        acc[ai][bj][m][n] = __builtin_amdgcn_mfma_f32_16x16x32_bf16(Bt[n][k], At[m][k], acc[ai][bj][m][n], 0, 0, 0); __builtin_amdgcn_s_setprio(0); } while (0)
#define PG8_WAIT_V(n) asm volatile("s_waitcnt vmcnt(" #n ")" ::: "memory")
#define PG8_WAIT_L(n) asm volatile("s_waitcnt lgkmcnt(" #n ")" ::: "memory")
#define PG8_BAR __builtin_amdgcn_s_barrier()
#define PG8_SCHED __builtin_amdgcn_sched_barrier(0)
    Unit cur, nxt; int ui = 0;
    if (!S.next(0, cur)) return;
    f32x4 acc[2][2][4][2];
#pragma unroll
    for (int a = 0; a < 2; ++a)
#pragma unroll
        for (int b = 0; b < 2; ++b)
#pragma unroll
            for (int m = 0; m < 4; ++m)
#pragma unroll
                for (int n = 0; n < 2; ++n) acc[a][b][m][n] = (f32x4){0.f, 0.f, 0.f, 0.f};
    bf16x8 At[4][2], B0[2][2], B1[2][2];
    const char* cA = a_ptr(g, cur); const char* cB = b_ptr(g, cur);
    PG8_STAGE(PG8_SB(0, 0), cB, voffB); PG8_STAGE(PG8_SB(0, 1), cB + hstepB, voffB); PG8_STAGE(PG8_SA(0, 0), cA, voffA); PG8_STAGE(PG8_SA(0, 1), cA + hstepA, voffA);
    if (wr == 1) PG8_BAR;
    PG8_WAIT_V(2); PG8_BAR;
    PG8_STAGE(PG8_SB(1, 0), cB + kstep, voffB); PG8_STAGE(PG8_SA(1, 0), cA + kstep, voffA); PG8_STAGE(PG8_SB(1, 1), cB + hstepB + kstep, voffB);
    PG8_WAIT_V(6); PG8_BAR;
    for (;;) {
        const bool has_next = S.next(ui + 1, nxt);
        const char* nA = has_next ? a_ptr(g, nxt) : cA; const char* nB = has_next ? b_ptr(g, nxt) : cB;
        for (int t = 0; t < nt; t += 2) {
            const bool last = (t == nt - 2);
            const char* a1 = cA + (size_t)(t + 1) * kstep;
            const char* a2 = last ? nA : cA + (size_t)(t + 2) * kstep; const char* b2 = last ? nB : cB + (size_t)(t + 2) * kstep;
            const char* a3 = a2 + kstep; const char* b3 = b2 + kstep;
            PG8_LDB(B0, 0, 0); PG8_LDB(B1, 0, 1); PG8_SCHED; PG8_LDA(At, 0, 0); PG8_STAGE(PG8_SA(1, 1), a1 + hstepA, voffA);
            PG8_WAIT_V(8); PG8_WAIT_L(0); PG8_BAR; PG8_MMA(0, 0, At, B0); PG8_MMA(0, 1, At, B1); PG8_BAR; PG8_SCHED;
            PG8_LDA(At, 0, 1); PG8_STAGE(PG8_SB(0, 0), b2, voffB); PG8_STAGE(PG8_SB(0, 1), b2 + hstepB, voffB); PG8_STAGE(PG8_SA(0, 0), a2, voffA);
            PG8_WAIT_V(8); PG8_WAIT_L(0); PG8_BAR; PG8_MMA(1, 0, At, B0); PG8_MMA(1, 1, At, B1); PG8_BAR; PG8_SCHED;
            PG8_LDB(B0, 1, 0); PG8_LDB(B1, 1, 1); PG8_SCHED; PG8_LDA(At, 1, 0); PG8_STAGE(PG8_SA(0, 1), a2 + hstepA, voffA);
            PG8_WAIT_V(8); PG8_WAIT_L(0); PG8_BAR; PG8_MMA(0, 0, At, B0); PG8_MMA(0, 1, At, B1); PG8_BAR; PG8_SCHED;
            PG8_LDA(At, 1, 1); PG8_STAGE(PG8_SB(1, 0), b3, voffB); PG8_STAGE(PG8_SB(1, 1), b3 + hstepB, voffB); PG8_STAGE(PG8_SA(1, 0), a3, voffA);
            PG8_WAIT_V(8); PG8_WAIT_L(0); PG8_BAR; PG8_MMA(1, 0, At, B0); PG8_MMA(1, 1, At, B1); PG8_BAR; PG8_SCHED;
        }
        if (wr == 0) PG8_BAR;
        E(acc, cur, wr, wc, fr, fq);
        if (!has_next) break;
#pragma unroll
        for (int a = 0; a < 2; ++a)
#pragma unroll
            for (int b = 0; b < 2; ++b)
#pragma unroll
                for (int m = 0; m < 4; ++m)
#pragma unroll
                    for (int n = 0; n < 2; ++n) acc[a][b][m][n] = (f32x4){0.f, 0.f, 0.f, 0.f};
        cur = nxt; cA = nA; cB = nB; ++ui;
        if (wr == 1) PG8_BAR;
    }
    PG8_WAIT_V(0);
    PG8_BAR;
#undef PG8_SA
#undef PG8_SB
#undef PG8_STAGE
#undef PG8_LDA
#undef PG8_LDB
#undef PG8_MMA
#undef PG8_WAIT_V
#undef PG8_WAIT_L
#undef PG8_BAR
#undef PG8_SCHED
}
}

struct Args { const float* in[29]; float* out; unsigned char* ws; int lo, hi; };

__device__ __forceinline__ void transpose_item(const float* W, int K, int N, const float* gain, bf16_t* WT, LAS float* scr, int item, int lane) {
    const int nblk = N / 32, kb = item / nblk, nb = item % nblk, k0 = 64 * kb, n0 = 32 * nb;
#pragma unroll 8
    for (int i = 0; i < 32; ++i) { const int kk = 2 * i + (lane >> 5); float v = W[(size_t)(k0 + kk) * N + n0 + (lane & 31)]; if (gain) v *= gain[k0 + kk]; scr[kk * 33 + (lane & 31)] = v; }
    asm volatile("s_waitcnt lgkmcnt(0)" ::: "memory");
    const int c = lane & 7;
#pragma unroll
    for (int j = 0; j < 4; ++j) { const int n = (lane >> 3) + 8 * j; const LAS float* s = scr + (8 * c) * 33 + n;
        u32x4 o; o.x = pk_bf16(s[0 * 33], s[1 * 33]); o.y = pk_bf16(s[2 * 33], s[3 * 33]); o.z = pk_bf16(s[4 * 33], s[5 * 33]); o.w = pk_bf16(s[6 * 33], s[7 * 33]);
        *(u32x4*)(WT + (size_t)(n0 + n) * K + k0 + 8 * c) = o; }
    asm volatile("s_waitcnt lgkmcnt(0)" ::: "memory");
}
__device__ __forceinline__ void transpose_all(const float* W, int K, int N, const float* gain, bf16_t* WT, LAS float* scr, int gw, int NGW, int lane) {
    const int nitems = (K / 64) * (N / 32);
    for (int it = gw; it < nitems; it += NGW) transpose_item(W, K, N, gain, WT, scr, it, lane);
}
__device__ __forceinline__ void row_to_bf16(const float* xrow, bf16_t* orow, u64* ss, int lane) {
    const f32x4* xr = (const f32x4*)xrow + lane; float s = 0.f; f32x4 v[4];
#pragma unroll
    for (int j = 0; j < 4; ++j) { v[j] = xr[64 * j]; s += (v[j].x * v[j].x + v[j].y * v[j].y) + (v[j].z * v[j].z + v[j].w * v[j].w); }
    s = wave_sum(s);
    u32x2* o8 = (u32x2*)orow + lane;
#pragma unroll
    for (int j = 0; j < 4; ++j) { u32x2 w; w.x = pk_bf16(v[j].x, v[j].y); w.y = pk_bf16(v[j].z, v[j].w); o8[64 * j] = w; }
    if (lane == 0) *ss = (u64)(s * SC_SS + 0.5f);
}

__device__ __forceinline__ void transpose_layer(const __attribute__((address_space(4))) Args* ap, unsigned char* ws, int l, LAS float* scr, int gw, int NGW, int lane) {
    const int e = l >> 1;
    if (l & 1) {
        transpose_all(ap->in[11] + (size_t)e * 1024 * 3328, 1024, 3328, ap->in[2] + l * 1024, (bf16_t*)(ws + WS_ODWIN) + (size_t)e * 3328 * 1024, scr, gw, NGW, lane);
        transpose_all(ap->in[18] + (size_t)e * 1280 * 1024, 1280, 1024, nullptr, (bf16_t*)(ws + WS_ODWOUT) + (size_t)e * 1024 * 1280, scr, gw, NGW, lane);
    } else {
        transpose_all(ap->in[3] + (size_t)e * 1024 * 3072, 1024, 3072, ap->in[2] + l * 1024, (bf16_t*)(ws + WS_EVWIN) + (size_t)e * 3072 * 1024, scr, gw, NGW, lane);
        transpose_all(ap->in[10] + (size_t)e * 1024 * 1024, 1024, 1024, nullptr, (bf16_t*)(ws + WS_EVWOUT) + (size_t)e * 1024 * 1024, scr, gw, NGW, lane);
    }
    transpose_all(ap->in[21] + (size_t)l * 1024 * 1024, 1024, 1024, ap->in[19] + l * 1024, (bf16_t*)(ws + WS_WQ) + (size_t)l * 1024 * 1024, scr, gw, NGW, lane);
    transpose_all(ap->in[25] + (size_t)l * 1024 * 1024, 1024, 1024, nullptr, (bf16_t*)(ws + WS_WO) + (size_t)l * 1024 * 1024, scr, gw, NGW, lane);
    transpose_all(ap->in[27] + (size_t)l * 1024 * 4096, 1024, 4096, ap->in[26] + l * 1024, (bf16_t*)(ws + WS_W1) + (size_t)l * 4096 * 1024, scr, gw, NGW, lane);
    transpose_all(ap->in[28] + (size_t)l * 4096 * 1024, 4096, 1024, nullptr, (bf16_t*)(ws + WS_W2) + (size_t)l * 1024 * 4096, scr, gw, NGW, lane);
}

#define XB_TMO      128
#define XB_XCNT(j)  (256  + 64 * (j))
#define XB_XSUB(j)  (1280 + 64 * (j))
#define XB_XGEN(j)  (2304 + 64 * (j))
#define XB_TOP      3328
#define XB_TOPGEN   3392
#define XCD_BAR_WORDS 3456
#define XB_SPIN_CAP (1u << 22)
__device__ __forceinline__ unsigned xb_ld(unsigned* p)              { return __hip_atomic_load(p, __ATOMIC_RELAXED, __HIP_MEMORY_SCOPE_AGENT); }
__device__ __forceinline__ unsigned xb_add(unsigned* p, unsigned v) { return __hip_atomic_fetch_add(p, v, __ATOMIC_RELAXED, __HIP_MEMORY_SCOPE_AGENT); }
__device__ __forceinline__ unsigned xb_xcc_id() { return (unsigned)__builtin_amdgcn_s_getreg((3 << 11) | 20) & 0xFu; }
#define XB_SPIN(cond, bar) do { unsigned _sp = 0; while (cond) { __builtin_amdgcn_s_sleep(1); \
    if ((++_sp & 255u) == 0u) { if (xb_ld(&(bar)[XB_TMO])) break; if (_sp > XB_SPIN_CAP) { atomicAdd(&(bar)[XB_TMO], 1u); break; } } } } while (0)
__device__ __forceinline__ void xcd_barrier_complete(unsigned* bar, unsigned x, unsigned& nloc, unsigned& nx) {
    const unsigned G = gridDim.x * gridDim.y * gridDim.z;
    unsigned sum, cnt, mine, sp = 0u;
    for (;;) {
        sum = 0u; cnt = 0u; mine = 0u;
#pragma unroll
        for (unsigned j = 0; j < 16; ++j) { const unsigned c = xb_ld(&bar[XB_XCNT(j)]); sum += c; cnt += (c > 0u) ? 1u : 0u; mine = (j == x) ? c : mine; }
        if (sum == G) break;
        __builtin_amdgcn_s_sleep(1);
        if ((++sp & 255u) == 0u) { if (xb_ld(&bar[XB_TMO])) break; if (sp > XB_SPIN_CAP) { atomicAdd(&bar[XB_TMO], 1u); break; } }
    }
    nloc = mine > 0u ? mine : 1u; nx = cnt > 0u ? cnt : 1u;
}
__device__ __forceinline__ void xcd_barrier(unsigned* bar, unsigned x, volatile LAS unsigned* st) {
    asm volatile("s_waitcnt vmcnt(0)" ::: "memory");
    __syncthreads();
    if (threadIdx.x == 0) {
        __builtin_amdgcn_s_waitcnt(0);
        unsigned nloc = st[0], nx = st[1];
        if (nloc == 0u) { xcd_barrier_complete(bar, x, nloc, nx); st[0] = nloc; st[1] = nx; }
        const unsigned old = xb_add(&bar[XB_XSUB(x)], 1u);
        const unsigned gen = old / nloc;
        if (old + 1u == (gen + 1u) * nloc) {
            __builtin_amdgcn_fence(__ATOMIC_RELEASE, "agent");
            asm volatile("s_waitcnt vmcnt(0)" ::: "memory");
            const unsigned og = xb_add(&bar[XB_TOP], 1u);
            const unsigned tg = og / nx;
            if (og + 1u == (tg + 1u) * nx) xb_add(&bar[XB_TOPGEN], 1u);
            else XB_SPIN(xb_ld(&bar[XB_TOPGEN]) == tg, bar);
            __builtin_amdgcn_fence(__ATOMIC_ACQUIRE, "agent");
            xb_add(&bar[XB_XGEN(x)], 1u);
            asm volatile("s_waitcnt vmcnt(0)" ::: "memory");
        } else {
            XB_SPIN(xb_ld(&bar[XB_XGEN(x)]) == gen, bar);
            __builtin_amdgcn_fence(__ATOMIC_ACQUIRE, "agent");
            asm volatile("s_waitcnt vmcnt(0)" ::: "memory");
        }
    }
    __syncthreads();
}

__global__ void __launch_bounds__(512, 2) mk_fwd(Args args) {
    extern __shared__ __attribute__((aligned(16))) unsigned char lds_raw[];
    LAS unsigned char* lds = (LAS unsigned char*)lds_raw;
    volatile LAS unsigned* const xst = (volatile LAS unsigned*)((LAS unsigned char*)lds_raw + LDS_BYTES - 64);
    if (threadIdx.x < 2) xst[threadIdx.x] = 0u;
    const unsigned xcc = xb_xcc_id();
    if (args.hi - args.lo > 1 && threadIdx.x == 0) (void)xb_add((unsigned*)(args.ws + ST_BAR) + XB_XCNT(xcc), 1u);
    __syncthreads();
    const __attribute__((address_space(4))) Args* const ap0 = (const __attribute__((address_space(4))) Args*)__builtin_amdgcn_kernarg_segment_ptr();
#ifdef REP_MASK
    for (int ph2 = args.lo * 2; ph2 < args.hi * 2; ++ph2) { const int ph = ph2 >> 1;
    if ((ph2 & 1) && !(ph >= 3 && ((REP_MASK >> ((ph - 3) % 10)) & 1) && ((REP_ODD >> (((ph - 3) / 10) & 1)) & 1))) continue;
#else
    for (int ph = args.lo; ph < args.hi; ++ph) {
#endif
    const __attribute__((address_space(4))) Args* ap = ap0; asm volatile("" : "+s"(ap));
    int tid = threadIdx.x; asm volatile("" : "+v"(tid));
    const int lane = tid & 63, wave = __builtin_amdgcn_readfirstlane(tid >> 6);
    int G = gridDim.x, bx = blockIdx.x; asm volatile("" : "+s"(G), "+s"(bx));
    const int vcu = (G % 8 == 0) ? (bx % 8) * (G / 8) + bx / 8 : bx;
    unsigned char* ws = ap->ws;
    u64* const st_sxz = (u64*)(ws + ST_SXZ); u64* const st_sx0 = (u64*)(ws + ST_SX0);
    bf16_t* const xb = (bf16_t*)(ws + WS_XB);
    bf16_t* const pbuf = (bf16_t*)(ws + WS_P); bf16_t* const mix = (bf16_t*)(ws + WS_MIX);
    float* const rope = (float*)(ws + ST_ROPE); float* const lse = (float*)(ws + ST_LSE);
    {
#ifdef ONLY_S
        if (ph < 0) {
#else
        if (ph == 0) {
#endif
            const int gw = vcu * 8 + wave, NGW = G * 8;
            { u32x4* z = (u32x4*)ws; const size_t n16 = ST_ZERO_BYTES / 16; for (size_t i = (size_t)bx * 512 + tid; i < n16; i += (size_t)G * 512) z[i] = (u32x4){0u, 0u, 0u, 0u}; }
            for (int m = gw * 2; m < NTOK; m += NGW * 2) {
                const f32x4* x0 = (const f32x4*)(ap->in[0] + (size_t)m * DM) + lane; const f32x4* x1 = x0 + DM / 4;
                f32x4 v[8];
#pragma unroll
                for (int j = 0; j < 4; ++j) { v[j] = x0[64 * j]; v[4 + j] = x1[64 * j]; }
                float s0 = 0.f, s1 = 0.f;
#pragma unroll
                for (int j = 0; j < 4; ++j) { s0 += (v[j].x * v[j].x + v[j].y * v[j].y) + (v[j].z * v[j].z + v[j].w * v[j].w); s1 += (v[4 + j].x * v[4 + j].x + v[4 + j].y * v[4 + j].y) + (v[4 + j].z * v[4 + j].z + v[4 + j].w * v[4 + j].w); }
                s0 = wave_sum(s0); s1 = wave_sum(s1);
                u32x2* o0 = (u32x2*)(xb + (size_t)m * DM) + lane; u32x2* o1 = o0 + DM / 4;
#pragma unroll
                for (int j = 0; j < 4; ++j) { u32x2 w; w.x = pk_bf16(v[j].x, v[j].y); w.y = pk_bf16(v[j].z, v[j].w); o0[64 * j] = w; u32x2 w1; w1.x = pk_bf16(v[4 + j].x, v[4 + j].y); w1.y = pk_bf16(v[4 + j].z, v[4 + j].w); o1[64 * j] = w1; }
                if (lane == 0) { st_sx0[m] = (u64)(s0 * SC_SS + 0.5f); st_sx0[m + 1] = (u64)(s1 * SC_SS + 0.5f); }
            }
            { bf16_t* memb = (bf16_t*)(ws + WS_MEMB); u64* smem = (u64*)(ws + ST_SMEM);
              for (int m = gw; m < 4096; m += NGW) row_to_bf16(ap->in[1] + (size_t)m * DM, memb + (size_t)m * DM, smem + m, lane); }
            LAS float* scr = (LAS float*)(lds + wave * 16384);
            for (int l = 0; l < 4; ++l)
                transpose_all(ap->in[22] + (size_t)l * 1024 * 2048, 1024, 2048, ap->in[20] + l * 1024, (bf16_t*)(ws + WS_WKV) + (size_t)l * 2048 * 1024, scr, gw, NGW, lane);
            for (int l = 0; l < ((G >= 128) ? 1 : 4); ++l) transpose_layer(ap, ws, l, scr, gw, NGW, lane);
            for (int i = bx * 512 + tid; i < 4096 * 8; i += G * 512) {
                const int t = i >> 3, j = i & 7;
                const float invf[8] = {1.0f, 0.19392274474868576f, 0.03760603093086393f, 0.007292664737217109f, 0.001414213562373095f, 0.0002742481756762073f, 5.318295896944988e-05f, 1.031338537721246e-05f};
                float fj = invf[0];
#pragma unroll
                for (int q = 1; q < 8; ++q) fj = (j == q) ? invf[q] : fj;
                const float ang = (float)t * fj;
                const double a = (double)ang; const double k = __builtin_rint(a * 0.15915494309189535); const float r = (float)(a - k * 6.283185307179586);
                rope[t * 16 + j] = __cosf(r); rope[t * 16 + 8 + j] = __sinf(r);
            }
#ifdef ONLY_S
        } else if (ph < 0) {
#else
        } else if (ph == 1) {
#endif
            pg8::Gemm g{(const bf16_t*)(ws + WS_MEMB), (const bf16_t*)(ws + WS_WKV), 1024, 1024, 1024, 16, 8, 4, 1, 0, 0, 2048 * 1024, 0, 0};
            pg8::EpiP E{(bf16_t*)(ws + WS_KVRAW), 2048, 4096, (const u64*)(ws + ST_SMEM), 1.0f / (1024.0f * SC_SS), 0, (u64*)(ws + ST_KST), 8, 1, 0};
            pg8::gemm_phase<pg8::EpiP>(lds, tid, g, G, bx, E);
#ifdef ONLY_S
        } else if (ph < 0) {
#else
        } else if (ph == 2) {
#endif
            const int gw = vcu * 8 + wave, NGW = G * 8;
            const bf16_t* kvraw = (const bf16_t*)(ws + WS_KVRAW); bf16_t* kt = (bf16_t*)(ws + WS_KT); bf16_t* vt = (bf16_t*)(ws + WS_VT); const u64* kst = (const u64*)(ws + ST_KST);
            for (int r = gw; r < 4 * 4096; r += NGW) {
                const int l = r >> 12;
                const float* gk = ap->in[24] + l * 256; const float* gq = ap->in[23] + l * 256;
#pragma unroll
                for (int c2 = 0; c2 < 2; ++c2) {
                    const int ch = lane + 64 * c2, h = ch >> 5, e0 = (ch & 31) * 8;
                    const float rs = rsqrtf((float)kst[(size_t)r * 8 + h] * (1.0f / (256.0f * SC_SS)) + EPSF) * 0.0625f;
                    const u32x4 raw = *(const u32x4*)(kvraw + (size_t)r * 2048 + ch * 8); float f[8]; unpack8(raw, f);
#pragma unroll
                    for (int i = 0; i < 8; ++i) f[i] = f[i] * rs * gk[e0 + i] * gq[e0 + i];
                    *(u32x4*)(kt + (size_t)r * 1024 + ch * 8) = pack8(f);
                }
            }
            for (int idx = bx * 512 + tid; idx < 4 * 4096 * 128; idx += G * 512) {
                const int ch = idx & 127, r = idx >> 7;
                *(u32x4*)(vt + (size_t)r * 1024 + ch * 8) = *(const u32x4*)(kvraw + (size_t)r * 2048 + 1024 + ch * 8);
            }
        } else {
            #ifdef ONLY_S
            const int l = (ph - 3) / 10, s = ONLY_S, odd = ONLY_ODD, eo = l >> 1;
#else
            const int l = (ph - 3) / 10, s = (ph - 3) % 10, odd = l & 1, eo = l >> 1;
#endif
            u64* const sx_mix = (l == 0) ? st_sx0 : st_sxz + (size_t)(3 * l - 1) * NTOK;
            u64* const sx_xat = st_sxz + (size_t)(3 * l) * NTOK;
            u64* const sx_mlp = st_sxz + (size_t)(3 * l + 1) * NTOK;
            u64* const sx_next = st_sxz + (size_t)(3 * l + 2) * NTOK;
            u64* const qst = (u64*)(ws + ST_QST) + (size_t)l * NTOK * 4;
            u64* const lsum = (u64*)(ws + ST_LSUM) + (size_t)l * NTOK * 4;
            const int PW = odd ? 3328 : 3072, MW = odd ? 1280 : 1024;
            if (s == 6) continue;
            if (s == 0) {
                const bf16_t* wt = odd ? (const bf16_t*)(ws + WS_ODWIN) + (size_t)eo * 3328 * 1024 : (const bf16_t*)(ws + WS_EVWIN) + (size_t)eo * 3072 * 1024;
                pg8::Gemm g{xb, wt, 1024, 1024, 1024, 256, PW / 256, 1, 1, 0, 0, 0, 0, 0};
                pg8::EpiP E{pbuf, PW, NTOK, sx_mix, 1.0f / (1024.0f * SC_SS), odd ? 1 : 0, nullptr, 0, 1, 0};
                pg8::Gemm gv{(const bf16_t*)(ws + WS_WO) + (size_t)l * 1024 * 1024, (const bf16_t*)(ws + WS_VT) + (size_t)l * 4096 * 1024, 1024, 1024, 256, 4, 1, 64, 4, 0, 256, 256 * 1024, 256, 0};
                pg8::EpiP Ev{(bf16_t*)(ws + WS_VP), 1024, 1024, nullptr, 0.f, 0, nullptr, 0, 4, 256};
#pragma unroll 1
                for (int pass = 0; pass < 2; ++pass)
                    pg8::gemm_phase<pg8::EpiP>(lds, tid, pass ? gv : g, G, bx, pass ? Ev : E);
            } else if (s == 1 && !odd) {
#if !defined(NO_HGRN)
                {
                    const int fr = lane & 15, fq = lane >> 4, tr_r = (lane & 15) >> 2, tr_c = lane & 3;
                    const int kch = tid >> 2, tq = tid & 3;
                    constexpr int HB = 17920;
                    for (int item = vcu; item < 64; item += G) {
                        const int b = item >> 2, h = item & 3;
                        float lbv = 0.f; if (eo == 1) { const int c = h * 128 + kch; lbv = sigmoidf_(ap->in[8][512 + c] - ap->in[8][c]); }
                        f32x4 Sacc[8];
#pragma unroll
                        for (int kt = 0; kt < 8; ++kt) Sacc[kt] = (f32x4){0.f, 0.f, 0.f, 0.f};
                        const bf16_t* pq = pbuf + ((size_t)b * SEQ + 4 * tq) * 3072 + 1024 + h * 128 + kch;
                        const bf16_t* pi = pbuf + ((size_t)b * SEQ + (tid >> 5)) * 3072 + 2048 + h * 128 + (tid & 31) * 4;
                        unsigned rqr[4], rfr[4]; u32x2 rir;
#define HG_LOAD(blk_) do { const bf16_t* p_ = pq + (size_t)(blk_) * 16 * 3072; \
                            _Pragma("unroll") for (int j = 0; j < 4; ++j) { rqr[j] = p_[(size_t)j * 3072]; rfr[j] = p_[(size_t)j * 3072 + 512]; } \
                            rir = *(const u32x2*)(pi + (size_t)(blk_) * 16 * 3072); } while (0)
#define HG_ELEM(buf_) do { LAS bf16_t* QT_ = (LAS bf16_t*)(lds + (buf_) * HB); LAS bf16_t* KT_ = QT_ + 2176; LAS bf16_t* KB_ = QT_ + 4352; LAS bf16_t* IV_ = QT_ + 6528; LAS float* EL_ = (LAS float*)(lds + (buf_) * HB + 17408); \
                            float cj[4], fk[4], qv[4]; float c_ = 0.f; \
                            _Pragma("unroll") for (int j = 0; j < 4; ++j) { const float fp = __uint_as_float(rfr[j] << 16); const float f = lbv + (1.0f - lbv) * sigmoidf_(fp); c_ += __logf(f); cj[j] = c_; fk[j] = 1.0f - f; qv[j] = __uint_as_float(rqr[j] << 16); } \
                            const float T0 = dppf<0x00>(c_), T1 = dppf<0x55>(c_), T2 = dppf<0xAA>(c_), T3 = dppf<0xFF>(c_); \
                            const float P_ = (tq > 0 ? T0 : 0.f) + (tq > 1 ? T1 : 0.f) + (tq > 2 ? T2 : 0.f); \
                            const float ELv = __expf(fmaxf((T0 + T1) + (T2 + T3), -80.f)); \
                            _Pragma("unroll") for (int j = 0; j < 4; ++j) { const float Bv = fmaxf(P_ + cj[j], -80.f); const float E = __expf(Bv), Ei = __expf(-Bv); const float kt_ = fk[j] * Ei; const int t_ = 4 * tq + j; \
                                QT_[t_ * 136 + kch] = (bf16_t)(pk_bf16(qv[j] * E, 0.f) & 0xffffu); KT_[t_ * 136 + kch] = (bf16_t)(pk_bf16(kt_, 0.f) & 0xffffu); KB_[t_ * 136 + kch] = (bf16_t)(pk_bf16(kt_ * ELv, 0.f) & 0xffffu); } \
                            if (tq == 0) EL_[kch] = ELv; \
                            *(LAS u32x2*)(IV_ + (tid >> 5) * 136 + (tid & 31) * 4) = rir; } while (0)
                        HG_LOAD(0);
                        {
                            LAS float* fL = (LAS float*)(lds + 40960); LAS float* qL = fL + 2048; LAS float* iL = fL + 4096; LAS float* SD = (LAS float*)(lds + 65536);
#pragma unroll
                            for (int j = 0; j < 4; ++j) { const float fp = __uint_as_float(rfr[j] << 16); fL[(4 * tq + j) * 128 + kch] = lbv + (1.0f - lbv) * sigmoidf_(fp); qL[(4 * tq + j) * 128 + kch] = __uint_as_float(rqr[j] << 16); }
                            *(LAS f32x4*)(iL + (tid >> 5) * 128 + (tid & 31) * 4) = (f32x4){bf_lo(rir.x), bf_hi(rir.x), bf_lo(rir.y), bf_hi(rir.y)};
                            asm volatile("s_waitcnt lgkmcnt(0)" ::: "memory"); __builtin_amdgcn_s_barrier(); asm volatile("" ::: "memory");
                            const int kg = lane & 15, vq = wave * 4 + (lane >> 4);
                            float S0[8][4];
#pragma unroll
                            for (int j = 0; j < 8; ++j)
#pragma unroll
                                for (int c = 0; c < 4; ++c) S0[j][c] = 0.f;
#pragma unroll 2
                            for (int t = 0; t < 16; ++t) {
                                const f32x4 fa = *(const LAS f32x4*)(fL + t * 128 + kg * 8), fb = *(const LAS f32x4*)(fL + t * 128 + kg * 8 + 4);
                                const f32x4 qa = *(const LAS f32x4*)(qL + t * 128 + kg * 8), qb = *(const LAS f32x4*)(qL + t * 128 + kg * 8 + 4);
                                const f32x4 iv = *(const LAS f32x4*)(iL + t * 128 + vq * 4);
                                float a[4] = {0.f, 0.f, 0.f, 0.f};
#pragma unroll
                                for (int j = 0; j < 8; ++j) { const float fj = j < 4 ? fa[j] : fb[j - 4], qj = j < 4 ? qa[j] : qb[j - 4];
#pragma unroll
                                    for (int c = 0; c < 4; ++c) { const float d0 = S0[j][c] - iv[c]; S0[j][c] = __builtin_fmaf(fj, d0, iv[c]); a[c] = __builtin_fmaf(qj, S0[j][c], a[c]); } }
#pragma unroll
                                for (int c = 0; c < 4; ++c) a[c] = row16_sum(a[c]);
                                if (kg == 0) { u32x2 wv; wv.x = pk_bf16(a[0], a[1]); wv.y = pk_bf16(a[2], a[3]); *(u32x2*)(mix + ((size_t)b * SEQ + t) * 1024 + 512 + h * 128 + vq * 4) = wv; }
                            }
#pragma unroll
                            for (int j = 0; j < 8; ++j) *(LAS f32x4*)(SD + (kg * 8 + j) * 128 + vq * 4) = (f32x4){S0[j][0], S0[j][1], S0[j][2], S0[j][3]};
                            asm volatile("s_waitcnt lgkmcnt(0)" ::: "memory"); __builtin_amdgcn_s_barrier(); asm volatile("" ::: "memory");
#pragma unroll
                            for (int kt = 0; kt < 8; ++kt)
#pragma unroll
                                for (int i = 0; i < 4; ++i) Sacc[kt][i] = SD[(16 * kt + 4 * fq + i) * 128 + 16 * wave + fr];
                        }
                        HG_LOAD(1); HG_ELEM(1); HG_LOAD(2);
                        asm volatile("s_waitcnt lgkmcnt(0)" ::: "memory"); __builtin_amdgcn_s_barrier(); asm volatile("" ::: "memory");
                        for (int blk = 1; blk < 256; ++blk) {
                            const int cur = blk & 1;
                            if (wave < 4 && blk + 1 < 256) { HG_ELEM(cur ^ 1); if (blk + 2 < 256) HG_LOAD(blk + 2); }
                            const LAS bf16_t* QT = (const LAS bf16_t*)(lds + cur * HB); const LAS bf16_t* KT = QT + 2176; const LAS bf16_t* KB = QT + 4352; const LAS bf16_t* IV = QT + 6528; const LAS float* EL = (const LAS float*)(lds + cur * HB + 17408);
                            const v4i16_t itv = __builtin_amdgcn_ds_read_tr16_b64_v4i16((LAS v4i16_t*)(IV + (4 * fq + tr_r) * 136 + 16 * wave + 4 * tr_c));
                            bf16x8 AX[4], AY[4]; u32x2 QY0[4], QY1[4]; f32x4 ELv4[8]; v4i16_t KX[8];
#pragma unroll
                            for (int ks = 0; ks < 4; ++ks) { AX[ks] = *(const LAS bf16x8*)(KT + fr * 136 + ks * 32 + fq * 8); AY[ks] = *(const LAS bf16x8*)(QT + fr * 136 + ks * 32 + fq * 8); }
#pragma unroll
                            for (int p = 0; p < 4; ++p) { QY0[p] = *(const LAS u32x2*)(QT + fr * 136 + 32 * p + 4 * fq); QY1[p] = *(const LAS u32x2*)(QT + fr * 136 + 32 * p + 16 + 4 * fq); }
#pragma unroll
                            for (int kt = 0; kt < 8; ++kt) { ELv4[kt] = *(const LAS f32x4*)(EL + 16 * kt + 4 * fq); KX[kt] = __builtin_amdgcn_ds_read_tr16_b64_v4i16((LAS v4i16_t*)(KB + (4 * fq + tr_r) * 136 + kt * 16 + 4 * tr_c)); }
                            __builtin_amdgcn_sched_barrier(0);
                            const bf16x8 IT = (bf16x8){itv[0], itv[1], itv[2], itv[3], 0, 0, 0, 0};
                            f32x4 A = (f32x4){0.f, 0.f, 0.f, 0.f};
#pragma unroll
                            for (int ks = 0; ks < 4; ++ks) A = __builtin_amdgcn_mfma_f32_16x16x32_bf16(AX[ks], AY[ks], A, 0, 0, 0);
#pragma unroll
                            for (int i = 0; i < 4; ++i) A[i] = (4 * fq + i > fr) ? 0.f : A[i];
                            const u32x4 apk = (u32x4){pk_bf16(A[0], A[1]), pk_bf16(A[2], A[3]), 0u, 0u};
                            f32x4 o = __builtin_amdgcn_mfma_f32_16x16x32_bf16(IT, __builtin_bit_cast(bf16x8, apk), (f32x4){0.f, 0.f, 0.f, 0.f}, 0, 0, 0);
#pragma unroll
                            for (int p = 0; p < 4; ++p) {
                                const u32x4 sx = (u32x4){pk_bf16(Sacc[2 * p][0], Sacc[2 * p][1]), pk_bf16(Sacc[2 * p][2], Sacc[2 * p][3]), pk_bf16(Sacc[2 * p + 1][0], Sacc[2 * p + 1][1]), pk_bf16(Sacc[2 * p + 1][2], Sacc[2 * p + 1][3])};
                                const u32x4 yy = (u32x4){QY0[p].x, QY0[p].y, QY1[p].x, QY1[p].y};
                                o = __builtin_amdgcn_mfma_f32_16x16x32_bf16(__builtin_bit_cast(bf16x8, sx), __builtin_bit_cast(bf16x8, yy), o, 0, 0, 0);
                            }
                            { u32x2 wv; wv.x = pk_bf16(o[0], o[1]); wv.y = pk_bf16(o[2], o[3]);
                              *(u32x2*)(mix + ((size_t)b * SEQ + blk * 16 + fr) * 1024 + 512 + h * 128 + 16 * wave + 4 * fq) = wv; }
#pragma unroll
                            for (int kt = 0; kt < 8; ++kt) {
                                const bf16x8 X = (bf16x8){KX[kt][0], KX[kt][1], KX[kt][2], KX[kt][3], 0, 0, 0, 0};
                                Sacc[kt] = __builtin_amdgcn_mfma_f32_16x16x32_bf16(X, IT, Sacc[kt] * ELv4[kt], 0, 0, 0);
                            }
                            if (wave >= 4 && blk + 1 < 256) { HG_ELEM(cur ^ 1); if (blk + 2 < 256) HG_LOAD(blk + 2); }
                            asm volatile("s_waitcnt lgkmcnt(0)" ::: "memory"); __builtin_amdgcn_s_barrier(); asm volatile("" ::: "memory");
                        }
#undef HG_LOAD
#undef HG_ELEM
                    }
                }
#endif
#if !defined(NO_CONV)
                {
                    LAS unsigned* hL32 = (LAS unsigned*)lds; LAS float* yL = (LAS float*)(lds + 65536);
                    const float* cw = ap->in[4] + (size_t)eo * 31 * 512; const float* cb = ap->in[5] + eo * 512;
                    const float* lng = ap->in[6] + eo * 512; const float* lnb = ap->in[7] + eo * 512;
                    const int cp = tid & 255, th = tid >> 8;
                    const bool split_ = (G >= 128);
                    for (int item = split_ ? vcu - 64 : vcu; item < 2048; item += split_ ? G - 64 : G) {
                        if (item < 0) break;
                        const int ritem = 2047 - item;
                        const int b = ritem >> 7, t0 = (ritem & 127) * 32;
                        {
                            u32x4 av[8], gv[8];
#pragma unroll
                            for (int q = 0; q < 8; ++q) {
                                const int idx = tid + 512 * q, r = idx >> 6, c8 = idx & 63, t = t0 - 30 + r;
                                av[q] = (u32x4){0u, 0u, 0u, 0u}; gv[q] = av[q];
                                if (idx < 62 * 64 && t >= 0) { const bf16_t* pr = pbuf + ((size_t)b * SEQ + t) * 3072 + c8 * 8; av[q] = *(const u32x4*)pr; gv[q] = *(const u32x4*)(pr + 512); }
                            }
#pragma unroll
                            for (int q = 0; q < 8; ++q) {
                                const int idx = tid + 512 * q, r = idx >> 6, c8 = idx & 63;
                                float a[8], g8[8]; unpack8(av[q], a); unpack8(gv[q], g8);
#pragma unroll
                                for (int i = 0; i < 8; ++i) a[i] *= sigmoidf_(g8[i]);
                                if (idx < 62 * 64) *(LAS u32x4*)(hL32 + r * 256 + c8 * 4) = pack8(a);
                            }
                        }
                        __syncthreads();
#pragma unroll 1
                        for (int sb = 0; sb < 2; ++sb) {
                            float y0[8], y1[8];
                            const float b0 = cb[2 * cp], b1 = cb[2 * cp + 1];
#pragma unroll
                            for (int t = 0; t < 8; ++t) { y0[t] = b0; y1[t] = b1; }
                            unsigned in[38];
#pragma unroll
                            for (int r = 0; r < 38; ++r) in[r] = hL32[(th * 16 + sb * 8 + r) * 256 + cp];
#pragma unroll
                            for (int j = 0; j < 31; ++j) {
                                const f32x2 wj = *(const f32x2*)(cw + j * 512 + 2 * cp);
#pragma unroll
                                for (int t = 0; t < 8; ++t) { y0[t] = __builtin_fmaf(wj.x, bf_lo(in[t + j]), y0[t]); y1[t] = __builtin_fmaf(wj.y, bf_hi(in[t + j]), y1[t]); }
                            }
#pragma unroll
                            for (int t = 0; t < 8; ++t) *(LAS f32x2*)(yL + (th * 16 + sb * 8 + t) * 512 + 2 * cp) = (f32x2){y0[t], y1[t]};
                        }
                        __syncthreads();
#pragma unroll
                        for (int q = 0; q < 4; ++q) {
                            const int tok = wave * 4 + q;
                            const f32x4 v0 = *(const LAS f32x4*)(yL + tok * 512 + lane * 8), v1 = *(const LAS f32x4*)(yL + tok * 512 + lane * 8 + 4);
                            float sm = (v0[0] + v0[1]) + (v0[2] + v0[3]) + (v1[0] + v1[1]) + (v1[2] + v1[3]);
                            sm = wave_sum(sm); const float mu = sm * (1.0f / 512.0f);
                            float f[8] = {v0[0] - mu, v0[1] - mu, v0[2] - mu, v0[3] - mu, v1[0] - mu, v1[1] - mu, v1[2] - mu, v1[3] - mu};
                            float sq = 0.f;
#pragma unroll
                            for (int i = 0; i < 8; ++i) sq += f[i] * f[i];
                            sq = wave_sum(sq); const float rstd = rsqrtf(sq * (1.0f / 512.0f) + EPSF);
#pragma unroll
                            for (int i = 0; i < 8; ++i) { const float yv = f[i] * rstd * lng[lane * 8 + i] + lnb[lane * 8 + i]; f[i] = yv * sigmoidf_(yv); }
                            *(u32x4*)(mix + ((size_t)b * SEQ + t0 + tok) * 1024 + lane * 8) = pack8(f);
                        }
                        __syncthreads();
                    }
                    if (split_ && vcu >= 64) {
                        LAS float* scr = (LAS float*)(lds + wave * 16384);
                        const int gw2 = (vcu - 64) * 8 + wave, NGW2 = (G - 64) * 8;
                        if (l == 0) { transpose_layer(ap, ws, 1, scr, gw2, NGW2, lane); transpose_layer(ap, ws, 2, scr, gw2, NGW2, lane); }
                        else transpose_layer(ap, ws, 3, scr, gw2, NGW2, lane);
                    }
                }
#endif
            } else if (s == 2 && !odd) {
                const int gw = vcu * 8 + wave, NGW = G * 8;
                const float* og = ap->in[9] + eo * 128;
                for (int m0 = gw * 4; m0 < NTOK; m0 += NGW * 4) {
                    u32x4 ov[4], gv[4];
#pragma unroll
                    for (int q = 0; q < 4; ++q) { ov[q] = *(const u32x4*)(mix + (size_t)(m0 + q) * 1024 + 512 + lane * 8); gv[q] = *(const u32x4*)(pbuf + (size_t)(m0 + q) * 3072 + 2560 + lane * 8); }
#pragma unroll
                    for (int q = 0; q < 4; ++q) {
                        float o[8], g8[8]; unpack8(ov[q], o); unpack8(gv[q], g8);
                        float ss = 0.f;
#pragma unroll
                        for (int i = 0; i < 8; ++i) ss += o[i] * o[i];
                        ss = row16_sum(ss);
                        const float rs = rsqrtf(ss * (1.0f / 128.0f) + EPSF);
                        const int c0 = (lane & 15) * 8;
#pragma unroll
                        for (int i = 0; i < 8; ++i) o[i] = o[i] * rs * og[c0 + i] * (g8[i] * sigmoidf_(g8[i]));
                        *(u32x4*)(mix + (size_t)(m0 + q) * 1024 + 512 + lane * 8) = pack8(o);
                    }
                }
            } else if (s == 1 && odd) {
#if !defined(NO_SGU)
                {
                    LAS bf16_t* VN = (LAS bf16_t*)lds;
                    const float* lng = ap->in[12] + eo * 512; const float* lnb = ap->in[13] + eo * 512;
                    const int wr = wave >> 2, wc = wave & 3, fr = lane & 15, fq = lane >> 4, tr_r = (lane & 15) >> 2, tr_c = lane & 3;
                    for (int item = vcu; item < 512; item += G) {
                        const int ritem = 511 - item;
                        const int b = ritem >> 5, n = ritem & 31;
                        const size_t row0 = (size_t)b * SEQ + n * 128;
                        const int sT = tid >> 2, qd = tid & 3;
                        {
                            const bf16_t* pr = pbuf + (row0 + sT) * 3328 + 512 + qd * 128;
                            float sm = 0.f, sq = 0.f;
#pragma unroll 4
                            for (int i = 0; i < 16; ++i) { const u32x4 rawv = *(const u32x4*)(pr + i * 8); float f[8]; unpack8(rawv, f);
#pragma unroll
                                for (int j = 0; j < 8; ++j) { sm += f[j]; sq += f[j] * f[j]; } }
                            sm += __shfl_xor(sm, 1); sm += __shfl_xor(sm, 2); sq += __shfl_xor(sq, 1); sq += __shfl_xor(sq, 2);
                            const float mu = sm * (1.0f / 512.0f); const float var = fmaxf(sq * (1.0f / 512.0f) - mu * mu, 0.f); const float rstd = rsqrtf(var + EPSF);
#pragma unroll 2
                            for (int i = 0; i < 16; ++i) { const u32x4 rawv = *(const u32x4*)(pr + i * 8); float f[8]; unpack8(rawv, f);
                                const f32x4 g0 = *(const f32x4*)(lng + qd * 128 + i * 8), g1 = *(const f32x4*)(lng + qd * 128 + i * 8 + 4);
                                const f32x4 b0 = *(const f32x4*)(lnb + qd * 128 + i * 8), b1 = *(const f32x4*)(lnb + qd * 128 + i * 8 + 4);
#pragma unroll
                                for (int j = 0; j < 4; ++j) { f[j] = (f[j] - mu) * rstd * g0[j] + b0[j]; f[4 + j] = (f[4 + j] - mu) * rstd * g1[j] + b1[j]; }
                                *(LAS u32x4*)(VN + sT * 520 + qd * 128 + i * 8) = pack8(f); }
                        }
                        asm volatile("s_waitcnt lgkmcnt(0)" ::: "memory"); __builtin_amdgcn_s_barrier(); asm volatile("" ::: "memory");
#pragma unroll 1
                        for (int gI = 0; gI < 4; ++gI) {
                            const float* wg = ap->in[14] + ((size_t)eo * 4 + gI) * 128 * 128; const float* bsg = ap->in[15] + (eo * 4 + gI) * 128;
                            f32x4 acc[4][2];
#pragma unroll
                            for (int m = 0; m < 4; ++m) { acc[m][0] = (f32x4){0.f, 0.f, 0.f, 0.f}; acc[m][1] = (f32x4){0.f, 0.f, 0.f, 0.f}; }
#pragma unroll
                            for (int k0 = 0; k0 < 128; k0 += 32) {
                                if (k0 <= wr * 64 + 63) {
                                    bf16x8 X[2];
#pragma unroll
                                    for (int nn = 0; nn < 2; ++nn) {
                                        const LAS bf16_t* vp = VN + (k0 + fq * 8 + tr_r) * 520 + gI * 128 + wc * 32 + nn * 16 + 4 * tr_c;
                                        const v4i16_t lo = __builtin_amdgcn_ds_read_tr16_b64_v4i16((LAS v4i16_t*)vp), hi = __builtin_amdgcn_ds_read_tr16_b64_v4i16((LAS v4i16_t*)(vp + 4 * 520));
                                        X[nn] = (bf16x8){lo[0], lo[1], lo[2], lo[3], hi[0], hi[1], hi[2], hi[3]};
                                    }
#pragma unroll
                                    for (int m = 0; m < 4; ++m) {
                                        if (k0 <= wr * 64 + m * 16 + 15) {
                                            const int t = wr * 64 + m * 16 + fr, s0 = k0 + fq * 8;
                                            const f32x4 w0 = *(const f32x4*)(wg + t * 128 + s0), w1 = *(const f32x4*)(wg + t * 128 + s0 + 4);
                                            float wf[8] = {w0[0], w0[1], w0[2], w0[3], w1[0], w1[1], w1[2], w1[3]};
#pragma unroll
                                            for (int i = 0; i < 8; ++i) wf[i] = (s0 + i <= t) ? wf[i] : 0.f;
                                            const u32x4 yp = pack8(wf); const bf16x8 Y = __builtin_bit_cast(bf16x8, yp);
                                            acc[m][0] = __builtin_amdgcn_mfma_f32_16x16x32_bf16(X[0], Y, acc[m][0], 0, 0, 0);
                                            acc[m][1] = __builtin_amdgcn_mfma_f32_16x16x32_bf16(X[1], Y, acc[m][1], 0, 0, 0);
                                        }
                                    }
                                }
                            }
#pragma unroll
                            for (int m = 0; m < 4; ++m) {
                                const int t = wr * 64 + m * 16 + fr; const float bias = bsg[t];
#pragma unroll
                                for (int nn = 0; nn < 2; ++nn) {
                                    const int c0 = wc * 32 + nn * 16 + 4 * fq;
                                    const u32x2 uv = *(const u32x2*)(pbuf + (row0 + t) * 3328 + gI * 128 + c0);
                                    const float o0 = bf_lo(uv.x) * (acc[m][nn][0] + bias), o1 = bf_hi(uv.x) * (acc[m][nn][1] + bias), o2 = bf_lo(uv.y) * (acc[m][nn][2] + bias), o3 = bf_hi(uv.y) * (acc[m][nn][3] + bias);
                                    u32x2 w; w.x = pk_bf16(o0, o1); w.y = pk_bf16(o2, o3);
                                    *(u32x2*)(mix + (row0 + t) * 1280 + gI * 128 + c0) = w;
                                }
                            }
                        }
                        asm volatile("s_waitcnt lgkmcnt(0)" ::: "memory"); __builtin_amdgcn_s_barrier(); asm volatile("" ::: "memory");
                    }
                }
#endif
#if !defined(NO_ATTN)
                {
                    LAS bf16_t* QL = (LAS bf16_t*)lds; LAS bf16_t* KL = (LAS bf16_t*)(lds + 18432); LAS bf16_t* VL = (LAS bf16_t*)(lds + 55296);
                    const int fr = lane & 15, fq = lane >> 4, tr_r = (lane & 15) >> 2, tr_c = lane & 3;
                    float gq16[16], gk16[16];
#pragma unroll
                    for (int i = 0; i < 16; ++i) { gq16[i] = ap->in[16][eo * 64 + (tid & 3) * 16 + i] * 0.125f; gk16[i] = ap->in[17][eo * 64 + (tid & 3) * 16 + i]; }
                    u32x4 rq[3][2], rv[4];
#pragma unroll
                    for (int i_ = 0; i_ < 3; ++i_) { rq[i_][0] = (u32x4){0u, 0u, 0u, 0u}; rq[i_][1] = (u32x4){0u, 0u, 0u, 0u}; }
#pragma unroll
                    for (int i_ = 0; i_ < 4; ++i_) rv[i_] = (u32x4){0u, 0u, 0u, 0u};
#define ATT_DECODE(it) const int rit_ = 6143 - (it); const int bj_ = rit_ / 96, q96_ = rit_ % 96, b = bj_ >> 2, j = bj_ & 3, cfg = q96_ >> 5, qq_ = q96_ & 31; \
                        const int sh = cfg * 2, r = (cfg == 0) ? 0 : (cfg == 1 ? (qq_ >> 3) : (qq_ >> 1)), n = (cfg == 0) ? qq_ : (cfg == 1 ? (qq_ & 7) : (qq_ & 1)); \
                        const int hd = cfg * 4 + j; const size_t rowb = (size_t)b * SEQ; (void)hd; (void)rowb; (void)n; (void)r; (void)sh;
#define ATT_LOAD(it) do { ATT_DECODE(it) \
                        _Pragma("unroll") for (int r3 = 0; r3 < 3; ++r3) { const int idx = tid + 512 * r3, rowi = idx >> 2, part = idx & 3; const bool isq = rowi < 128; \
                            const int sub = isq ? (n * 128 + rowi) : ((n - 1) * 128 + (rowi - 128)); const bool valid = sub >= 0; const int tok = valid ? ((sub << sh) + r) : 0; \
                            const bf16_t* src = pbuf + (rowb + tok) * 3328 + (isq ? 1024 : 1792) + hd * 64 + part * 16; \
                            rq[r3][0] = (u32x4){0u, 0u, 0u, 0u}; rq[r3][1] = rq[r3][0]; if (valid) { rq[r3][0] = *(const u32x4*)src; rq[r3][1] = *(const u32x4*)(src + 8); } } \
                        _Pragma("unroll") for (int r4 = 0; r4 < 4; ++r4) { const int idx = tid + 512 * r4, ks = idx >> 3, c8 = idx & 7; const int sub = (n - 1) * 128 + ks; \
                            rv[r4] = (u32x4){0u, 0u, 0u, 0u}; if (sub >= 0) rv[r4] = *(const u32x4*)(pbuf + (rowb + ((sub << sh) + r)) * 3328 + 2560 + hd * 64 + c8 * 8); } } while (0)
                    if (vcu < 6144) ATT_LOAD(vcu);
                    for (int item = vcu; item < 6144; item += G) {
                        ATT_DECODE(item)
#pragma unroll
                        for (int r3 = 0; r3 < 3; ++r3) {
                            const int idx = tid + 512 * r3, rowi = idx >> 2, part = idx & 3;
                            const bool isq = rowi < 128;
                            const int sub = isq ? (n * 128 + rowi) : ((n - 1) * 128 + (rowi - 128));
                            const int tok = (sub >= 0) ? ((sub << sh) + r) : 0;
                            float f[16]; unpack8(rq[r3][0], f); unpack8(rq[r3][1], f + 8);
                            float ss = 0.f;
#pragma unroll
                            for (int i = 0; i < 16; ++i) ss += f[i] * f[i];
                            ss += __shfl_xor(ss, 1); ss += __shfl_xor(ss, 2);
                            const float rs = rsqrtf(ss * (1.0f / 64.0f) + EPSF);
#pragma unroll
                            for (int i = 0; i < 16; ++i) f[i] = f[i] * rs * (r3 == 0 ? gq16[i] : gk16[i]);
                            if (part == 0) {
                                const float tf = (float)tok;
                                const float crev[8] = {0.15915494309189535f, 0.03086376340470123f, 0.005985185712713705f, 0.001160663641240061f, 0.00022507907903927653f, 4.364795279280289e-05f, 8.464330808241401e-06f, 1.6414262627950345e-06f};
#pragma unroll
                                for (int i = 0; i < 8; ++i) { const float rev = __builtin_amdgcn_fractf(tf * crev[i]); const float c = __builtin_amdgcn_cosf(rev), sn = __builtin_amdgcn_sinf(rev), x1 = f[i], x2 = f[8 + i]; f[i] = x1 * c - x2 * sn; f[8 + i] = x2 * c + x1 * sn; }
                            }
                            LAS bf16_t* dst = isq ? (QL + rowi * 72 + part * 16) : (KL + (rowi - 128) * 72 + part * 16);
                            *(LAS u32x4*)dst = pack8(f); *(LAS u32x4*)(dst + 8) = pack8(f + 8);
                        }
#pragma unroll
                        for (int r4 = 0; r4 < 4; ++r4) { const int idx = tid + 512 * r4, ks = idx >> 3, c8 = idx & 7; *(LAS u32x4*)(VL + ks * 72 + c8 * 8) = rv[r4]; }
                        if (item + G < 6144) ATT_LOAD(item + G);
                        asm volatile("s_waitcnt lgkmcnt(0)" ::: "memory"); __builtin_amdgcn_s_barrier(); asm volatile("" ::: "memory");
                        {
                            const int w = wave, qi = w * 16 + fr;
                            const bf16x8 Y0 = *(const LAS bf16x8*)(QL + qi * 72 + fq * 8), Y1 = *(const LAS bf16x8*)(QL + qi * 72 + 32 + fq * 8);
                            f32x4 sc[10];
                            {
                                bf16x8 KX0[9], KX1[9];
#pragma unroll
                                for (int jt = 0; jt < 9; ++jt) { const LAS bf16_t* kp = KL + ((w + jt) * 16 + fr) * 72 + fq * 8; KX0[jt] = *(const LAS bf16x8*)kp; KX1[jt] = *(const LAS bf16x8*)(kp + 32); }
                                __builtin_amdgcn_sched_barrier(0);
#pragma unroll
                                for (int jt = 0; jt < 9; ++jt) {
                                    f32x4 a = (f32x4){0.f, 0.f, 0.f, 0.f};
                                    a = __builtin_amdgcn_mfma_f32_16x16x32_bf16(KX0[jt], Y0, a, 0, 0, 0);
                                    a = __builtin_amdgcn_mfma_f32_16x16x32_bf16(KX1[jt], Y1, a, 0, 0, 0);
                                    sc[jt] = a;
                                }
                            }
                            float mx = -INFINITY;
#pragma unroll
                            for (int jt = 0; jt < 9; ++jt)
#pragma unroll
                                for (int i = 0; i < 4; ++i) {
                                    const int c = 4 * fq + i;
                                    bool ok = (n > 0) || (w + jt >= 8);
                                    if (jt == 0) ok = ok && (fr <= c);
                                    if (jt == 8) ok = ok && (fr >= c);
                                    const float v = ok ? sc[jt][i] : -INFINITY; sc[jt][i] = v; mx = fmaxf(mx, v);
                                }
                            mx = fmaxf(mx, __shfl_xor(mx, 16)); mx = fmaxf(mx, __shfl_xor(mx, 32));
                            float den = 0.f;
#pragma unroll
                            for (int jt = 0; jt < 9; ++jt)
#pragma unroll
                                for (int i = 0; i < 4; ++i) { const float e = __expf(sc[jt][i] - mx); sc[jt][i] = e; den += e; }
                            sc[9] = (f32x4){0.f, 0.f, 0.f, 0.f};
                            den += __shfl_xor(den, 16); den += __shfl_xor(den, 32);
                            f32x4 oa[4];
#pragma unroll
                            for (int et = 0; et < 4; ++et) oa[et] = (f32x4){0.f, 0.f, 0.f, 0.f};
                            v4i16_t VLO[5][4], VHI[5][4];
#pragma unroll
                            for (int jj = 0; jj < 5; ++jj) {
                                const int t0r = (w + 2 * jj) * 16, t1r = (jj < 4) ? (w + 2 * jj + 1) * 16 : t0r;
#pragma unroll
                                for (int et = 0; et < 4; ++et) {
                                    VLO[jj][et] = __builtin_amdgcn_ds_read_tr16_b64_v4i16((LAS v4i16_t*)(VL + (t0r + 4 * fq + tr_r) * 72 + et * 16 + 4 * tr_c));
                                    VHI[jj][et] = __builtin_amdgcn_ds_read_tr16_b64_v4i16((LAS v4i16_t*)(VL + (t1r + 4 * fq + tr_r) * 72 + et * 16 + 4 * tr_c));
                                }
                            }
                            __builtin_amdgcn_sched_barrier(0);
#pragma unroll
                            for (int jj = 0; jj < 5; ++jj) {
                                u32x4 pp; pp.x = pk_bf16(sc[2 * jj][0], sc[2 * jj][1]); pp.y = pk_bf16(sc[2 * jj][2], sc[2 * jj][3]); pp.z = pk_bf16(sc[2 * jj + 1][0], sc[2 * jj + 1][1]); pp.w = pk_bf16(sc[2 * jj + 1][2], sc[2 * jj + 1][3]);
                                const bf16x8 Pf = __builtin_bit_cast(bf16x8, pp);
#pragma unroll
                                for (int et = 0; et < 4; ++et) {
                                    const v4i16_t lo = VLO[jj][et], hi = VHI[jj][et];
                                    const bf16x8 xv = (bf16x8){lo[0], lo[1], lo[2], lo[3], hi[0], hi[1], hi[2], hi[3]};
                                    oa[et] = __builtin_amdgcn_mfma_f32_16x16x32_bf16(xv, Pf, oa[et], 0, 0, 0);
                                }
                            }
                            const float inv = 1.0f / den;
                            const int tokq = ((n * 128 + qi) << sh) + r;
                            bf16_t* op = mix + (rowb + tokq) * 1280 + 512 + hd * 64 + 4 * fq;
#pragma unroll
                            for (int et = 0; et < 4; ++et) { u32x2 wv; wv.x = pk_bf16(oa[et][0] * inv, oa[et][1] * inv); wv.y = pk_bf16(oa[et][2] * inv, oa[et][3] * inv); *(u32x2*)(op + et * 16) = wv; }
                            if (fq == 0) lse[(rowb + tokq) * 12 + hd] = mx + __logf(den);
                        }
                        asm volatile("s_waitcnt lgkmcnt(0)" ::: "memory"); __builtin_amdgcn_s_barrier(); asm volatile("" ::: "memory");
                    }
#undef ATT_LOAD
#undef ATT_DECODE
                }
#endif
            } else if (s == 2 && odd) {
                const int gw = vcu * 8 + wave, NGW = G * 8;
                for (int m0 = gw * 2; m0 < NTOK; m0 += NGW * 2) {
                    u32x4 v[2][2]; float al[2][2];
#pragma unroll
                    for (int q = 0; q < 2; ++q)
#pragma unroll
                        for (int c2 = 0; c2 < 2; ++c2) {
                            const int ch = lane + 64 * c2; v[q][c2] = (u32x4){0u, 0u, 0u, 0u}; al[q][c2] = 0.f;
                            if (ch < 96) {
                                const size_t m = (size_t)(m0 + q);
                                const int hd = ch >> 3, cfg = hd >> 2, j = hd & 3;
                                const float l0 = lse[m * 12 + j], l1 = lse[m * 12 + 4 + j], l2 = lse[m * 12 + 8 + j];
                                v[q][c2] = *(const u32x4*)(mix + m * 1280 + 512 + ch * 8);
                                const float mxl = fmaxf(l0, fmaxf(l1, l2));
                                const float e0 = __expf(l0 - mxl), e1 = __expf(l1 - mxl), e2 = __expf(l2 - mxl);
                                al[q][c2] = ((cfg == 0) ? e0 : (cfg == 1 ? e1 : e2)) / (e0 + e1 + e2);
                            }
                        }
#pragma unroll
                    for (int q = 0; q < 2; ++q)
#pragma unroll
                        for (int c2 = 0; c2 < 2; ++c2) {
                            const int ch = lane + 64 * c2;
                            if (ch < 96) { float f[8]; unpack8(v[q][c2], f);
#pragma unroll
                                for (int i = 0; i < 8; ++i) f[i] *= al[q][c2];
                                *(u32x4*)(mix + (size_t)(m0 + q) * 1280 + 512 + ch * 8) = pack8(f); }
                        }
                }
            } else if (s == 3) {
                const bf16_t* wt = odd ? (const bf16_t*)(ws + WS_ODWOUT) + (size_t)eo * 1024 * 1280 : (const bf16_t*)(ws + WS_EVWOUT) + (size_t)eo * 1024 * 1024;
                pg8::Gemm g{mix, wt, MW, MW, MW, 256, 4, 1, 1, 0, 0, 0, 0, 0};
                pg8::EpiR E{nullptr, xb, sx_xat, 0};
                pg8::gemm_phase<pg8::EpiR>(lds, tid, g, G, bx, E);
            } else if (s == 4) {
                pg8::Gemm g{xb, (const bf16_t*)(ws + WS_WQ) + (size_t)l * 1024 * 1024, 1024, 1024, 1024, 256, 4, 1, 1, 0, 0, 0, 0, 0};
                pg8::EpiP E{(bf16_t*)(ws + WS_QX), 1024, NTOK, sx_xat, 1.0f / (1024.0f * SC_SS), 0, qst, 4, 1, 0};
                pg8::gemm_phase<pg8::EpiP>(lds, tid, g, G, bx, E);
            } else if (s == 5) {
                pg8::Gemm g{(const bf16_t*)(ws + WS_QX), (const bf16_t*)(ws + WS_KT) + (size_t)l * 4096 * 1024, 1024, 1024, 256, 16, 1, 64, 4, SEQ * 1024, 256, 256 * 1024, 256, 0};
                pg8::EpiS E{(bf16_t*)(ws + WS_PB), qst, (LAS float*)(lds + 131072)};
                pg8::gemm_phase<pg8::EpiS>(lds, tid, g, G, bx, E);
            } else if (s == 7) {
                pg8::Gemm g{(const bf16_t*)(ws + WS_PB), (const bf16_t*)(ws + WS_VP), 1024, 1024, 1024, 16, 4, 16, 1, SEQ * 1024, 0, 1024 * 1024, 0, 0};
                pg8::EpiR E{nullptr, xb, sx_mlp, SEQ};
                pg8::gemm_phase<pg8::EpiR>(lds, tid, g, G, bx, E);
            } else if (s == 8) {
                pg8::Gemm g{xb, (const bf16_t*)(ws + WS_W1) + (size_t)l * 4096 * 1024, 1024, 1024, 1024, 256, 16, 1, 1, 0, 0, 0, 0, 0};
                pg8::EpiP E{(bf16_t*)(ws + WS_HMID), 4096, NTOK, sx_mlp, 1.0f / (1024.0f * SC_SS), 2, nullptr, 0, 1, 0};
                pg8::gemm_phase<pg8::EpiP>(lds, tid, g, G, bx, E);
            } else {
                pg8::Gemm g{(const bf16_t*)(ws + WS_HMID), (const bf16_t*)(ws + WS_W2) + (size_t)l * 1024 * 4096, 4096, 4096, 4096, 256, 4, 1, 1, 0, 0, 0, 0, 1};
                pg8::EpiR E{(l == 3) ? ap->out : nullptr, xb, (l == 3) ? (u64*)(ws + ST_QST) : sx_next, 0};
                pg8::gemm_phase<pg8::EpiR>(lds, tid, g, G, bx, E);
            }
        }
        }
        if (ph + 1 < args.hi) { if (ph == 0) cg::this_grid().sync(); else xcd_barrier((unsigned*)(ws + ST_BAR), xcc, xst); }
    }
}

constexpr int N_PHASES = 43;
extern "C" void kernel_launch(void* const* d_in, const int* in_sizes, int n_in, void* d_out, int out_size, void* d_ws, size_t ws_size, hipStream_t stream) {
    static int grid = 0;
    if (grid == 0) {
        if (n_in != 29 || ws_size < WS_END) { fprintf(stderr, "kernel_launch: need 29 inputs and %zu bytes of workspace; got %d, %zu\n", (size_t)WS_END, n_in, ws_size); grid = -1; return; }
        int dev = 0, cus = 0, per_cu = 0;
        hipGetDevice(&dev); hipDeviceGetAttribute(&cus, hipDeviceAttributeMultiprocessorCount, dev);
        if (hipFuncSetAttribute((const void*)mk_fwd, hipFuncAttributeMaxDynamicSharedMemorySize, LDS_BYTES) != hipSuccess) { fprintf(stderr, "kernel_launch: hipFuncSetAttribute failed\n"); grid = -1; return; }
        if (hipOccupancyMaxActiveBlocksPerMultiprocessor(&per_cu, (const void*)mk_fwd, 512, LDS_BYTES) != hipSuccess || per_cu < 1) per_cu = 1;
        (void)hipGetLastError();
        grid = cus * per_cu;
        fprintf(stderr, "kernel_launch: grid %d (cus %d x %d)\n", grid, cus, per_cu);
    }
    if (grid < 0) return;
    Args a{};
    for (int i = 0; i < 29; ++i) a.in[i] = (const float*)d_in[i];
    a.out = (float*)d_out; a.ws = (unsigned char*)d_ws;
#if MK_MULTI
    for (int ph = 0; ph < N_PHASES; ++ph) { a.lo = ph; a.hi = ph + 1; hipLaunchKernelGGL(mk_fwd, dim3(grid), dim3(512), LDS_BYTES, stream, a); }
#else
    a.lo = 0; a.hi = N_PHASES;
    if (hipMemsetAsync((char*)d_ws + ST_BAR, 0, 16384, stream) != hipSuccess) { fprintf(stderr, "kernel_launch: memset failed\n"); return; }
    void* kargs[] = {&a};
    hipError_t e = hipLaunchCooperativeKernel((const void*)mk_fwd, dim3(grid), dim3(512), kargs, LDS_BYTES, stream);
    if (e != hipSuccess) fprintf(stderr, "cooperative launch failed: %s (grid %d)\n", hipGetErrorString(e), grid);
#endif
}
```

```cpp
#include <hip/hip_runtime.h>
#include <hip/hip_cooperative_groups.h>
#include <cstdio>
#include <cstdint>
namespace cg = cooperative_groups;

#ifndef MK_MULTI
#define MK_MULTI 0
#endif

#define LAS __attribute__((address_space(3)))
typedef unsigned short bf16_t;
typedef short bf16x8 __attribute__((ext_vector_type(8)));
typedef float f32x4 __attribute__((ext_vector_type(4)));
typedef float f32x2 __attribute__((ext_vector_type(2)));
typedef unsigned u32x4 __attribute__((ext_vector_type(4)));
typedef unsigned u32x2 __attribute__((ext_vector_type(2)));
typedef __bf16 bf16x2_t __attribute__((ext_vector_type(2)));
typedef short v4i16_t __attribute__((ext_vector_type(4)));

constexpr int NTOK = 65536, DM = 1024, SEQ = 4096, NBATCH = 16;
constexpr float EPSF = 1e-6f;
constexpr size_t MiB = 1u << 20;
typedef unsigned long long u64;
constexpr float SC_SS = 1048576.0f, SC_L = 16777216.0f;
constexpr size_t ST_SXZ = 0;
constexpr size_t ST_QST = 11 * 512 * 1024;
constexpr size_t ST_LSUM = ST_QST + 8 * MiB;
constexpr size_t ST_KST = ST_LSUM + 8 * MiB;
constexpr size_t ST_ZERO_BYTES = ST_KST + 1 * MiB;
constexpr size_t ST_SX0 = ST_ZERO_BYTES;
constexpr size_t ST_SMEM = ST_SX0 + 512 * 1024;
constexpr size_t ST_BAR = ST_SX0 + 768 * 1024;
constexpr size_t ST_LSE = 24 * MiB;
constexpr size_t ST_ROPE = 27 * MiB;
constexpr size_t WB = 16 * MiB;
constexpr size_t WS_EVWIN = WB + 16 * MiB, WS_ODWIN = WB + 28 * MiB, WS_EVWOUT = WB + 41 * MiB, WS_ODWOUT = WB + 45 * MiB, WS_WQ = WB + 50 * MiB, WS_WKV = WB + 58 * MiB,
                 WS_WO = WB + 74 * MiB, WS_W1 = WB + 82 * MiB, WS_W2 = WB + 114 * MiB, WS_MEMB = WB + 146 * MiB, WS_KT = WB + 154 * MiB, WS_VT = WB + 186 * MiB, WS_XB = WB + 218 * MiB,
                 WS_A = WB + 346 * MiB;
constexpr size_t WS_P = WS_A, WS_MIX = WS_A + 416 * MiB, WS_KVRAW = WS_A, WS_QX = WS_A, WS_PB = WS_A + 128 * MiB, WS_AO = WS_A + 256 * MiB, WS_HMID = WS_A;
constexpr size_t WS_VP = WS_A + 576 * MiB;
constexpr size_t WS_END = WS_VP + 32 * MiB;
constexpr int LDS_BYTES = 147456;

__device__ __forceinline__ unsigned pk_bf16(float lo, float hi) { f32x2 v = {lo, hi}; bf16x2_t b = __builtin_convertvector(v, bf16x2_t); return __builtin_bit_cast(unsigned, b); }
__device__ __forceinline__ float bf_lo(unsigned u) { return __uint_as_float(u << 16); }
__device__ __forceinline__ float bf_hi(unsigned u) { return __uint_as_float(u & 0xffff0000u); }
__device__ __forceinline__ void unpack8(const u32x4 v, float* f) { f[0] = bf_lo(v.x); f[1] = bf_hi(v.x); f[2] = bf_lo(v.y); f[3] = bf_hi(v.y); f[4] = bf_lo(v.z); f[5] = bf_hi(v.z); f[6] = bf_lo(v.w); f[7] = bf_hi(v.w); }
__device__ __forceinline__ u32x4 pack8(const float* f) { u32x4 w; w.x = pk_bf16(f[0], f[1]); w.y = pk_bf16(f[2], f[3]); w.z = pk_bf16(f[4], f[5]); w.w = pk_bf16(f[6], f[7]); return w; }
__device__ __forceinline__ float sigmoidf_(float x) { return __builtin_amdgcn_rcpf(1.0f + __expf(-x)); }
__device__ __forceinline__ float wave_sum(float v) {
#pragma unroll
    for (int o = 1; o < 64; o <<= 1) v += __shfl_xor(v, o);
    return v;
}
template <int CTRL> __device__ __forceinline__ float dppf(float v) { return __int_as_float(__builtin_amdgcn_update_dpp(0, __float_as_int(v), CTRL, 0xf, 0xf, true)); }
__device__ __forceinline__ float row16_sum(float v) { v += dppf<0x128>(v); v += dppf<0x124>(v); v += dppf<0x122>(v); v += dppf<0x121>(v); return v; }
__device__ __forceinline__ f32x2 gelu_pk(f32x2 v) {
    const f32x2 av = __builtin_elementwise_abs(v), d = av * 0.2316418882f + 1.0f;
    f32x2 t; t.x = __builtin_amdgcn_rcpf(d.x); t.y = __builtin_amdgcn_rcpf(d.y);
    f32x2 q = t * 0.5307027145f + (-0.7265760135f); q = q * t + 0.7107068705f; q = q * t + (-0.142248368f); q = q * t + 0.127414796f; q = q * t;
    const f32x2 s = (v * v) * (-0.72134752044f);
    f32x2 e; e.x = __builtin_amdgcn_exp2f(s.x); e.y = __builtin_amdgcn_exp2f(s.y);
    const f32x2 m = v * (q * e), r = v - m;
    f32x2 o; o.x = v.x < 0.f ? m.x : r.x; o.y = v.y < 0.f ? m.y : r.y; return o;
}

namespace pg8 {
constexpr int BM = 256, BK = 64, HALF = 128, HTB = HALF * BK * 2, STAGE_BYTES = 8 * HTB, WGM = 8;
__host__ __device__ __forceinline__ int lds_byte(int r, int c) { const int st = (r >> 4) * 2 + (c >> 5), rr = r & 15, cc = c & 31, ob = rr * 64 + cc * 2; return st * 1024 + (ob ^ (((ob >> 9) & 1) << 5)); }
__host__ __device__ __forceinline__ void stage_rc(int b, int& R, int& C) { const int st = b / 1024, sb = b % 1024, swz = sb ^ (((sb >> 9) & 1) << 5); R = (st >> 1) * 16 + swz / 64; C = (st & 1) * 32 + (swz % 64) / 2; }
__host__ __device__ __forceinline__ int perm32(int rho) { const int n = rho >> 4, i = rho & 15; return 8 * (i >> 2) + 4 * n + (i & 3); }

struct Unit { int pm, pn, z; };
struct Gemm { const bf16_t* A; const bf16_t* Bt; int lda, ldb, K, nM, nN, nZ, ZL; int sAh, sAl, sBh, sBl; int rev; };
struct Order {
    int nM, nN, per, nwg, G, c, rev;
    __device__ __forceinline__ void init(const Gemm& g, int G_, int c_) { nM = g.nM; nN = g.nN; per = nM * nN; nwg = per * g.nZ; G = G_; c = c_; rev = g.rev; }
    __device__ __forceinline__ bool next(int i, Unit& u) const {
        const long L = (long)i * G + c; if (L >= nwg) return false;
        int w = (int)L;
        if ((nwg & 7) == 0) { const int ch = nwg >> 3, off = w >> 3; w = (w & 7) * ch + (rev ? ch - 1 - off : off); }
        u.z = w / per; const int t = w % per;
        const int nig = WGM * nN, gid = t / nig, fm = gid * WGM, gsz = (nM - fm) < WGM ? (nM - fm) : WGM;
        u.pm = fm + ((t % nig) % gsz); u.pn = (t % nig) / gsz; return true;
    }
};
__device__ __forceinline__ const char* a_ptr(const Gemm& g, const Unit& u) { return (const char*)(g.A + ((u.z / g.ZL) * g.sAh + (u.z % g.ZL) * g.sAl + u.pm * BM * g.lda)); }
__device__ __forceinline__ const char* b_ptr(const Gemm& g, const Unit& u) { return (const char*)(g.Bt + ((u.z / g.ZL) * g.sBh + (u.z % g.ZL) * g.sBl + u.pn * BM * g.ldb)); }

struct EpiP {
    static constexpr bool PERM = true;
    bf16_t* O; int ldc; int Mz; const u64* rstat; float rinv; int act; u64* hstat; int hs_ld; int ZLo; int zcol;
    __device__ __forceinline__ void operator()(f32x4 (&acc)[2][2][4][2], const Unit& u, int wr, int wc, int fr, int fq) const {
        const int row0 = u.pm * BM + wr * 64 + fr, col0 = u.pn * BM + wc * 32 + 8 * fq;
        const bool do_gelu = (act == 1) && (u.pn < 4);
        float rsv[8];
#pragma unroll
        for (int q = 0; q < 8; ++q) rsv[q] = 1.f;
        if (rstat) {
            u64 sv[8];
#pragma unroll
            for (int q = 0; q < 8; ++q) sv[q] = rstat[row0 + (q >> 2) * HALF + (q & 3) * 16];
#pragma unroll
            for (int q = 0; q < 8; ++q) rsv[q] = rsqrtf((float)sv[q] * rinv + EPSF);
        }
        asm volatile("" ::: "memory");
#pragma unroll
        for (int ai = 0; ai < 2; ++ai)
#pragma unroll
            for (int m = 0; m < 4; ++m) {
                const int row = row0 + ai * HALF + m * 16;
                const float rs = rsv[ai * 4 + m];
                float hs = 0.f;
                bf16_t* rowp = O + ((long)(u.z / ZLo) * Mz + row) * ldc + (u.z % ZLo) * zcol + col0;
#pragma unroll
                for (int bj = 0; bj < 2; ++bj) {
                    f32x4 v0 = acc[ai][bj][m][0] * rs, v1 = acc[ai][bj][m][1] * rs;
                    if (do_gelu) { f32x2 a = gelu_pk((f32x2){v0[0], v0[1]}), b = gelu_pk((f32x2){v0[2], v0[3]}), c = gelu_pk((f32x2){v1[0], v1[1]}), d = gelu_pk((f32x2){v1[2], v1[3]});
                        v0 = (f32x4){a.x, a.y, b.x, b.y}; v1 = (f32x4){c.x, c.y, d.x, d.y}; }
                    else if (act == 2) {
#pragma unroll
                        for (int i = 0; i < 4; ++i) { const float a = fmaxf(v0[i], 0.f), b = fmaxf(v1[i], 0.f); v0[i] = a * a; v1[i] = b * b; } }
                    hs += (v0[0] * v0[0] + v0[1] * v0[1]) + (v0[2] * v0[2] + v0[3] * v0[3]) + (v1[0] * v1[0] + v1[1] * v1[1]) + (v1[2] * v1[2] + v1[3] * v1[3]);
                    u32x4 w; w.x = pk_bf16(v0[0], v0[1]); w.y = pk_bf16(v0[2], v0[3]); w.z = pk_bf16(v1[0], v1[1]); w.w = pk_bf16(v1[2], v1[3]);
                    *(u32x4*)(rowp + bj * HALF) = w;
                }
                if (hstat) { hs += __shfl_xor(hs, 16); hs += __shfl_xor(hs, 32); if (fq == 0) atomicAdd(hstat + ((long)u.z * Mz + row) * hs_ld + u.pn, (u64)(hs * SC_SS + 0.5f)); }
            }
    }
};
struct EpiS {
    static constexpr bool PERM = true;
    bf16_t* P; const u64* qstat; LAS float* xch;
    __device__ __forceinline__ void operator()(f32x4 (&acc)[2][2][4][2], const Unit& u, int wr, int wc, int fr, int fq) const {
        const int b = u.z >> 2, h = u.z & 3;
        const int row0 = b * SEQ + u.pm * BM + wr * 64 + fr, col0 = h * 256 + wc * 32 + 8 * fq;
        float rsv[8];
        { u64 sv[8];
#pragma unroll
          for (int q = 0; q < 8; ++q) sv[q] = qstat[(long)(row0 + (q >> 2) * HALF + (q & 3) * 16) * 4 + h];
#pragma unroll
          for (int q = 0; q < 8; ++q) rsv[q] = rsqrtf((float)sv[q] * (1.0f / (256.0f * SC_SS)) + EPSF) * 1.4426950408889634f; }
#pragma unroll
        for (int ai = 0; ai < 2; ++ai)
#pragma unroll
            for (int m = 0; m < 4; ++m) {
                const int rl = ai * HALF + wr * 64 + m * 16 + fr;
                const float rs = rsv[ai * 4 + m];
                float sum = 0.f;
#pragma unroll
                for (int bj = 0; bj < 2; ++bj)
#pragma unroll
                    for (int n = 0; n < 2; ++n)
#pragma unroll
                        for (int i = 0; i < 4; ++i) { const float e = __builtin_amdgcn_exp2f(acc[ai][bj][m][n][i] * rs); acc[ai][bj][m][n][i] = e; sum += e; }
                sum += __shfl_xor(sum, 16); sum += __shfl_xor(sum, 32);
                if (fq == 0) xch[rl * 4 + wc] = sum;
            }
        asm volatile("s_waitcnt lgkmcnt(0)" ::: "memory"); __builtin_amdgcn_s_barrier(); asm volatile("" ::: "memory");
#pragma unroll
        for (int ai = 0; ai < 2; ++ai)
#pragma unroll
            for (int m = 0; m < 4; ++m) {
                const int row = row0 + ai * HALF + m * 16, rl = ai * HALF + wr * 64 + m * 16 + fr;
                const f32x4 t = *(const LAS f32x4*)(xch + rl * 4);
                const float inv = 1.0f / ((t[0] + t[1]) + (t[2] + t[3]));
                bf16_t* rowp = P + (long)row * 1024 + col0;
#pragma unroll
                for (int bj = 0; bj < 2; ++bj) {
                    const f32x4 v0 = acc[ai][bj][m][0] * inv, v1 = acc[ai][bj][m][1] * inv;
                    u32x4 w; w.x = pk_bf16(v0[0], v0[1]); w.y = pk_bf16(v0[2], v0[3]); w.z = pk_bf16(v1[0], v1[1]); w.w = pk_bf16(v1[2], v1[3]);
                    *(u32x4*)(rowp + bj * HALF) = w;
                }
            }
    }
};
struct EpiO {
    static constexpr bool PERM = true;
    bf16_t* O; const u64* lsum;
    __device__ __forceinline__ void operator()(f32x4 (&acc)[2][2][4][2], const Unit& u, int wr, int wc, int fr, int fq) const {
        const int b = u.z >> 2, h = u.z & 3;
        const int row0 = b * SEQ + u.pm * BM + wr * 64 + fr, col0 = h * 256 + wc * 32 + 8 * fq;
#pragma unroll
        for (int ai = 0; ai < 2; ++ai)
#pragma unroll
            for (int m = 0; m < 4; ++m) {
                const int row = row0 + ai * HALF + m * 16;
                const float inv = SC_L / (float)lsum[(long)row * 4 + h];
                bf16_t* rowp = O + (long)row * 1024 + col0;
#pragma unroll
                for (int bj = 0; bj < 2; ++bj) {
                    const f32x4 v0 = acc[ai][bj][m][0] * inv, v1 = acc[ai][bj][m][1] * inv;
                    u32x4 w; w.x = pk_bf16(v0[0], v0[1]); w.y = pk_bf16(v0[2], v0[3]); w.z = pk_bf16(v1[0], v1[1]); w.w = pk_bf16(v1[2], v1[3]);
                    *(u32x4*)(rowp + bj * HALF) = w;
                }
            }
    }
};
struct EpiR {
    static constexpr bool PERM = true;
    float* out; bf16_t* xb; u64* stat; int Mz;
    __device__ __forceinline__ bool can_repeat() const { return false; }
    __device__ __forceinline__ void operator()(f32x4 (&acc)[2][2][4][2], const Unit& u, int wr, int wc, int fr, int fq) const {
        const int row0 = u.z * Mz + u.pm * BM + wr * 64 + fr, col0 = u.pn * BM + wc * 32 + 8 * fq;
#pragma unroll
        for (int ai = 0; ai < 2; ++ai) {
            u32x4 xv[4][2];
#pragma unroll
            for (int m = 0; m < 4; ++m)
#pragma unroll
                for (int bj = 0; bj < 2; ++bj) xv[m][bj] = *(const u32x4*)(xb + (size_t)(row0 + ai * HALF + m * 16) * DM + col0 + bj * HALF);
            asm volatile("" ::: "memory");
#pragma unroll
            for (int m = 0; m < 4; ++m) {
                const int row = row0 + ai * HALF + m * 16; const size_t off = (size_t)row * DM + col0;
                float ss = 0.f;
#pragma unroll
                for (int bj = 0; bj < 2; ++bj) {
                    float f[8]; unpack8(xv[m][bj], f);
#pragma unroll
                    for (int i = 0; i < 4; ++i) { f[i] += acc[ai][bj][m][0][i]; f[4 + i] += acc[ai][bj][m][1][i]; }
#pragma unroll
                    for (int i = 0; i < 8; ++i) ss += f[i] * f[i];
                    *(u32x4*)(xb + off + bj * HALF) = pack8(f);
                    if (out) { *(f32x4*)(out + off + bj * HALF) = (f32x4){f[0], f[1], f[2], f[3]}; *(f32x4*)(out + off + bj * HALF + 4) = (f32x4){f[4], f[5], f[6], f[7]}; }
                }
                ss += __shfl_xor(ss, 16); ss += __shfl_xor(ss, 32);
                if (fq == 0) atomicAdd(stat + row, (u64)(ss * SC_SS + 0.5f));
            }
        }
    }
};

template <class Epi>
__device__ __forceinline__ void gemm_phase(LAS unsigned char* lds, const int tid, const Gemm g, const int G, const int cidx, const Epi& E) {
    const int wid = __builtin_amdgcn_readfirstlane(tid >> 6), lane = tid & 63, wr = wid >> 2, wc = wid & 3, fr = lane & 15, fq = lane >> 4;
    Order S; S.init(g, G, cidx);
    const int K = g.K, nt = K / BK;
    unsigned voffA[2], voffB[2];
#pragma unroll
    for (int i = 0; i < 2; ++i) { int R, C; stage_rc(tid * 16 + i * 8192, R, C); const int Rb = Epi::PERM ? ((R & ~31) + perm32(R & 31)) : R;
        voffA[i] = (unsigned)(R * g.lda + C) * 2u; voffB[i] = (unsigned)(Rb * g.ldb + C) * 2u; }
    const size_t kstep = (size_t)(BK * 2);
    const size_t hstepA = (size_t)HALF * g.lda * 2, hstepB = (size_t)HALF * g.ldb * 2;
    const unsigned ldsw = (unsigned)wid * 1024u;
    const int aoff = lds_byte(wr * 64 + fr, fq * 8), boff = lds_byte(wc * 32 + fr, fq * 8);
#define PG8_SA(b, h) (((b) * 2 + (h)) * HTB)
#define PG8_SB(b, h) ((4 + (b) * 2 + (h)) * HTB)
#define PG8_STAGE(bufoff, gbase, voff) do { _Pragma("unroll") for (int _i = 0; _i < 2; ++_i) \
        __builtin_amdgcn_global_load_lds((const unsigned*)((const char*)(gbase) + (voff)[_i]), (LAS unsigned*)(lds + (bufoff) + ldsw + _i * 8192), 16, 0, 0); } while (0)
#define PG8_LDA(dst, b, h) do { _Pragma("unroll") for (int m = 0; m < 4; ++m) _Pragma("unroll") for (int k = 0; k < 2; ++k) dst[m][k] = *(const LAS bf16x8*)(lds + PG8_SA(b, h) + aoff + m * 2048 + k * 1024); } while (0)
#define PG8_LDB(dst, b, h) do { _Pragma("unroll") for (int n = 0; n < 2; ++n) _Pragma("unroll") for (int k = 0; k < 2; ++k) dst[n][k] = *(const LAS bf16x8*)(lds + PG8_SB(b, h) + boff + n * 2048 + k * 1024); } while (0)
#define PG8_MMA(ai, bj, At, Bt) do { __builtin_amdgcn_s_setprio(1); _Pragma("unroll") for (int m = 0; m < 4; ++m) _Pragma("unroll") for (int n = 0; n < 2; ++n) _Pragma("unroll") for (int k = 0; k < 2; ++k) \
        acc[ai][bj][m][n] = __builtin_amdgcn_mfma_f32_16x16x32_bf16(Bt[n][k], At[m][k], acc[ai][bj][m][n], 0, 0, 0); __builtin_amdgcn_s_setprio(0); } while (0)
#define PG8_WAIT_V(n) asm volatile("s_waitcnt vmcnt(" #n ")" ::: "memory")
#define PG8_WAIT_L(n) asm volatile("s_waitcnt lgkmcnt(" #n ")" ::: "memory")
#define PG8_BAR __builtin_amdgcn_s_barrier()
#define PG8_SCHED __builtin_amdgcn_sched_barrier(0)
    Unit cur, nxt; int ui = 0;
    if (!S.next(0, cur)) return;
    f32x4 acc[2][2][4][2];
#pragma unroll
    for (int a = 0; a < 2; ++a)
#pragma unroll
        for (int b = 0; b < 2; ++b)
#pragma unroll
            for (int m = 0; m < 4; ++m)
#pragma unroll
                for (int n = 0; n < 2; ++n) acc[a][b][m][n] = (f32x4){0.f, 0.f, 0.f, 0.f};
    bf16x8 At[4][2], B0[2][2], B1[2][2];
    const char* cA = a_ptr(g, cur); const char* cB = b_ptr(g, cur);
    PG8_STAGE(PG8_SB(0, 0), cB, voffB); PG8_STAGE(PG8_SB(0, 1), cB + hstepB, voffB); PG8_STAGE(PG8_SA(0, 0), cA, voffA); PG8_STAGE(PG8_SA(0, 1), cA + hstepA, voffA);
    if (wr == 1) PG8_BAR;
    PG8_WAIT_V(2); PG8_BAR;
    PG8_STAGE(PG8_SB(1, 0), cB + kstep, voffB); PG8_STAGE(PG8_SA(1, 0), cA + kstep, voffA); PG8_STAGE(PG8_SB(1, 1), cB + hstepB + kstep, voffB);
    PG8_WAIT_V(6); PG8_BAR;
    for (;;) {
        const bool has_next = S.next(ui + 1, nxt);
        const char* nA = has_next ? a_ptr(g, nxt) : cA; const char* nB = has_next ? b_ptr(g, nxt) : cB;
        for (int t = 0; t < nt; t += 2) {
            const bool last = (t == nt - 2);
            const char* a1 = cA + (size_t)(t + 1) * kstep;
            const char* a2 = last ? nA : cA + (size_t)(t + 2) * kstep; const char* b2 = last ? nB : cB + (size_t)(t + 2) * kstep;
            const char* a3 = a2 + kstep; const char* b3 = b2 + kstep;
            PG8_LDB(B0, 0, 0); PG8_LDB(B1, 0, 1); PG8_SCHED; PG8_LDA(At, 0, 0); PG8_STAGE(PG8_SA(1, 1), a1 + hstepA, voffA);
            PG8_WAIT_V(8); PG8_WAIT_L(0); PG8_BAR; PG8_MMA(0, 0, At, B0); PG8_MMA(0, 1, At, B1); PG8_BAR; PG8_SCHED;
            PG8_LDA(At, 0, 1); PG8_STAGE(PG8_SB(0, 0), b2, voffB); PG8_STAGE(PG8_SB(0, 1), b2 + hstepB, voffB); PG8_STAGE(PG8_SA(0, 0), a2, voffA);
            PG8_WAIT_V(8); PG8_WAIT_L(0); PG8_BAR; PG8_MMA(1, 0, At, B0); PG8_MMA(1, 1, At, B1); PG8_BAR; PG8_SCHED;
            PG8_LDB(B0, 1, 0); PG8_LDB(B1, 1, 1); PG8_SCHED; PG8_LDA(At, 1, 0); PG8_STAGE(PG8_SA(0, 1), a2 + hstepA, voffA);
            PG8_WAIT_V(8); PG8_WAIT_L(0); PG8_BAR; PG8_MMA(0, 0, At, B0); PG8_MMA(0, 1, At, B1); PG8_BAR; PG8_SCHED;
            PG8_LDA(At, 1, 1); PG8_STAGE(PG8_SB(1, 0), b3, voffB); PG8_STAGE(PG8_SB(1, 1), b3 + hstepB, voffB); PG8_STAGE(PG8_SA(1, 0), a3, voffA);
            PG8_WAIT_V(8); PG8_WAIT_L(0); PG8_BAR; PG8_MMA(1, 0, At, B0); PG8_MMA(1, 1, At, B1); PG8_BAR; PG8_SCHED;
        }
        if (wr == 0) PG8_BAR;
        E(acc, cur, wr, wc, fr, fq);
        if (!has_next) break;
#pragma unroll
        for (int a = 0; a < 2; ++a)
#pragma unroll
            for (int b = 0; b < 2; ++b)
#pragma unroll
                for (int m = 0; m < 4; ++m)
#pragma unroll
                    for (int n = 0; n < 2; ++n) acc[a][b][m][n] = (f32x4){0.f, 0.f, 0.f, 0.f};
        cur = nxt; cA = nA; cB = nB; ++ui;
        if (wr == 1) PG8_BAR;
    }
    PG8_WAIT_V(0);
    PG8_BAR;
#undef PG8_SA
#undef PG8_SB
#undef PG8_STAGE
#undef PG8_LDA
#undef PG8_LDB
#undef PG8_MMA
#undef PG8_WAIT_V
#undef PG8_WAIT_L
#undef PG8_BAR
#undef PG8_SCHED
}
}

struct Args { const float* in[29]; float* out; unsigned char* ws; int lo, hi; };

__device__ __forceinline__ void transpose_item(const float* W, int K, int N, const float* gain, bf16_t* WT, LAS float* scr, int item, int lane) {
    const int nblk = N / 32, kb = item / nblk, nb = item % nblk, k0 = 64 * kb, n0 = 32 * nb;
#pragma unroll 8
    for (int i = 0; i < 32; ++i) { const int kk = 2 * i + (lane >> 5); float v = W[(size_t)(k0 + kk) * N + n0 + (lane & 31)]; if (gain) v *= gain[k0 + kk]; scr[kk * 33 + (lane & 31)] = v; }
    asm volatile("s_waitcnt lgkmcnt(0)" ::: "memory");
    const int c = lane & 7;
#pragma unroll
    for (int j = 0; j < 4; ++j) { const int n = (lane >> 3) + 8 * j; const LAS float* s = scr + (8 * c) * 33 + n;
        u32x4 o; o.x = pk_bf16(s[0 * 33], s[1 * 33]); o.y = pk_bf16(s[2 * 33], s[3 * 33]); o.z = pk_bf16(s[4 * 33], s[5 * 33]); o.w = pk_bf16(s[6 * 33], s[7 * 33]);
        *(u32x4*)(WT + (size_t)(n0 + n) * K + k0 + 8 * c) = o; }
    asm volatile("s_waitcnt lgkmcnt(0)" ::: "memory");
}
__device__ __forceinline__ void transpose_all(const float* W, int K, int N, const float* gain, bf16_t* WT, LAS float* scr, int gw, int NGW, int lane) {
    const int nitems = (K / 64) * (N / 32);
    for (int it = gw; it < nitems; it += NGW) transpose_item(W, K, N, gain, WT, scr, it, lane);
}
__device__ __forceinline__ void row_to_bf16(const float* xrow, bf16_t* orow, u64* ss, int lane) {
    const f32x4* xr = (const f32x4*)xrow + lane; float s = 0.f; f32x4 v[4];
#pragma unroll
    for (int j = 0; j < 4; ++j) { v[j] = xr[64 * j]; s += (v[j].x * v[j].x + v[j].y * v[j].y) + (v[j].z * v[j].z + v[j].w * v[j].w); }
    s = wave_sum(s);
    u32x2* o8 = (u32x2*)orow + lane;
#pragma unroll
    for (int j = 0; j < 4; ++j) { u32x2 w; w.x = pk_bf16(v[j].x, v[j].y); w.y = pk_bf16(v[j].z, v[j].w); o8[64 * j] = w; }
    if (lane == 0) *ss = (u64)(s * SC_SS + 0.5f);
}

__device__ __forceinline__ void transpose_layer(const __attribute__((address_space(4))) Args* ap, unsigned char* ws, int l, LAS float* scr, int gw, int NGW, int lane) {
    const int e = l >> 1;
    if (l & 1) {
        transpose_all(ap->in[11] + (size_t)e * 1024 * 3328, 1024, 3328, ap->in[2] + l * 1024, (bf16_t*)(ws + WS_ODWIN) + (size_t)e * 3328 * 1024, scr, gw, NGW, lane);
        transpose_all(ap->in[18] + (size_t)e * 1280 * 1024, 1280, 1024, nullptr, (bf16_t*)(ws + WS_ODWOUT) + (size_t)e * 1024 * 1280, scr, gw, NGW, lane);
    } else {
        transpose_all(ap->in[3] + (size_t)e * 1024 * 3072, 1024, 3072, ap->in[2] + l * 1024, (bf16_t*)(ws + WS_EVWIN) + (size_t)e * 3072 * 1024, scr, gw, NGW, lane);
        transpose_all(ap->in[10] + (size_t)e * 1024 * 1024, 1024, 1024, nullptr, (bf16_t*)(ws + WS_EVWOUT) + (size_t)e * 1024 * 1024, scr, gw, NGW, lane);
    }
    transpose_all(ap->in[21] + (size_t)l * 1024 * 1024, 1024, 1024, ap->in[19] + l * 1024, (bf16_t*)(ws + WS_WQ) + (size_t)l * 1024 * 1024, scr, gw, NGW, lane);
    transpose_all(ap->in[25] + (size_t)l * 1024 * 1024, 1024, 1024, nullptr, (bf16_t*)(ws + WS_WO) + (size_t)l * 1024 * 1024, scr, gw, NGW, lane);
    transpose_all(ap->in[27] + (size_t)l * 1024 * 4096, 1024, 4096, ap->in[26] + l * 1024, (bf16_t*)(ws + WS_W1) + (size_t)l * 4096 * 1024, scr, gw, NGW, lane);
    transpose_all(ap->in[28] + (size_t)l * 4096 * 1024, 4096, 1024, nullptr, (bf16_t*)(ws + WS_W2) + (size_t)l * 1024 * 4096, scr, gw, NGW, lane);
}

#define XB_TMO      128
#define XB_XCNT(j)  (256  + 64 * (j))
#define XB_XSUB(j)  (1280 + 64 * (j))
#define XB_XGEN(j)  (2304 + 64 * (j))
#define XB_TOP      3328
#define XB_TOPGEN   3392
#define XCD_BAR_WORDS 3456
#define XB_SPIN_CAP (1u << 22)
__device__ __forceinline__ unsigned xb_ld(unsigned* p)              { return __hip_atomic_load(p, __ATOMIC_RELAXED, __HIP_MEMORY_SCOPE_AGENT); }
__device__ __forceinline__ unsigned xb_add(unsigned* p, unsigned v) { return __hip_atomic_fetch_add(p, v, __ATOMIC_RELAXED, __HIP_MEMORY_SCOPE_AGENT); }
__device__ __forceinline__ unsigned xb_xcc_id() { return (unsigned)__builtin_amdgcn_s_getreg((3 << 11) | 20) & 0xFu; }
#define XB_SPIN(cond, bar) do { unsigned _sp = 0; while (cond) { __builtin_amdgcn_s_sleep(1); \
    if ((++_sp & 255u) == 0u) { if (xb_ld(&(bar)[XB_TMO])) break; if (_sp > XB_SPIN_CAP) { atomicAdd(&(bar)[XB_TMO], 1u); break; } } } } while (0)
__device__ __forceinline__ void xcd_barrier_complete(unsigned* bar, unsigned x, unsigned& nloc, unsigned& nx) {
    const unsigned G = gridDim.x * gridDim.y * gridDim.z;
    unsigned sum, cnt, mine, sp = 0u;
    for (;;) {
        sum = 0u; cnt = 0u; mine = 0u;
#pragma unroll
        for (unsigned j = 0; j < 16; ++j) { const unsigned c = xb_ld(&bar[XB_XCNT(j)]); sum += c; cnt += (c > 0u) ? 1u : 0u; mine = (j == x) ? c : mine; }
        if (sum == G) break;
        __builtin_amdgcn_s_sleep(1);
        if ((++sp & 255u) == 0u) { if (xb_ld(&bar[XB_TMO])) break; if (sp > XB_SPIN_CAP) { atomicAdd(&bar[XB_TMO], 1u); break; } }
    }
    nloc = mine > 0u ? mine : 1u; nx = cnt > 0u ? cnt : 1u;
}
__device__ __forceinline__ void xcd_barrier(unsigned* bar, unsigned x, volatile LAS unsigned* st) {
    asm volatile("s_waitcnt vmcnt(0)" ::: "memory");
    __syncthreads();
    if (threadIdx.x == 0) {
        __builtin_amdgcn_s_waitcnt(0);
        unsigned nloc = st[0], nx = st[1];
        if (nloc == 0u) { xcd_barrier_complete(bar, x, nloc, nx); st[0] = nloc; st[1] = nx; }
        const unsigned old = xb_add(&bar[XB_XSUB(x)], 1u);
        const unsigned gen = old / nloc;
        if (old + 1u == (gen + 1u) * nloc) {
            __builtin_amdgcn_fence(__ATOMIC_RELEASE, "agent");
            asm volatile("s_waitcnt vmcnt(0)" ::: "memory");
            const unsigned og = xb_add(&bar[XB_TOP], 1u);
            const unsigned tg = og / nx;
            if (og + 1u == (tg + 1u) * nx) xb_add(&bar[XB_TOPGEN], 1u);
            else XB_SPIN(xb_ld(&bar[XB_TOPGEN]) == tg, bar);
            __builtin_amdgcn_fence(__ATOMIC_ACQUIRE, "agent");
            xb_add(&bar[XB_XGEN(x)], 1u);
            asm volatile("s_waitcnt vmcnt(0)" ::: "memory");
        } else {
            XB_SPIN(xb_ld(&bar[XB_XGEN(x)]) == gen, bar);
            __builtin_amdgcn_fence(__ATOMIC_ACQUIRE, "agent");
            asm volatile("s_waitcnt vmcnt(0)" ::: "memory");
        }
    }
    __syncthreads();
}

__global__ void __launch_bounds__(512, 2) mk_fwd(Args args) {
    extern __shared__ __attribute__((aligned(16))) unsigned char lds_raw[];
    LAS unsigned char* lds = (LAS unsigned char*)lds_raw;
    volatile LAS unsigned* const xst = (volatile LAS unsigned*)((LAS unsigned char*)lds_raw + LDS_BYTES - 64);
    if (threadIdx.x < 2) xst[threadIdx.x] = 0u;
    const unsigned xcc = xb_xcc_id();
    if (args.hi - args.lo > 1 && threadIdx.x == 0) (void)xb_add((unsigned*)(args.ws + ST_BAR) + XB_XCNT(xcc), 1u);
    __syncthreads();
    const __attribute__((address_space(4))) Args* const ap0 = (const __attribute__((address_space(4))) Args*)__builtin_amdgcn_kernarg_segment_ptr();
#ifdef REP_MASK
    for (int ph2 = args.lo * 2; ph2 < args.hi * 2; ++ph2) { const int ph = ph2 >> 1;
    if ((ph2 & 1) && !(ph >= 3 && ((REP_MASK >> ((ph - 3) % 10)) & 1) && ((REP_ODD >> (((ph - 3) / 10) & 1)) & 1))) continue;
#else
    for (int ph = args.lo; ph < args.hi; ++ph) {
#endif
    const __attribute__((address_space(4))) Args* ap = ap0; asm volatile("" : "+s"(ap));
    int tid = threadIdx.x; asm volatile("" : "+v"(tid));
    const int lane = tid & 63, wave = __builtin_amdgcn_readfirstlane(tid >> 6);
    int G = gridDim.x, bx = blockIdx.x; asm volatile("" : "+s"(G), "+s"(bx));
    const int vcu = (G % 8 == 0) ? (bx % 8) * (G / 8) + bx / 8 : bx;
    unsigned char* ws = ap->ws;
    u64* const st_sxz = (u64*)(ws + ST_SXZ); u64* const st_sx0 = (u64*)(ws + ST_SX0);
    bf16_t* const xb = (bf16_t*)(ws + WS_XB);
    bf16_t* const pbuf = (bf16_t*)(ws + WS_P); bf16_t* const mix = (bf16_t*)(ws + WS_MIX);
    float* const rope = (float*)(ws + ST_ROPE); float* const lse = (float*)(ws + ST_LSE);
    {
#ifdef ONLY_S
        if (ph < 0) {
#else
        if (ph == 0) {
#endif
            const int gw = vcu * 8 + wave, NGW = G * 8;
            { u32x4* z = (u32x4*)ws; const size_t n16 = ST_ZERO_BYTES / 16; for (size_t i = (size_t)bx * 512 + tid; i < n16; i += (size_t)G * 512) z[i] = (u32x4){0u, 0u, 0u, 0u}; }
            for (int m = gw * 2; m < NTOK; m += NGW * 2) {
                const f32x4* x0 = (const f32x4*)(ap->in[0] + (size_t)m * DM) + lane; const f32x4* x1 = x0 + DM / 4;
                f32x4 v[8];
#pragma unroll
                for (int j = 0; j < 4; ++j) { v[j] = x0[64 * j]; v[4 + j] = x1[64 * j]; }
                float s0 = 0.f, s1 = 0.f;
#pragma unroll
                for (int j = 0; j < 4; ++j) { s0 += (v[j].x * v[j].x + v[j].y * v[j].y) + (v[j].z * v[j].z + v[j].w * v[j].w); s1 += (v[4 + j].x * v[4 + j].x + v[4 + j].y * v[4 + j].y) + (v[4 + j].z * v[4 + j].z + v[4 + j].w * v[4 + j].w); }
                s0 = wave_sum(s0); s1 = wave_sum(s1);
                u32x2* o0 = (u32x2*)(xb + (size_t)m * DM) + lane; u32x2* o1 = o0 + DM / 4;
#pragma unroll
                for (int j = 0; j < 4; ++j) { u32x2 w; w.x = pk_bf16(v[j].x, v[j].y); w.y = pk_bf16(v[j].z, v[j].w); o0[64 * j] = w; u32x2 w1; w1.x = pk_bf16(v[4 + j].x, v[4 + j].y); w1.y = pk_bf16(v[4 + j].z, v[4 + j].w); o1[64 * j] = w1; }
                if (lane == 0) { st_sx0[m] = (u64)(s0 * SC_SS + 0.5f); st_sx0[m + 1] = (u64)(s1 * SC_SS + 0.5f); }
            }
            { bf16_t* memb = (bf16_t*)(ws + WS_MEMB); u64* smem = (u64*)(ws + ST_SMEM);
              for (int m = gw; m < 4096; m += NGW) row_to_bf16(ap->in[1] + (size_t)m * DM, memb + (size_t)m * DM, smem + m, lane); }
            LAS float* scr = (LAS float*)(lds + wave * 16384);
            for (int l = 0; l < 4; ++l)
                transpose_all(ap->in[22] + (size_t)l * 1024 * 2048, 1024, 2048, ap->in[20] + l * 1024, (bf16_t*)(ws + WS_WKV) + (size_t)l * 2048 * 1024, scr, gw, NGW, lane);
            for (int l = 0; l < ((G >= 128) ? 1 : 4); ++l) transpose_layer(ap, ws, l, scr, gw, NGW, lane);
            for (int i = bx * 512 + tid; i < 4096 * 8; i += G * 512) {
                const int t = i >> 3, j = i & 7;
                const float invf[8] = {1.0f, 0.19392274474868576f, 0.03760603093086393f, 0.007292664737217109f, 0.001414213562373095f, 0.0002742481756762073f, 5.318295896944988e-05f, 1.031338537721246e-05f};
                float fj = invf[0];
#pragma unroll
                for (int q = 1; q < 8; ++q) fj = (j == q) ? invf[q] : fj;
                const float ang = (float)t * fj;
                const double a = (double)ang; const double k = __builtin_rint(a * 0.15915494309189535); const float r = (float)(a - k * 6.283185307179586);
                rope[t * 16 + j] = __cosf(r); rope[t * 16 + 8 + j] = __sinf(r);
            }
#ifdef ONLY_S
        } else if (ph < 0) {
#else
        } else if (ph == 1) {
#endif
            pg8::Gemm g{(const bf16_t*)(ws + WS_MEMB), (const bf16_t*)(ws + WS_WKV), 1024, 1024, 1024, 16, 8, 4, 1, 0, 0, 2048 * 1024, 0, 0};
            pg8::EpiP E{(bf16_t*)(ws + WS_KVRAW), 2048, 4096, (const u64*)(ws + ST_SMEM), 1.0f / (1024.0f * SC_SS), 0, (u64*)(ws + ST_KST), 8, 1, 0};
            pg8::gemm_phase<pg8::EpiP>(lds, tid, g, G, bx, E);
#ifdef ONLY_S
        } else if (ph < 0) {
#else
        } else if (ph == 2) {
#endif
            const int gw = vcu * 8 + wave, NGW = G * 8;
            const bf16_t* kvraw = (const bf16_t*)(ws + WS_KVRAW); bf16_t* kt = (bf16_t*)(ws + WS_KT); bf16_t* vt = (bf16_t*)(ws + WS_VT); const u64* kst = (const u64*)(ws + ST_KST);
            for (int r = gw; r < 4 * 4096; r += NGW) {
                const int l = r >> 12;
                const float* gk = ap->in[24] + l * 256; const float* gq = ap->in[23] + l * 256;
#pragma unroll
                for (int c2 = 0; c2 < 2; ++c2) {
                    const int ch = lane + 64 * c2, h = ch >> 5, e0 = (ch & 31) * 8;
                    const float rs = rsqrtf((float)kst[(size_t)r * 8 + h] * (1.0f / (256.0f * SC_SS)) + EPSF) * 0.0625f;
                    const u32x4 raw = *(const u32x4*)(kvraw + (size_t)r * 2048 + ch * 8); float f[8]; unpack8(raw, f);
#pragma unroll
                    for (int i = 0; i < 8; ++i) f[i] = f[i] * rs * gk[e0 + i] * gq[e0 + i];
                    *(u32x4*)(kt + (size_t)r * 1024 + ch * 8) = pack8(f);
                }
            }
            for (int idx = bx * 512 + tid; idx < 4 * 4096 * 128; idx += G * 512) {
                const int ch = idx & 127, r = idx >> 7;
                *(u32x4*)(vt + (size_t)r * 1024 + ch * 8) = *(const u32x4*)(kvraw + (size_t)r * 2048 + 1024 + ch * 8);
            }
        } else {
            #ifdef ONLY_S
            const int l = (ph - 3) / 10, s = ONLY_S, odd = ONLY_ODD, eo = l >> 1;
#else
            const int l = (ph - 3) / 10, s = (ph - 3) % 10, odd = l & 1, eo = l >> 1;
#endif
            u64* const sx_mix = (l == 0) ? st_sx0 : st_sxz + (size_t)(3 * l - 1) * NTOK;
            u64* const sx_xat = st_sxz + (size_t)(3 * l) * NTOK;
            u64* const sx_mlp = st_sxz + (size_t)(3 * l + 1) * NTOK;
            u64* const sx_next = st_sxz + (size_t)(3 * l + 2) * NTOK;
            u64* const qst = (u64*)(ws + ST_QST) + (size_t)l * NTOK * 4;
            u64* const lsum = (u64*)(ws + ST_LSUM) + (size_t)l * NTOK * 4;
            const int PW = odd ? 3328 : 3072, MW = odd ? 1280 : 1024;
            if (s == 6) continue;
            if (s == 0) {
                const bf16_t* wt = odd ? (const bf16_t*)(ws + WS_ODWIN) + (size_t)eo * 3328 * 1024 : (const bf16_t*)(ws + WS_EVWIN) + (size_t)eo * 3072 * 1024;
                pg8::Gemm g{xb, wt, 1024, 1024, 1024, 256, PW / 256, 1, 1, 0, 0, 0, 0, 0};
                pg8::EpiP E{pbuf, PW, NTOK, sx_mix, 1.0f / (1024.0f * SC_SS), odd ? 1 : 0, nullptr, 0, 1, 0};
                pg8::Gemm gv{(const bf16_t*)(ws + WS_WO) + (size_t)l * 1024 * 1024, (const bf16_t*)(ws + WS_VT) + (size_t)l * 4096 * 1024, 1024, 1024, 256, 4, 1, 64, 4, 0, 256, 256 * 1024, 256, 0};
                pg8::EpiP Ev{(bf16_t*)(ws + WS_VP), 1024, 1024, nullptr, 0.f, 0, nullptr, 0, 4, 256};
#pragma unroll 1
                for (int pass = 0; pass < 2; ++pass)
                    pg8::gemm_phase<pg8::EpiP>(lds, tid, pass ? gv : g, G, bx, pass ? Ev : E);
            } else if (s == 1 && !odd) {
#if !defined(NO_HGRN)
                {
                    const int fr = lane & 15, fq = lane >> 4, tr_r = (lane & 15) >> 2, tr_c = lane & 3;
                    const int kch = tid >> 2, tq = tid & 3;
                    constexpr int HB = 17920;
                    for (int item = vcu; item < 64; item += G) {
                        const int b = item >> 2, h = item & 3;
                        float lbv = 0.f; if (eo == 1) { const int c = h * 128 + kch; lbv = sigmoidf_(ap->in[8][512 + c] - ap->in[8][c]); }
                        f32x4 Sacc[8];
#pragma unroll
                        for (int kt = 0; kt < 8; ++kt) Sacc[kt] = (f32x4){0.f, 0.f, 0.f, 0.f};
                        const bf16_t* pq = pbuf + ((size_t)b * SEQ + 4 * tq) * 3072 + 1024 + h * 128 + kch;
                        const bf16_t* pi = pbuf + ((size_t)b * SEQ + (tid >> 5)) * 3072 + 2048 + h * 128 + (tid & 31) * 4;
                        unsigned rqr[4], rfr[4]; u32x2 rir;
#define HG_LOAD(blk_) do { const bf16_t* p_ = pq + (size_t)(blk_) * 16 * 3072; \
                            _Pragma("unroll") for (int j = 0; j < 4; ++j) { rqr[j] = p_[(size_t)j * 3072]; rfr[j] = p_[(size_t)j * 3072 + 512]; } \
                            rir = *(const u32x2*)(pi + (size_t)(blk_) * 16 * 3072); } while (0)
#define HG_ELEM(buf_) do { LAS bf16_t* QT_ = (LAS bf16_t*)(lds + (buf_) * HB); LAS bf16_t* KT_ = QT_ + 2176; LAS bf16_t* KB_ = QT_ + 4352; LAS bf16_t* IV_ = QT_ + 6528; LAS float* EL_ = (LAS float*)(lds + (buf_) * HB + 17408); \
                            float cj[4], fk[4], qv[4]; float c_ = 0.f; \
                            _Pragma("unroll") for (int j = 0; j < 4; ++j) { const float fp = __uint_as_float(rfr[j] << 16); const float f = lbv + (1.0f - lbv) * sigmoidf_(fp); c_ += __logf(f); cj[j] = c_; fk[j] = 1.0f - f; qv[j] = __uint_as_float(rqr[j] << 16); } \
                            const float T0 = dppf<0x00>(c_), T1 = dppf<0x55>(c_), T2 = dppf<0xAA>(c_), T3 = dppf<0xFF>(c_); \
                            const float P_ = (tq > 0 ? T0 : 0.f) + (tq > 1 ? T1 : 0.f) + (tq > 2 ? T2 : 0.f); \
                            const float ELv = __expf(fmaxf((T0 + T1) + (T2 + T3), -80.f)); \
                            _Pragma("unroll") for (int j = 0; j < 4; ++j) { const float Bv = fmaxf(P_ + cj[j], -80.f); const float E = __expf(Bv), Ei = __expf(-Bv); const float kt_ = fk[j] * Ei; const int t_ = 4 * tq + j; \
                                QT_[t_ * 136 + kch] = (bf16_t)(pk_bf16(qv[j] * E, 0.f) & 0xffffu); KT_[t_ * 136 + kch] = (bf16_t)(pk_bf16(kt_, 0.f) & 0xffffu); KB_[t_ * 136 + kch] = (bf16_t)(pk_bf16(kt_ * ELv, 0.f) & 0xffffu); } \
                            if (tq == 0) EL_[kch] = ELv; \
                            *(LAS u32x2*)(IV_ + (tid >> 5) * 136 + (tid & 31) * 4) = rir; } while (0)
                        HG_LOAD(0);
                        {
                            LAS float* fL = (LAS float*)(lds + 40960); LAS float* qL = fL + 2048; LAS float* iL = fL + 4096; LAS float* SD = (LAS float*)(lds + 65536);
#pragma unroll
                            for (int j = 0; j < 4; ++j) { const float fp = __uint_as_float(rfr[j] << 16); fL[(4 * tq + j) * 128 + kch] = lbv + (1.0f - lbv) * sigmoidf_(fp); qL[(4 * tq + j) * 128 + kch] = __uint_as_float(rqr[j] << 16); }
                            *(LAS f32x4*)(iL + (tid >> 5) * 128 + (tid & 31) * 4) = (f32x4){bf_lo(rir.x), bf_hi(rir.x), bf_lo(rir.y), bf_hi(rir.y)};
                            asm volatile("s_waitcnt lgkmcnt(0)" ::: "memory"); __builtin_amdgcn_s_barrier(); asm volatile("" ::: "memory");
                            const int kg = lane & 15, vq = wave * 4 + (lane >> 4);
                            float S0[8][4];
#pragma unroll
                            for (int j = 0; j < 8; ++j)
#pragma unroll
                                for (int c = 0; c < 4; ++c) S0[j][c] = 0.f;
#pragma unroll 2
                            for (int t = 0; t < 16; ++t) {
                                const f32x4 fa = *(const LAS f32x4*)(fL + t * 128 + kg * 8), fb = *(const LAS f32x4*)(fL + t * 128 + kg * 8 + 4);
                                const f32x4 qa = *(const LAS f32x4*)(qL + t * 128 + kg * 8), qb = *(const LAS f32x4*)(qL + t * 128 + kg * 8 + 4);
                                const f32x4 iv = *(const LAS f32x4*)(iL + t * 128 + vq * 4);
                                float a[4] = {0.f, 0.f, 0.f, 0.f};
#pragma unroll
                                for (int j = 0; j < 8; ++j) { const float fj = j < 4 ? fa[j] : fb[j - 4], qj = j < 4 ? qa[j] : qb[j - 4];
#pragma unroll
                                    for (int c = 0; c < 4; ++c) { const float d0 = S0[j][c] - iv[c]; S0[j][c] = __builtin_fmaf(fj, d0, iv[c]); a[c] = __builtin_fmaf(qj, S0[j][c], a[c]); } }
#pragma unroll
                                for (int c = 0; c < 4; ++c) a[c] = row16_sum(a[c]);
                                if (kg == 0) { u32x2 wv; wv.x = pk_bf16(a[0], a[1]); wv.y = pk_bf16(a[2], a[3]); *(u32x2*)(mix + ((size_t)b * SEQ + t) * 1024 + 512 + h * 128 + vq * 4) = wv; }
                            }
#pragma unroll
                            for (int j = 0; j < 8; ++j) *(LAS f32x4*)(SD + (kg * 8 + j) * 128 + vq * 4) = (f32x4){S0[j][0], S0[j][1], S0[j][2], S0[j][3]};
                            asm volatile("s_waitcnt lgkmcnt(0)" ::: "memory"); __builtin_amdgcn_s_barrier(); asm volatile("" ::: "memory");
#pragma unroll
                            for (int kt = 0; kt < 8; ++kt)
#pragma unroll
                                for (int i = 0; i < 4; ++i) Sacc[kt][i] = SD[(16 * kt + 4 * fq + i) * 128 + 16 * wave + fr];
                        }
                        HG_LOAD(1); HG_ELEM(1); HG_LOAD(2);
                        asm volatile("s_waitcnt lgkmcnt(0)" ::: "memory"); __builtin_amdgcn_s_barrier(); asm volatile("" ::: "memory");
                        for (int blk = 1; blk < 256; ++blk) {
                            const int cur = blk & 1;
                            if (wave < 4 && blk + 1 < 256) { HG_ELEM(cur ^ 1); if (blk + 2 < 256) HG_LOAD(blk + 2); }
                            const LAS bf16_t* QT = (const LAS bf16_t*)(lds + cur * HB); const LAS bf16_t* KT = QT + 2176; const LAS bf16_t* KB = QT + 4352; const LAS bf16_t* IV = QT + 6528; const LAS float* EL = (const LAS float*)(lds + cur * HB + 17408);
                            const v4i16_t itv = __builtin_amdgcn_ds_read_tr16_b64_v4i16((LAS v4i16_t*)(IV + (4 * fq + tr_r) * 136 + 16 * wave + 4 * tr_c));
                            bf16x8 AX[4], AY[4]; u32x2 QY0[4], QY1[4]; f32x4 ELv4[8]; v4i16_t KX[8];
#pragma unroll
                            for (int ks = 0; ks < 4; ++ks) { AX[ks] = *(const LAS bf16x8*)(KT + fr * 136 + ks * 32 + fq * 8); AY[ks] = *(const LAS bf16x8*)(QT + fr * 136 + ks * 32 + fq * 8); }
#pragma unroll
                            for (int p = 0; p < 4; ++p) { QY0[p] = *(const LAS u32x2*)(QT + fr * 136 + 32 * p + 4 * fq); QY1[p] = *(const LAS u32x2*)(QT + fr * 136 + 32 * p + 16 + 4 * fq); }
#pragma unroll
                            for (int kt = 0; kt < 8; ++kt) { ELv4[kt] = *(const LAS f32x4*)(EL + 16 * kt + 4 * fq); KX[kt] = __builtin_amdgcn_ds_read_tr16_b64_v4i16((LAS v4i16_t*)(KB + (4 * fq + tr_r) * 136 + kt * 16 + 4 * tr_c)); }
                            __builtin_amdgcn_sched_barrier(0);
                            const bf16x8 IT = (bf16x8){itv[0], itv[1], itv[2], itv[3], 0, 0, 0, 0};
                            f32x4 A = (f32x4){0.f, 0.f, 0.f, 0.f};
#pragma unroll
                            for (int ks = 0; ks < 4; ++ks) A = __builtin_amdgcn_mfma_f32_16x16x32_bf16(AX[ks], AY[ks], A, 0, 0, 0);
#pragma unroll
                            for (int i = 0; i < 4; ++i) A[i] = (4 * fq + i > fr) ? 0.f : A[i];
                            const u32x4 apk = (u32x4){pk_bf16(A[0], A[1]), pk_bf16(A[2], A[3]), 0u, 0u};
                            f32x4 o = __builtin_amdgcn_mfma_f32_16x16x32_bf16(IT, __builtin_bit_cast(bf16x8, apk), (f32x4){0.f, 0.f, 0.f, 0.f}, 0, 0, 0);
#pragma unroll
                            for (int p = 0; p < 4; ++p) {
                                const u32x4 sx = (u32x4){pk_bf16(Sacc[2 * p][0], Sacc[2 * p][1]), pk_bf16(Sacc[2 * p][2], Sacc[2 * p][3]), pk_bf16(Sacc[2 * p + 1][0], Sacc[2 * p + 1][1]), pk_bf16(Sacc[2 * p + 1][2], Sacc[2 * p + 1][3])};
                                const u32x4 yy = (u32x4){QY0[p].x, QY0[p].y, QY1[p].x, QY1[p].y};
                                o = __builtin_amdgcn_mfma_f32_16x16x32_bf16(__builtin_bit_cast(bf16x8, sx), __builtin_bit_cast(bf16x8, yy), o, 0, 0, 0);
                            }
                            { u32x2 wv; wv.x = pk_bf16(o[0], o[1]); wv.y = pk_bf16(o[2], o[3]);
                              *(u32x2*)(mix + ((size_t)b * SEQ + blk * 16 + fr) * 1024 + 512 + h * 128 + 16 * wave + 4 * fq) = wv; }
#pragma unroll
                            for (int kt = 0; kt < 8; ++kt) {
                                const bf16x8 X = (bf16x8){KX[kt][0], KX[kt][1], KX[kt][2], KX[kt][3], 0, 0, 0, 0};
                                Sacc[kt] = __builtin_amdgcn_mfma_f32_16x16x32_bf16(X, IT, Sacc[kt] * ELv4[kt], 0, 0, 0);
                            }
                            if (wave >= 4 && blk + 1 < 256) { HG_ELEM(cur ^ 1); if (blk + 2 < 256) HG_LOAD(blk + 2); }
                            asm volatile("s_waitcnt lgkmcnt(0)" ::: "memory"); __builtin_amdgcn_s_barrier(); asm volatile("" ::: "memory");
                        }
#undef HG_LOAD
#undef HG_ELEM
                    }
                }
#endif
#if !defined(NO_CONV)
                {
                    LAS unsigned* hL32 = (LAS unsigned*)lds; LAS float* yL = (LAS float*)(lds + 65536);
                    const float* cw = ap->in[4] + (size_t)eo * 31 * 512; const float* cb = ap->in[5] + eo * 512;
                    const float* lng = ap->in[6] + eo * 512; const float* lnb = ap->in[7] + eo * 512;
                    const int cp = tid & 255, th = tid >> 8;
                    const bool split_ = (G >= 128);
                    for (int item = split_ ? vcu - 64 : vcu; item < 2048; item += split_ ? G - 64 : G) {
                        if (item < 0) break;
                        const int ritem = 2047 - item;
                        const int b = ritem >> 7, t0 = (ritem & 127) * 32;
                        {
                            u32x4 av[8], gv[8];
#pragma unroll
                            for (int q = 0; q < 8; ++q) {
                                const int idx = tid + 512 * q, r = idx >> 6, c8 = idx & 63, t = t0 - 30 + r;
                                av[q] = (u32x4){0u, 0u, 0u, 0u}; gv[q] = av[q];
                                if (idx < 62 * 64 && t >= 0) { const bf16_t* pr = pbuf + ((size_t)b * SEQ + t) * 3072 + c8 * 8; av[q] = *(const u32x4*)pr; gv[q] = *(const u32x4*)(pr + 512); }
                            }
#pragma unroll
                            for (int q = 0; q < 8; ++q) {
                                const int idx = tid + 512 * q, r = idx >> 6, c8 = idx & 63;
                                float a[8], g8[8]; unpack8(av[q], a); unpack8(gv[q], g8);
#pragma unroll
                                for (int i = 0; i < 8; ++i) a[i] *= sigmoidf_(g8[i]);
                                if (idx < 62 * 64) *(LAS u32x4*)(hL32 + r * 256 + c8 * 4) = pack8(a);
                            }
                        }
                        __syncthreads();
#pragma unroll 1
                        for (int sb = 0; sb < 2; ++sb) {
                            float y0[8], y1[8];
                            const float b0 = cb[2 * cp], b1 = cb[2 * cp + 1];
#pragma unroll
                            for (int t = 0; t < 8; ++t) { y0[t] = b0; y1[t] = b1; }
                            unsigned in[38];
#pragma unroll
                            for (int r = 0; r < 38; ++r) in[r] = hL32[(th * 16 + sb * 8 + r) * 256 + cp];
#pragma unroll
                            for (int j = 0; j < 31; ++j) {
                                const f32x2 wj = *(const f32x2*)(cw + j * 512 + 2 * cp);
#pragma unroll
                                for (int t = 0; t < 8; ++t) { y0[t] = __builtin_fmaf(wj.x, bf_lo(in[t + j]), y0[t]); y1[t] = __builtin_fmaf(wj.y, bf_hi(in[t + j]), y1[t]); }
                            }
#pragma unroll
                            for (int t = 0; t < 8; ++t) *(LAS f32x2*)(yL + (th * 16 + sb * 8 + t) * 512 + 2 * cp) = (f32x2){y0[t], y1[t]};
                        }
                        __syncthreads();
#pragma unroll
                        for (int q = 0; q < 4; ++q) {
                            const int tok = wave * 4 + q;
                            const f32x4 v0 = *(const LAS f32x4*)(yL + tok * 512 + lane * 8), v1 = *(const LAS f32x4*)(yL + tok * 512 + lane * 8 + 4);
                            float sm = (v0[0] + v0[1]) + (v0[2] + v0[3]) + (v1[0] + v1[1]) + (v1[2] + v1[3]);
                            sm = wave_sum(sm); const float mu = sm * (1.0f / 512.0f);
                            float f[8] = {v0[0] - mu, v0[1] - mu, v0[2] - mu, v0[3] - mu, v1[0] - mu, v1[1] - mu, v1[2] - mu, v1[3] - mu};
                            float sq = 0.f;
#pragma unroll
                            for (int i = 0; i < 8; ++i) sq += f[i] * f[i];
                            sq = wave_sum(sq); const float rstd = rsqrtf(sq * (1.0f / 512.0f) + EPSF);
#pragma unroll
                            for (int i = 0; i < 8; ++i) { const float yv = f[i] * rstd * lng[lane * 8 + i] + lnb[lane * 8 + i]; f[i] = yv * sigmoidf_(yv); }
                            *(u32x4*)(mix + ((size_t)b * SEQ + t0 + tok) * 1024 + lane * 8) = pack8(f);
                        }
                        __syncthreads();
                    }
                    if (split_ && vcu >= 64) {
                        LAS float* scr = (LAS float*)(lds + wave * 16384);
                        const int gw2 = (vcu - 64) * 8 + wave, NGW2 = (G - 64) * 8;
                        if (l == 0) { transpose_layer(ap, ws, 1, scr, gw2, NGW2, lane); transpose_layer(ap, ws, 2, scr, gw2, NGW2, lane); }
                        else transpose_layer(ap, ws, 3, scr, gw2, NGW2, lane);
                    }
                }
#endif
            } else if (s == 2 && !odd) {
                const int gw = vcu * 8 + wave, NGW = G * 8;
                const float* og = ap->in[9] + eo * 128;
                for (int m0 = gw * 4; m0 < NTOK; m0 += NGW * 4) {
                    u32x4 ov[4], gv[4];
#pragma unroll
                    for (int q = 0; q < 4; ++q) { ov[q] = *(const u32x4*)(mix + (size_t)(m0 + q) * 1024 + 512 + lane * 8); gv[q] = *(const u32x4*)(pbuf + (size_t)(m0 + q) * 3072 + 2560 + lane * 8); }
#pragma unroll
                    for (int q = 0; q < 4; ++q) {
                        float o[8], g8[8]; unpack8(ov[q], o); unpack8(gv[q], g8);
                        float ss = 0.f;
#pragma unroll
                        for (int i = 0; i < 8; ++i) ss += o[i] * o[i];
                        ss = row16_sum(ss);
                        const float rs = rsqrtf(ss * (1.0f / 128.0f) + EPSF);
                        const int c0 = (lane & 15) * 8;
#pragma unroll
                        for (int i = 0; i < 8; ++i) o[i] = o[i] * rs * og[c0 + i] * (g8[i] * sigmoidf_(g8[i]));
                        *(u32x4*)(mix + (size_t)(m0 + q) * 1024 + 512 + lane * 8) = pack8(o);
                    }
                }
            } else if (s == 1 && odd) {
#if !defined(NO_SGU)
                {
                    LAS bf16_t* VN = (LAS bf16_t*)lds;
                    const float* lng = ap->in[12] + eo * 512; const float* lnb = ap->in[13] + eo * 512;
                    const int wr = wave >> 2, wc = wave & 3, fr = lane & 15, fq = lane >> 4, tr_r = (lane & 15) >> 2, tr_c = lane & 3;
                    for (int item = vcu; item < 512; item += G) {
                        const int ritem = 511 - item;
                        const int b = ritem >> 5, n = ritem & 31;
                        const size_t row0 = (size_t)b * SEQ + n * 128;
                        const int sT = tid >> 2, qd = tid & 3;
                        {
                            const bf16_t* pr = pbuf + (row0 + sT) * 3328 + 512 + qd * 128;
                            float sm = 0.f, sq = 0.f;
#pragma unroll 4
                            for (int i = 0; i < 16; ++i) { const u32x4 rawv = *(const u32x4*)(pr + i * 8); float f[8]; unpack8(rawv, f);
#pragma unroll
                                for (int j = 0; j < 8; ++j) { sm += f[j]; sq += f[j] * f[j]; } }
                            sm += __shfl_xor(sm, 1); sm += __shfl_xor(sm, 2); sq += __shfl_xor(sq, 1); sq += __shfl_xor(sq, 2);
                            const float mu = sm * (1.0f / 512.0f); const float var = fmaxf(sq * (1.0f / 512.0f) - mu * mu, 0.f); const float rstd = rsqrtf(var + EPSF);
#pragma unroll 2
                            for (int i = 0; i < 16; ++i) { const u32x4 rawv = *(const u32x4*)(pr + i * 8); float f[8]; unpack8(rawv, f);
                                const f32x4 g0 = *(const f32x4*)(lng + qd * 128 + i * 8), g1 = *(const f32x4*)(lng + qd * 128 + i * 8 + 4);
                                const f32x4 b0 = *(const f32x4*)(lnb + qd * 128 + i * 8), b1 = *(const f32x4*)(lnb + qd * 128 + i * 8 + 4);
#pragma unroll
                                for (int j = 0; j < 4; ++j) { f[j] = (f[j] - mu) * rstd * g0[j] + b0[j]; f[4 + j] = (f[4 + j] - mu) * rstd * g1[j] + b1[j]; }
                                *(LAS u32x4*)(VN + sT * 520 + qd * 128 + i * 8) = pack8(f); }
                        }
                        asm volatile("s_waitcnt lgkmcnt(0)" ::: "memory"); __builtin_amdgcn_s_barrier(); asm volatile("" ::: "memory");
#pragma unroll 1
                        for (int gI = 0; gI < 4; ++gI) {
                            const float* wg = ap->in[14] + ((size_t)eo * 4 + gI) * 128 * 128; const float* bsg = ap->in[15] + (eo * 4 + gI) * 128;
                            f32x4 acc[4][2];
#pragma unroll
                            for (int m = 0; m < 4; ++m) { acc[m][0] = (f32x4){0.f, 0.f, 0.f, 0.f}; acc[m][1] = (f32x4){0.f, 0.f, 0.f, 0.f}; }
#pragma unroll
                            for (int k0 = 0; k0 < 128; k0 += 32) {
                                if (k0 <= wr * 64 + 63) {
                                    bf16x8 X[2];
#pragma unroll
                                    for (int nn = 0; nn < 2; ++nn) {
                                        const LAS bf16_t* vp = VN + (k0 + fq * 8 + tr_r) * 520 + gI * 128 + wc * 32 + nn * 16 + 4 * tr_c;
                                        const v4i16_t lo = __builtin_amdgcn_ds_read_tr16_b64_v4i16((LAS v4i16_t*)vp), hi = __builtin_amdgcn_ds_read_tr16_b64_v4i16((LAS v4i16_t*)(vp + 4 * 520));
                                        X[nn] = (bf16x8){lo[0], lo[1], lo[2], lo[3], hi[0], hi[1], hi[2], hi[3]};
                                    }
#pragma unroll
                                    for (int m = 0; m < 4; ++m) {
                                        if (k0 <= wr * 64 + m * 16 + 15) {
                                            const int t = wr * 64 + m * 16 + fr, s0 = k0 + fq * 8;
                                            const f32x4 w0 = *(const f32x4*)(wg + t * 128 + s0), w1 = *(const f32x4*)(wg + t * 128 + s0 + 4);
                                            float wf[8] = {w0[0], w0[1], w0[2], w0[3], w1[0], w1[1], w1[2], w1[3]};
#pragma unroll
                                            for (int i = 0; i < 8; ++i) wf[i] = (s0 + i <= t) ? wf[i] : 0.f;
                                            const u32x4 yp = pack8(wf); const bf16x8 Y = __builtin_bit_cast(bf16x8, yp);
                                            acc[m][0] = __builtin_amdgcn_mfma_f32_16x16x32_bf16(X[0], Y, acc[m][0], 0, 0, 0);
                                            acc[m][1] = __builtin_amdgcn_mfma_f32_16x16x32_bf16(X[1], Y, acc[m][1], 0, 0, 0);
                                        }
                                    }
                                }
                            }
#pragma unroll
                            for (int m = 0; m < 4; ++m) {
                                const int t = wr * 64 + m * 16 + fr; const float bias = bsg[t];
#pragma unroll
                                for (int nn = 0; nn < 2; ++nn) {
                                    const int c0 = wc * 32 + nn * 16 + 4 * fq;
                                    const u32x2 uv = *(const u32x2*)(pbuf + (row0 + t) * 3328 + gI * 128 + c0);
                                    const float o0 = bf_lo(uv.x) * (acc[m][nn][0] + bias), o1 = bf_hi(uv.x) * (acc[m][nn][1] + bias), o2 = bf_lo(uv.y) * (acc[m][nn][2] + bias), o3 = bf_hi(uv.y) * (acc[m][nn][3] + bias);
                                    u32x2 w; w.x = pk_bf16(o0, o1); w.y = pk_bf16(o2, o3);
                                    *(u32x2*)(mix + (row0 + t) * 1280 + gI * 128 + c0) = w;
                                }
                            }
                        }
                        asm volatile("s_waitcnt lgkmcnt(0)" ::: "memory"); __builtin_amdgcn_s_barrier(); asm volatile("" ::: "memory");
                    }
                }
#endif
#if !defined(NO_ATTN)
                {
                    LAS bf16_t* QL = (LAS bf16_t*)lds; LAS bf16_t* KL = (LAS bf16_t*)(lds + 18432); LAS bf16_t* VL = (LAS bf16_t*)(lds + 55296);
                    const int fr = lane & 15, fq = lane >> 4, tr_r = (lane & 15) >> 2, tr_c = lane & 3;
                    float gq16[16], gk16[16];
#pragma unroll
                    for (int i = 0; i < 16; ++i) { gq16[i] = ap->in[16][eo * 64 + (tid & 3) * 16 + i] * 0.125f; gk16[i] = ap->in[17][eo * 64 + (tid & 3) * 16 + i]; }
                    u32x4 rq[3][2], rv[4];
#pragma unroll
                    for (int i_ = 0; i_ < 3; ++i_) { rq[i_][0] = (u32x4){0u, 0u, 0u, 0u}; rq[i_][1] = (u32x4){0u, 0u, 0u, 0u}; }
#pragma unroll
                    for (int i_ = 0; i_ < 4; ++i_) rv[i_] = (u32x4){0u, 0u, 0u, 0u};
#define ATT_DECODE(it) const int rit_ = 6143 - (it); const int bj_ = rit_ / 96, q96_ = rit_ % 96, b = bj_ >> 2, j = bj_ & 3, cfg = q96_ >> 5, qq_ = q96_ & 31; \
                        const int sh = cfg * 2, r = (cfg == 0) ? 0 : (cfg == 1 ? (qq_ >> 3) : (qq_ >> 1)), n = (cfg == 0) ? qq_ : (cfg == 1 ? (qq_ & 7) : (qq_ & 1)); \
                        const int hd = cfg * 4 + j; const size_t rowb = (size_t)b * SEQ; (void)hd; (void)rowb; (void)n; (void)r; (void)sh;
#define ATT_LOAD(it) do { ATT_DECODE(it) \
                        _Pragma("unroll") for (int r3 = 0; r3 < 3; ++r3) { const int idx = tid + 512 * r3, rowi = idx >> 2, part = idx & 3; const bool isq = rowi < 128; \
                            const int sub = isq ? (n * 128 + rowi) : ((n - 1) * 128 + (rowi - 128)); const bool valid = sub >= 0; const int tok = valid ? ((sub << sh) + r) : 0; \
                            const bf16_t* src = pbuf + (rowb + tok) * 3328 + (isq ? 1024 : 1792) + hd * 64 + part * 16; \
                            rq[r3][0] = (u32x4){0u, 0u, 0u, 0u}; rq[r3][1] = rq[r3][0]; if (valid) { rq[r3][0] = *(const u32x4*)src; rq[r3][1] = *(const u32x4*)(src + 8); } } \
                        _Pragma("unroll") for (int r4 = 0; r4 < 4; ++r4) { const int idx = tid + 512 * r4, ks = idx >> 3, c8 = idx & 7; const int sub = (n - 1) * 128 + ks; \
                            rv[r4] = (u32x4){0u, 0u, 0u, 0u}; if (sub >= 0) rv[r4] = *(const u32x4*)(pbuf + (rowb + ((sub << sh) + r)) * 3328 + 2560 + hd * 64 + c8 * 8); } } while (0)
                    if (vcu < 6144) ATT_LOAD(vcu);
                    for (int item = vcu; item < 6144; item += G) {
                        ATT_DECODE(item)
#pragma unroll
                        for (int r3 = 0; r3 < 3; ++r3) {
                            const int idx = tid + 512 * r3, rowi = idx >> 2, part = idx & 3;
                            const bool isq = rowi < 128;
                            const int sub = isq ? (n * 128 + rowi) : ((n - 1) * 128 + (rowi - 128));
                            const int tok = (sub >= 0) ? ((sub << sh) + r) : 0;
                            float f[16]; unpack8(rq[r3][0], f); unpack8(rq[r3][1], f + 8);
                            float ss = 0.f;
#pragma unroll
                            for (int i = 0; i < 16; ++i) ss += f[i] * f[i];
                            ss += __shfl_xor(ss, 1); ss += __shfl_xor(ss, 2);
                            const float rs = rsqrtf(ss * (1.0f / 64.0f) + EPSF);
#pragma unroll
                            for (int i = 0; i < 16; ++i) f[i] = f[i] * rs * (r3 == 0 ? gq16[i] : gk16[i]);
                            if (part == 0) {
                                const float tf = (float)tok;
                                const float crev[8] = {0.15915494309189535f, 0.03086376340470123f, 0.005985185712713705f, 0.001160663641240061f, 0.00022507907903927653f, 4.364795279280289e-05f, 8.464330808241401e-06f, 1.6414262627950345e-06f};
#pragma unroll
                                for (int i = 0; i < 8; ++i) { const float rev = __builtin_amdgcn_fractf(tf * crev[i]); const float c = __builtin_amdgcn_cosf(rev), sn = __builtin_amdgcn_sinf(rev), x1 = f[i], x2 = f[8 + i]; f[i] = x1 * c - x2 * sn; f[8 + i] = x2 * c + x1 * sn; }
                            }
                            LAS bf16_t* dst = isq ? (QL + rowi * 72 + part * 16) : (KL + (rowi - 128) * 72 + part * 16);
                            *(LAS u32x4*)dst = pack8(f); *(LAS u32x4*)(dst + 8) = pack8(f + 8);
                        }
#pragma unroll
                        for (int r4 = 0; r4 < 4; ++r4) { const int idx = tid + 512 * r4, ks = idx >> 3, c8 = idx & 7; *(LAS u32x4*)(VL + ks * 72 + c8 * 8) = rv[r4]; }
                        if (item + G < 6144) ATT_LOAD(item + G);
                        asm volatile("s_waitcnt lgkmcnt(0)" ::: "memory"); __builtin_amdgcn_s_barrier(); asm volatile("" ::: "memory");
                        {
                            const int w = wave, qi = w * 16 + fr;
                            const bf16x8 Y0 = *(const LAS bf16x8*)(QL + qi * 72 + fq * 8), Y1 = *(const LAS bf16x8*)(QL + qi * 72 + 32 + fq * 8);
                            f32x4 sc[10];
                            {
                                bf16x8 KX0[9], KX1[9];
#pragma unroll
                                for (int jt = 0; jt < 9; ++jt) { const LAS bf16_t* kp = KL + ((w + jt) * 16 + fr) * 72 + fq * 8; KX0[jt] = *(const LAS bf16x8*)kp; KX1[jt] = *(const LAS bf16x8*)(kp + 32); }
                                __builtin_amdgcn_sched_barrier(0);
#pragma unroll
                                for (int jt = 0; jt < 9; ++jt) {
                                    f32x4 a = (f32x4){0.f, 0.f, 0.f, 0.f};
                                    a = __builtin_amdgcn_mfma_f32_16x16x32_bf16(KX0[jt], Y0, a, 0, 0, 0);
                                    a = __builtin_amdgcn_mfma_f32_16x16x32_bf16(KX1[jt], Y1, a, 0, 0, 0);
                                    sc[jt] = a;
                                }
                            }
                            float mx = -INFINITY;
#pragma unroll
                            for (int jt = 0; jt < 9; ++jt)
#pragma unroll
                                for (int i = 0; i < 4; ++i) {
                                    const int c = 4 * fq + i;
                                    bool ok = (n > 0) || (w + jt >= 8);
                                    if (jt == 0) ok = ok && (fr <= c);
                                    if (jt == 8) ok = ok && (fr >= c);
                                    const float v = ok ? sc[jt][i] : -INFINITY; sc[jt][i] = v; mx = fmaxf(mx, v);
                                }
                            mx = fmaxf(mx, __shfl_xor(mx, 16)); mx = fmaxf(mx, __shfl_xor(mx, 32));
                            float den = 0.f;
#pragma unroll
                            for (int jt = 0; jt < 9; ++jt)
#pragma unroll
                                for (int i = 0; i < 4; ++i) { const float e = __expf(sc[jt][i] - mx); sc[jt][i] = e; den += e; }
                            sc[9] = (f32x4){0.f, 0.f, 0.f, 0.f};
                            den += __shfl_xor(den, 16); den += __shfl_xor(den, 32);
                            f32x4 oa[4];
#pragma unroll
                            for (int et = 0; et < 4; ++et) oa[et] = (f32x4){0.f, 0.f, 0.f, 0.f};
                            v4i16_t VLO[5][4], VHI[5][4];
#pragma unroll
                            for (int jj = 0; jj < 5; ++jj) {
                                const int t0r = (w + 2 * jj) * 16, t1r = (jj < 4) ? (w + 2 * jj + 1) * 16 : t0r;
#pragma unroll
                                for (int et = 0; et < 4; ++et) {
                                    VLO[jj][et] = __builtin_amdgcn_ds_read_tr16_b64_v4i16((LAS v4i16_t*)(VL + (t0r + 4 * fq + tr_r) * 72 + et * 16 + 4 * tr_c));
                                    VHI[jj][et] = __builtin_amdgcn_ds_read_tr16_b64_v4i16((LAS v4i16_t*)(VL + (t1r + 4 * fq + tr_r) * 72 + et * 16 + 4 * tr_c));
                                }
                            }
                            __builtin_amdgcn_sched_barrier(0);
#pragma unroll
                            for (int jj = 0; jj < 5; ++jj) {
                                u32x4 pp; pp.x = pk_bf16(sc[2 * jj][0], sc[2 * jj][1]); pp.y = pk_bf16(sc[2 * jj][2], sc[2 * jj][3]); pp.z = pk_bf16(sc[2 * jj + 1][0], sc[2 * jj + 1][1]); pp.w = pk_bf16(sc[2 * jj + 1][2], sc[2 * jj + 1][3]);
                                const bf16x8 Pf = __builtin_bit_cast(bf16x8, pp);
#pragma unroll
                                for (int et = 0; et < 4; ++et) {
                                    const v4i16_t lo = VLO[jj][et], hi = VHI[jj][et];
                                    const bf16x8 xv = (bf16x8){lo[0], lo[1], lo[2], lo[3], hi[0], hi[1], hi[2], hi[3]};
                                    oa[et] = __builtin_amdgcn_mfma_f32_16x16x32_bf16(xv, Pf, oa[et], 0, 0, 0);
                                }
                            }
                            const float inv = 1.0f / den;
                            const int tokq = ((n * 128 + qi) << sh) + r;
                            bf16_t* op = mix + (rowb + tokq) * 1280 + 512 + hd * 64 + 4 * fq;
#pragma unroll
                            for (int et = 0; et < 4; ++et) { u32x2 wv; wv.x = pk_bf16(oa[et][0] * inv, oa[et][1] * inv); wv.y = pk_bf16(oa[et][2] * inv, oa[et][3] * inv); *(u32x2*)(op + et * 16) = wv; }
                            if (fq == 0) lse[(rowb + tokq) * 12 + hd] = mx + __logf(den);
                        }
                        asm volatile("s_waitcnt lgkmcnt(0)" ::: "memory"); __builtin_amdgcn_s_barrier(); asm volatile("" ::: "memory");
                    }
#undef ATT_LOAD
#undef ATT_DECODE
                }
#endif
            } else if (s == 2 && odd) {
                const int gw = vcu * 8 + wave, NGW = G * 8;
                for (int m0 = gw * 2; m0 < NTOK; m0 += NGW * 2) {
                    u32x4 v[2][2]; float al[2][2];
#pragma unroll
                    for (int q = 0; q < 2; ++q)
#pragma unroll
                        for (int c2 = 0; c2 < 2; ++c2) {
                            const int ch = lane + 64 * c2; v[q][c2] = (u32x4){0u, 0u, 0u, 0u}; al[q][c2] = 0.f;
                            if (ch < 96) {
                                const size_t m = (size_t)(m0 + q);
                                const int hd = ch >> 3, cfg = hd >> 2, j = hd & 3;
                                const float l0 = lse[m * 12 + j], l1 = lse[m * 12 + 4 + j], l2 = lse[m * 12 + 8 + j];
                                v[q][c2] = *(const u32x4*)(mix + m * 1280 + 512 + ch * 8);
                                const float mxl = fmaxf(l0, fmaxf(l1, l2));
                                const float e0 = __expf(l0 - mxl), e1 = __expf(l1 - mxl), e2 = __expf(l2 - mxl);
                                al[q][c2] = ((cfg == 0) ? e0 : (cfg == 1 ? e1 : e2)) / (e0 + e1 + e2);
                            }
                        }
#pragma unroll
                    for (int q = 0; q < 2; ++q)
#pragma unroll
                        for (int c2 = 0; c2 < 2; ++c2) {
                            const int ch = lane + 64 * c2;
                            if (ch < 96) { float f[8]; unpack8(v[q][c2], f);
#pragma unroll
                                for (int i = 0; i < 8; ++i) f[i] *= al[q][c2];
                                *(u32x4*)(mix + (size_t)(m0 + q) * 1280 + 512 + ch * 8) = pack8(f); }
                        }
                }
            } else if (s == 3) {
                const bf16_t* wt = odd ? (const bf16_t*)(ws + WS_ODWOUT) + (size_t)eo * 1024 * 1280 : (const bf16_t*)(ws + WS_EVWOUT) + (size_t)eo * 1024 * 1024;
                pg8::Gemm g{mix, wt, MW, MW, MW, 256, 4, 1, 1, 0, 0, 0, 0, 0};
                pg8::EpiR E{nullptr, xb, sx_xat, 0};
                pg8::gemm_phase<pg8::EpiR>(lds, tid, g, G, bx, E);
            } else if (s == 4) {
                pg8::Gemm g{xb, (const bf16_t*)(ws + WS_WQ) + (size_t)l * 1024 * 1024, 1024, 1024, 1024, 256, 4, 1, 1, 0, 0, 0, 0, 0};
                pg8::EpiP E{(bf16_t*)(ws + WS_QX), 1024, NTOK, sx_xat, 1.0f / (1024.0f * SC_SS), 0, qst, 4, 1, 0};
                pg8::gemm_phase<pg8::EpiP>(lds, tid, g, G, bx, E);
            } else if (s == 5) {
                pg8::Gemm g{(const bf16_t*)(ws + WS_QX), (const bf16_t*)(ws + WS_KT) + (size_t)l * 4096 * 1024, 1024, 1024, 256, 16, 1, 64, 4, SEQ * 1024, 256, 256 * 1024, 256, 0};
                pg8::EpiS E{(bf16_t*)(ws + WS_PB), qst, (LAS float*)(lds + 131072)};
                pg8::gemm_phase<pg8::EpiS>(lds, tid, g, G, bx, E);
            } else if (s == 7) {
                pg8::Gemm g{(const bf16_t*)(ws + WS_PB), (const bf16_t*)(ws + WS_VP), 1024, 1024, 1024, 16, 4, 16, 1, SEQ * 1024, 0, 1024 * 1024, 0, 0};
                pg8::EpiR E{nullptr, xb, sx_mlp, SEQ};
                pg8::gemm_phase<pg8::EpiR>(lds, tid, g, G, bx, E);
            } else if (s == 8) {
                pg8::Gemm g{xb, (const bf16_t*)(ws + WS_W1) + (size_t)l * 4096 * 1024, 1024, 1024, 1024, 256, 16, 1, 1, 0, 0, 0, 0, 0};
                pg8::EpiP E{(bf16_t*)(ws + WS_HMID), 4096, NTOK, sx_mlp, 1.0f / (1024.0f * SC_SS), 2, nullptr, 0, 1, 0};
                pg8::gemm_phase<pg8::EpiP>(lds, tid, g, G, bx, E);
            } else {
                pg8::Gemm g{(const bf16_t*)(ws + WS_HMID), (const bf16_t*)(ws + WS_W2) + (size_t)l * 1024 * 4096, 4096, 4096, 4096, 256, 4, 1, 1, 0, 0, 0, 0, 1};
                pg8::EpiR E{(l == 3) ? ap->out : nullptr, xb, (l == 3) ? (u64*)(ws + ST_QST) : sx_next, 0};
                pg8::gemm_phase<pg8::EpiR>(lds, tid, g, G, bx, E);
            }
        }
        }
        if (ph + 1 < args.hi) { if (ph == 0) cg::this_grid().sync(); else xcd_barrier((unsigned*)(ws + ST_BAR), xcc, xst); }
    }
}

constexpr int N_PHASES = 43;
extern "C" void kernel_launch(void* const* d_in, const int* in_sizes, int n_in, void* d_out, int out_size, void* d_ws, size_t ws_size, hipStream_t stream) {
    static int grid = 0;
    if (grid == 0) {
        if (n_in != 29 || ws_size < WS_END) { fprintf(stderr, "kernel_launch: need 29 inputs and %zu bytes of workspace; got %d, %zu\n", (size_t)WS_END, n_in, ws_size); grid = -1; return; }
        int dev = 0, cus = 0, per_cu = 0;
        hipGetDevice(&dev); hipDeviceGetAttribute(&cus, hipDeviceAttributeMultiprocessorCount, dev);
        if (hipFuncSetAttribute((const void*)mk_fwd, hipFuncAttributeMaxDynamicSharedMemorySize, LDS_BYTES) != hipSuccess) { fprintf(stderr, "kernel_launch: hipFuncSetAttribute failed\n"); grid = -1; return; }
        if (hipOccupancyMaxActiveBlocksPerMultiprocessor(&per_cu, (const void*)mk_fwd, 512, LDS_BYTES) != hipSuccess || per_cu < 1) per_cu = 1;
        (void)hipGetLastError();
        grid = cus * per_cu;
        fprintf(stderr, "kernel_launch: grid %d (cus %d x %d)\n", grid, cus, per_cu);
    }
    if (grid < 0) return;
    Args a{};
    for (int i = 0; i < 29; ++i) a.in[i] = (const float*)d_in[i];
    a.out = (float*)d_out; a.ws = (unsigned char*)d_ws;
#if MK_MULTI
    for (int ph = 0; ph < N_PHASES; ++ph) { a.lo = ph; a.hi = ph + 1; hipLaunchKernelGGL(mk_fwd, dim3(grid), dim3(512), LDS_BYTES, stream, a); }
#else
    a.lo = 0; a.hi = N_PHASES;
    if (hipMemsetAsync((char*)d_ws + ST_BAR, 0, 16384, stream) != hipSuccess) { fprintf(stderr, "kernel_launch: memset failed\n"); return; }
    void* kargs[] = {&a};
    hipError_t e = hipLaunchCooperativeKernel((const void*)mk_fwd, dim3(grid), dim3(512), kargs, LDS_BYTES, stream);
    if (e != hipSuccess) fprintf(stderr, "cooperative launch failed: %s (grid %d)\n", hipGetErrorString(e), grid);
#endif
}
```

```cpp
#include <hip/hip_runtime.h>
#include <hip/hip_cooperative_groups.h>
#include <cstdio>
#include <cstdint>
namespace cg = cooperative_groups;

#ifndef MK_MULTI
#define MK_MULTI 0
#endif

#define LAS __attribute__((address_space(3)))
typedef unsigned short bf16_t;
typedef short bf16x8 __attribute__((ext_vector_type(8)));
typedef float f32x4 __attribute__((ext_vector_type(4)));
typedef float f32x2 __attribute__((ext_vector_type(2)));
typedef unsigned u32x4 __attribute__((ext_vector_type(4)));
typedef unsigned u32x2 __attribute__((ext_vector_type(2)));
typedef __bf16 bf16x2_t __attribute__((ext_vector_type(2)));
typedef short v4i16_t __attribute__((ext_vector_type(4)));

constexpr int NTOK = 65536, DM = 1024, SEQ = 4096, NBATCH = 16;
constexpr float EPSF = 1e-6f;
constexpr size_t MiB = 1u << 20;
typedef unsigned long long u64;
constexpr float SC_SS = 1048576.0f, SC_L = 16777216.0f;
constexpr size_t ST_SXZ = 0;
constexpr size_t ST_QST = 11 * 512 * 1024;
constexpr size_t ST_LSUM = ST_QST + 8 * MiB;
constexpr size_t ST_KST = ST_LSUM + 8 * MiB;
constexpr size_t ST_ZERO_BYTES = ST_KST + 1 * MiB;
constexpr size_t ST_SX0 = ST_ZERO_BYTES;
constexpr size_t ST_SMEM = ST_SX0 + 512 * 1024;
constexpr size_t ST_BAR = ST_SX0 + 768 * 1024;
constexpr size_t ST_LSE = 24 * MiB;
constexpr size_t ST_ROPE = 27 * MiB;
constexpr size_t WB = 16 * MiB;
constexpr size_t WS_EVWIN = WB + 16 * MiB, WS_ODWIN = WB + 28 * MiB, WS_EVWOUT = WB + 41 * MiB, WS_ODWOUT = WB + 45 * MiB, WS_WQ = WB + 50 * MiB, WS_WKV = WB + 58 * MiB,
                 WS_WO = WB + 74 * MiB, WS_W1 = WB + 82 * MiB, WS_W2 = WB + 114 * MiB, WS_MEMB = WB + 146 * MiB, WS_KT = WB + 154 * MiB, WS_VT = WB + 186 * MiB, WS_XB = WB + 218 * MiB,
                 WS_A = WB + 346 * MiB;
constexpr size_t WS_P = WS_A, WS_MIX = WS_A + 416 * MiB, WS_KVRAW = WS_A, WS_QX = WS_A, WS_PB = WS_A + 128 * MiB, WS_AO = WS_A + 256 * MiB, WS_HMID = WS_A;
constexpr size_t WS_VP = WS_A + 576 * MiB;
constexpr size_t WS_END = WS_VP + 32 * MiB;
constexpr int LDS_BYTES = 147456;

__device__ __forceinline__ unsigned pk_bf16(float lo, float hi) { f32x2 v = {lo, hi}; bf16x2_t b = __builtin_convertvector(v, bf16x2_t); return __builtin_bit_cast(unsigned, b); }
__device__ __forceinline__ float bf_lo(unsigned u) { return __uint_as_float(u << 16); }
__device__ __forceinline__ float bf_hi(unsigned u) { return __uint_as_float(u & 0xffff0000u); }
__device__ __forceinline__ void unpack8(const u32x4 v, float* f) { f[0] = bf_lo(v.x); f[1] = bf_hi(v.x); f[2] = bf_lo(v.y); f[3] = bf_hi(v.y); f[4] = bf_lo(v.z); f[5] = bf_hi(v.z); f[6] = bf_lo(v.w); f[7] = bf_hi(v.w); }
__device__ __forceinline__ u32x4 pack8(const float* f) { u32x4 w; w.x = pk_bf16(f[0], f[1]); w.y = pk_bf16(f[2], f[3]); w.z = pk_bf16(f[4], f[5]); w.w = pk_bf16(f[6], f[7]); return w; }
__device__ __forceinline__ float sigmoidf_(float x) { return __builtin_amdgcn_rcpf(1.0f + __expf(-x)); }
__device__ __forceinline__ float wave_sum(float v) {
#pragma unroll
    for (int o = 1; o < 64; o <<= 1) v += __shfl_xor(v, o);
    return v;
}
template <int CTRL> __device__ __forceinline__ float dppf(float v) { return __int_as_float(__builtin_amdgcn_update_dpp(0, __float_as_int(v), CTRL, 0xf, 0xf, true)); }
__device__ __forceinline__ float row16_sum(float v) { v += dppf<0x128>(v); v += dppf<0x124>(v); v += dppf<0x122>(v); v += dppf<0x121>(v); return v; }
__device__ __forceinline__ f32x2 gelu_pk(f32x2 v) {
    const f32x2 av = __builtin_elementwise_abs(v), d = av * 0.2316418882f + 1.0f;
    f32x2 t; t.x = __builtin_amdgcn_rcpf(d.x); t.y = __builtin_amdgcn_rcpf(d.y);
    f32x2 q = t * 0.5307027145f + (-0.7265760135f); q = q * t + 0.7107068705f; q = q * t + (-0.142248368f); q = q * t + 0.127414796f; q = q * t;
    const f32x2 s = (v * v) * (-0.72134752044f);
    f32x2 e; e.x = __builtin_amdgcn_exp2f(s.x); e.y = __builtin_amdgcn_exp2f(s.y);
    const f32x2 m = v * (q * e), r = v - m;
    f32x2 o; o.x = v.x < 0.f ? m.x : r.x; o.y = v.y < 0.f ? m.y : r.y; return o;
}

namespace pg8 {
constexpr int BM = 256, BK = 64, HALF = 128, HTB = HALF * BK * 2, STAGE_BYTES = 8 * HTB, WGM = 8;
__host__ __device__ __forceinline__ int lds_byte(int r, int c) { const int st = (r >> 4) * 2 + (c >> 5), rr = r & 15, cc = c & 31, ob = rr * 64 + cc * 2; return st * 1024 + (ob ^ (((ob >> 9) & 1) << 5)); }
__host__ __device__ __forceinline__ void stage_rc(int b, int& R, int& C) { const int st = b / 1024, sb = b % 1024, swz = sb ^ (((sb >> 9) & 1) << 5); R = (st >> 1) * 16 + swz / 64; C = (st & 1) * 32 + (swz % 64) / 2; }
__host__ __device__ __forceinline__ int perm32(int rho) { const int n = rho >> 4, i = rho & 15; return 8 * (i >> 2) + 4 * n + (i & 3); }

struct Unit { int pm, pn, z; };
struct Gemm { const bf16_t* A; const bf16_t* Bt; int lda, ldb, K, nM, nN, nZ, ZL; int sAh, sAl, sBh, sBl; int rev; };
struct Order {
    int nM, nN, per, nwg, G, c, rev;
    __device__ __forceinline__ void init(const Gemm& g, int G_, int c_) { nM = g.nM; nN = g.nN; per = nM * nN; nwg = per * g.nZ; G = G_; c = c_; rev = g.rev; }
    __device__ __forceinline__ bool next(int i, Unit& u) const {
        const long L = (long)i * G + c; if (L >= nwg) return false;
        int w = (int)L;
        if ((nwg & 7) == 0) { const int ch = nwg >> 3, off = w >> 3; w = (w & 7) * ch + (rev ? ch - 1 - off : off); }
        u.z = w / per; const int t = w % per;
        const int nig = WGM * nN, gid = t / nig, fm = gid * WGM, gsz = (nM - fm) < WGM ? (nM - fm) : WGM;
        u.pm = fm + ((t % nig) % gsz); u.pn = (t % nig) / gsz; return true;
    }
};
__device__ __forceinline__ const char* a_ptr(const Gemm& g, const Unit& u) { return (const char*)(g.A + ((u.z / g.ZL) * g.sAh + (u.z % g.ZL) * g.sAl + u.pm * BM * g.lda)); }
__device__ __forceinline__ const char* b_ptr(const Gemm& g, const Unit& u) { return (const char*)(g.Bt + ((u.z / g.ZL) * g.sBh + (u.z % g.ZL) * g.sBl + u.pn * BM * g.ldb)); }

struct EpiP {
    static constexpr bool PERM = true;
    bf16_t* O; int ldc; int Mz; const u64* rstat; float rinv; int act; u64* hstat; int hs_ld; int ZLo; int zcol;
    __device__ __forceinline__ void operator()(f32x4 (&acc)[2][2][4][2], const Unit& u, int wr, int wc, int fr, int fq) const {
        const int row0 = u.pm * BM + wr * 64 + fr, col0 = u.pn * BM + wc * 32 + 8 * fq;
        const bool do_gelu = (act == 1) && (u.pn < 4);
        float rsv[8];
#pragma unroll
        for (int q = 0; q < 8; ++q) rsv[q] = 1.f;
        if (rstat) {
            u64 sv[8];
#pragma unroll
            for (int q = 0; q < 8; ++q) sv[q] = rstat[row0 + (q >> 2) * HALF + (q & 3) * 16];
#pragma unroll
            for (int q = 0; q < 8; ++q) rsv[q] = rsqrtf((float)sv[q] * rinv + EPSF);
        }
        asm volatile("" ::: "memory");
#pragma unroll
        for (int ai = 0; ai < 2; ++ai)
#pragma unroll
            for (int m = 0; m < 4; ++m) {
                const int row = row0 + ai * HALF + m * 16;
                const float rs = rsv[ai * 4 + m];
                float hs = 0.f;
                bf16_t* rowp = O + ((long)(u.z / ZLo) * Mz + row) * ldc + (u.z % ZLo) * zcol + col0;
#pragma unroll
                for (int bj = 0; bj < 2; ++bj) {
                    f32x4 v0 = acc[ai][bj][m][0] * rs, v1 = acc[ai][bj][m][1] * rs;
                    if (do_gelu) { f32x2 a = gelu_pk((f32x2){v0[0], v0[1]}), b = gelu_pk((f32x2){v0[2], v0[3]}), c = gelu_pk((f32x2){v1[0], v1[1]}), d = gelu_pk((f32x2){v1[2], v1[3]});
                        v0 = (f32x4){a.x, a.y, b.x, b.y}; v1 = (f32x4){c.x, c.y, d.x, d.y}; }
                    else if (act == 2) {
#pragma unroll
                        for (int i = 0; i < 4; ++i) { const float a = fmaxf(v0[i], 0.f), b = fmaxf(v1[i], 0.f); v0[i] = a * a; v1[i] = b * b; } }
                    hs += (v0[0] * v0[0] + v0[1] * v0[1]) + (v0[2] * v0[2] + v0[3] * v0[3]) + (v1[0] * v1[0] + v1[1] * v1[1]) + (v1[2] * v1[2] + v1[3] * v1[3]);
                    u32x4 w; w.x = pk_bf16(v0[0], v0[1]); w.y = pk_bf16(v0[2], v0[3]); w.z = pk_bf16(v1[0], v1[1]); w.w = pk_bf16(v1[2], v1[3]);
                    *(u32x4*)(rowp + bj * HALF) = w;
                }
                if (hstat) { hs += __shfl_xor(hs, 16); hs += __shfl_xor(hs, 32); if (fq == 0) atomicAdd(hstat + ((long)u.z * Mz + row) * hs_ld + u.pn, (u64)(hs * SC_SS + 0.5f)); }
            }
    }
};
struct EpiS {
    static constexpr bool PERM = true;
    bf16_t* P; const u64* qstat; LAS float* xch;
    __device__ __forceinline__ void operator()(f32x4 (&acc)[2][2][4][2], const Unit& u, int wr, int wc, int fr, int fq) const {
        const int b = u.z >> 2, h = u.z & 3;
        const int row0 = b * SEQ + u.pm * BM + wr * 64 + fr, col0 = h * 256 + wc * 32 + 8 * fq;
        float rsv[8];
        { u64 sv[8];
#pragma unroll
          for (int q = 0; q < 8; ++q) sv[q] = qstat[(long)(row0 + (q >> 2) * HALF + (q & 3) * 16) * 4 + h];
#pragma unroll
          for (int q = 0; q < 8; ++q) rsv[q] = rsqrtf((float)sv[q] * (1.0f / (256.0f * SC_SS)) + EPSF) * 1.4426950408889634f; }
#pragma unroll
        for (int ai = 0; ai < 2; ++ai)
#pragma unroll
            for (int m = 0; m < 4; ++m) {
                const int rl = ai * HALF + wr * 64 + m * 16 + fr;
                const float rs = rsv[ai * 4 + m];
                float sum = 0.f;
#pragma unroll
                for (int bj = 0; bj < 2; ++bj)
#pragma unroll
                    for (int n = 0; n < 2; ++n)
#pragma unroll
                        for (int i = 0; i < 4; ++i) { const float e = __builtin_amdgcn_exp2f(acc[ai][bj][m][n][i] * rs); acc[ai][bj][m][n][i] = e; sum += e; }
                sum += __shfl_xor(sum, 16); sum += __shfl_xor(sum, 32);
                if (fq == 0) xch[rl * 4 + wc] = sum;
            }
        asm volatile("s_waitcnt lgkmcnt(0)" ::: "memory"); __builtin_amdgcn_s_barrier(); asm volatile("" ::: "memory");
#pragma unroll
        for (int ai = 0; ai < 2; ++ai)
#pragma unroll
            for (int m = 0; m < 4; ++m) {
                const int row = row0 + ai * HALF + m * 16, rl = ai * HALF + wr * 64 + m * 16 + fr;
                const f32x4 t = *(const LAS f32x4*)(xch + rl * 4);
                const float inv = 1.0f / ((t[0] + t[1]) + (t[2] + t[3]));
                bf16_t* rowp = P + (long)row * 1024 + col0;
#pragma unroll
                for (int bj = 0; bj < 2; ++bj) {
                    const f32x4 v0 = acc[ai][bj][m][0] * inv, v1 = acc[ai][bj][m][1] * inv;
                    u32x4 w; w.x = pk_bf16(v0[0], v0[1]); w.y = pk_bf16(v0[2], v0[3]); w.z = pk_bf16(v1[0], v1[1]); w.w = pk_bf16(v1[2], v1[3]);
                    *(u32x4*)(rowp + bj * HALF) = w;
                }
            }
    }
};
struct EpiO {
    static constexpr bool PERM = true;
    bf16_t* O; const u64* lsum;
    __device__ __forceinline__ void operator()(f32x4 (&acc)[2][2][4][2], const Unit& u, int wr, int wc, int fr, int fq) const {
        const int b = u.z >> 2, h = u.z & 3;
        const int row0 = b * SEQ + u.pm * BM + wr * 64 + fr, col0 = h * 256 + wc * 32 + 8 * fq;
#pragma unroll
        for (int ai = 0; ai < 2; ++ai)
#pragma unroll
            for (int m = 0; m < 4; ++m) {
                const int row = row0 + ai * HALF + m * 16;
                const float inv = SC_L / (float)lsum[(long)row * 4 + h];
                bf16_t* rowp = O + (long)row * 1024 + col0;
#pragma unroll
                for (int bj = 0; bj < 2; ++bj) {
                    const f32x4 v0 = acc[ai][bj][m][0] * inv, v1 = acc[ai][bj][m][1] * inv;
                    u32x4 w; w.x = pk_bf16(v0[0], v0[1]); w.y = pk_bf16(v0[2], v0[3]); w.z = pk_bf16(v1[0], v1[1]); w.w = pk_bf16(v1[2], v1[3]);
                    *(u32x4*)(rowp + bj * HALF) = w;
                }
            }
    }
};
struct EpiR {
    static constexpr bool PERM = true;
    float* out; bf16_t* xb; u64* stat; int Mz;
    __device__ __forceinline__ bool can_repeat() const { return false; }
    __device__ __forceinline__ void operator()(f32x4 (&acc)[2][2][4][2], const Unit& u, int wr, int wc, int fr, int fq) const {
        const int row0 = u.z * Mz + u.pm * BM + wr * 64 + fr, col0 = u.pn * BM + wc * 32 + 8 * fq;
#pragma unroll
        for (int ai = 0; ai < 2; ++ai) {
            u32x4 xv[4][2];
#pragma unroll
            for (int m = 0; m < 4; ++m)
#pragma unroll
                for (int bj = 0; bj < 2; ++bj) xv[m][bj] = *(const u32x4*)(xb + (size_t)(row0 + ai * HALF + m * 16) * DM + col0 + bj * HALF);
            asm volatile("" ::: "memory");
#pragma unroll
            for (int m = 0; m < 4; ++m) {
                const int row = row0 + ai * HALF + m * 16; const size_t off = (size_t)row * DM + col0;
                float ss = 0.f;
#pragma unroll
                for (int bj = 0; bj < 2; ++bj) {
                    float f[8]; unpack8(xv[m][bj], f);
#pragma unroll
                    for (int i = 0; i < 4; ++i) { f[i] += acc[ai][bj][m][0][i]; f[4 + i] += acc[ai][bj][m][1][i]; }
#pragma unroll
                    for (int i = 0; i < 8; ++i) ss += f[i] * f[i];
                    *(u32x4*)(xb + off + bj * HALF) = pack8(f);
                    if (out) { *(f32x4*)(out + off + bj * HALF) = (f32x4){f[0], f[1], f[2], f[3]}; *(f32x4*)(out + off + bj * HALF + 4) = (f32x4){f[4], f[5], f[6], f[7]}; }
                }
                ss += __shfl_xor(ss, 16); ss += __shfl_xor(ss, 32);
                if (fq == 0) atomicAdd(stat + row, (u64)(ss * SC_SS + 0.5f));
            }
        }
    }
};

template <class Epi>
__device__ __forceinline__ void gemm_phase(LAS unsigned char* lds, const int tid, const Gemm g, const int G, const int cidx, const Epi& E) {
    const int wid = __builtin_amdgcn_readfirstlane(tid >> 6), lane = tid & 63, wr = wid >> 2, wc = wid & 3, fr = lane & 15, fq = lane >> 4;
    Order S; S.init(g, G, cidx);
    const int K = g.K, nt = K / BK;
    unsigned voffA[2], voffB[2];
#pragma unroll
    for (int i = 0; i < 2; ++i) { int R, C; stage_rc(tid * 16 + i * 8192, R, C); const int Rb = Epi::PERM ? ((R & ~31) + perm32(R & 31)) : R;
        voffA[i] = (unsigned)(R * g.lda + C) * 2u; voffB[i] = (unsigned)(Rb * g.ldb + C) * 2u; }
    const size_t kstep = (size_t)(BK * 2);
    const size_t hstepA = (size_t)HALF * g.lda * 2, hstepB = (size_t)HALF * g.ldb * 2;
    const unsigned ldsw = (unsigned)wid * 1024u;
    const int aoff = lds_byte(wr * 64 + fr, fq * 8), boff = lds_byte(wc * 32 + fr, fq * 8);
#define PG8_SA(b, h) (((b) * 2 + (h)) * HTB)
#define PG8_SB(b, h) ((4 + (b) * 2 + (h)) * HTB)
#define PG8_STAGE(bufoff, gbase, voff) do { _Pragma("unroll") for (int _i = 0; _i < 2; ++_i) \
        __builtin_amdgcn_global_load_lds((const unsigned*)((const char*)(gbase) + (voff)[_i]), (LAS unsigned*)(lds + (bufoff) + ldsw + _i * 8192), 16, 0, 0); } while (0)
#define PG8_LDA(dst, b, h) do { _Pragma("unroll") for (int m = 0; m < 4; ++m) _Pragma("unroll") for (int k = 0; k < 2; ++k) dst[m][k] = *(const LAS bf16x8*)(lds + PG8_SA(b, h) + aoff + m * 2048 + k * 1024); } while (0)
#define PG8_LDB(dst, b, h) do { _Pragma("unroll") for (int n = 0; n < 2; ++n) _Pragma("unroll") for (int k = 0; k < 2; ++k) dst[n][k] = *(const LAS bf16x8*)(lds + PG8_SB(b, h) + boff + n * 2048 + k * 1024); } while (0)
#define PG8_MMA(ai, bj, At, Bt) do { __builtin_amdgcn_s_setprio(1); _Pragma("unroll") for (int m = 0; m < 4; ++m) _Pragma("unroll") for (int n = 0; n < 2; ++n) _Pragma("unroll") for (int k = 0; k < 2; ++k) \
        acc[ai][bj][m][n] = __builtin_amdgcn_mfma_f32_16x16x32_bf16(Bt[n][k], At[m][k], acc[ai][bj][m][n], 0, 0, 0); __builtin_amdgcn_s_setprio(0); } while (0)
#define PG8_WAIT_V(n) asm volatile("s_waitcnt vmcnt(" #n ")" ::: "memory")
#define PG8_WAIT_L(n) asm volatile("s_waitcnt lgkmcnt(" #n ")" ::: "memory")
#define PG8_BAR __builtin_amdgcn_s_barrier()
#define PG8_SCHED __builtin_amdgcn_sched_barrier(0)
    Unit cur, nxt; int ui = 0;
    if (!S.next(0, cur)) return;
    f32x4 acc[2][2][4][2];
#pragma unroll
    for (int a = 0; a < 2; ++a)
#pragma unroll
        for (int b = 0; b < 2; ++b)
#pragma unroll
            for (int m = 0; m < 4; ++m)
#pragma unroll
                for (int n = 0; n < 2; ++n) acc[a][b][m][n] = (f32x4){0.f, 0.f, 0.f, 0.f};
    bf16x8 At[4][2], B0[2][2], B1[2][2];
    const char* cA = a_ptr(g, cur); const char* cB = b_ptr(g, cur);
    PG8_STAGE(PG8_SB(0, 0), cB, voffB); PG8_STAGE(PG8_SB(0, 1), cB + hstepB, voffB); PG8_STAGE(PG8_SA(0, 0), cA, voffA); PG8_STAGE(PG8_SA(0, 1), cA + hstepA, voffA);
    if (wr == 1) PG8_BAR;
    PG8_WAIT_V(2); PG8_BAR;
    PG8_STAGE(PG8_SB(1, 0), cB + kstep, voffB); PG8_STAGE(PG8_SA(1, 0), cA + kstep, voffA); PG8_STAGE(PG8_SB(1, 1), cB + hstepB + kstep, voffB);
    PG8_WAIT_V(6); PG8_BAR;
    for (;;) {
        const bool has_next = S.next(ui + 1, nxt);
        const char* nA = has_next ? a_ptr(g, nxt) : cA; const char* nB = has_next ? b_ptr(g, nxt) : cB;
        for (int t = 0; t < nt; t += 2) {
            const bool last = (t == nt - 2);
            const char* a1 = cA + (size_t)(t + 1) * kstep;
            const char* a2 = last ? nA : cA + (size_t)(t + 2) * kstep; const char* b2 = last ? nB : cB + (size_t)(t + 2) * kstep;
            const char* a3 = a2 + kstep; const char* b3 = b2 + kstep;
            PG8_LDB(B0, 0, 0); PG8_LDB(B1, 0, 1); PG8_SCHED; PG8_LDA(At, 0, 0); PG8_STAGE(PG8_SA(1, 1), a1 + hstepA, voffA);
            PG8_WAIT_V(8); PG8_WAIT_L(0); PG8_BAR; PG8_MMA(0, 0, At, B0); PG8_MMA(0, 1, At, B1); PG8_BAR; PG8_SCHED;
            PG8_LDA(At, 0, 1); PG8_STAGE(PG8_SB(0, 0), b2, voffB); PG8_STAGE(PG8_SB(0, 1), b2 + hstepB, voffB); PG8_STAGE(PG8_SA(0, 0), a2, voffA);
            PG8_WAIT_V(8); PG8_WAIT_L(0); PG8_BAR; PG8_MMA(1, 0, At, B0); PG8_MMA(1, 1, At, B1); PG8_BAR; PG8_SCHED;
            PG8_LDB(B0, 1, 0); PG8_LDB(B1, 1, 1); PG8_SCHED; PG8_LDA(At, 1, 0); PG8_STAGE(PG8_SA(0, 1), a2 + hstepA, voffA);
            PG8_WAIT_V(8); PG8_WAIT_L(0); PG8_BAR; PG8_MMA(0, 0, At, B0); PG8_MMA(0, 1, At, B1); PG8_BAR; PG8_SCHED;
            PG8_LDA(At, 1, 1); PG8_STAGE(PG8_SB(1, 0), b3, voffB); PG8_STAGE(PG8_SB(1, 1), b3 + hstepB, voffB); PG8_STAGE(PG8_SA(1, 0), a3, voffA);
            PG8_WAIT_V(8); PG8_WAIT_L(0); PG8_BAR; PG8_MMA(1, 0, At, B0); PG8_MMA(1, 1, At, B1); PG8_BAR; PG8_SCHED;
        }
        if (wr == 0) PG8_BAR;
        E(acc, cur, wr, wc, fr, fq);
        if (!has_next) break;
#pragma unroll
        for (int a = 0; a < 2; ++a)
#pragma unroll
            for (int b = 0; b < 2; ++b)
#pragma unroll
                for (int m = 0; m < 4; ++m)
#pragma unroll
                    for (int n = 0; n < 2; ++n) acc[a][b][m][n] = (f32x4){0.f, 0.f, 0.f, 0.f};
        cur = nxt; cA = nA; cB = nB; ++ui;
        if (wr == 1) PG8_BAR;
    }
    PG8_WAIT_V(0);
    PG8_BAR;
#undef PG8_SA
#undef PG8_SB
#undef PG8_STAGE
#undef PG8_LDA
#undef PG8_LDB
#undef PG8_MMA
#undef PG8_WAIT_V
#undef PG8_WAIT_L
#undef PG8_BAR
#undef PG8_SCHED
}
}

struct Args { const float* in[29]; float* out; unsigned char* ws; int lo, hi; };

__device__ __forceinline__ void transpose_item(const float* W, int K, int N, const float* gain, bf16_t* WT, LAS float* scr, int item, int lane) {
    const int nblk = N / 32, kb = item / nblk, nb = item % nblk, k0 = 64 * kb, n0 = 32 * nb;
#pragma unroll 8
    for (int i = 0; i < 32; ++i) { const int kk = 2 * i + (lane >> 5); float v = W[(size_t)(k0 + kk) * N + n0 + (lane & 31)]; if (gain) v *= gain[k0 + kk]; scr[kk * 33 + (lane & 31)] = v; }
    asm volatile("s_waitcnt lgkmcnt(0)" ::: "memory");
    const int c = lane & 7;
#pragma unroll
    for (int j = 0; j < 4; ++j) { const int n = (lane >> 3) + 8 * j; const LAS float* s = scr + (8 * c) * 33 + n;
        u32x4 o; o.x = pk_bf16(s[0 * 33], s[1 * 33]); o.y = pk_bf16(s[2 * 33], s[3 * 33]); o.z = pk_bf16(s[4 * 33], s[5 * 33]); o.w = pk_bf16(s[6 * 33], s[7 * 33]);
        *(u32x4*)(WT + (size_t)(n0 + n) * K + k0 + 8 * c) = o; }
    asm volatile("s_waitcnt lgkmcnt(0)" ::: "memory");
}
__device__ __forceinline__ void transpose_all(const float* W, int K, int N, const float* gain, bf16_t* WT, LAS float* scr, int gw, int NGW, int lane) {
    const int nitems = (K / 64) * (N / 32);
    for (int it = gw; it < nitems; it += NGW) transpose_item(W, K, N, gain, WT, scr, it, lane);
}
__device__ __forceinline__ void row_to_bf16(const float* xrow, bf16_t* orow, u64* ss, int lane) {
    const f32x4* xr = (const f32x4*)xrow + lane; float s = 0.f; f32x4 v[4];
#pragma unroll
    for (int j = 0; j < 4; ++j) { v[j] = xr[64 * j]; s += (v[j].x * v[j].x + v[j].y * v[j].y) + (v[j].z * v[j].z + v[j].w * v[j].w); }
    s = wave_sum(s);
    u32x2* o8 = (u32x2*)orow + lane;
#pragma unroll
    for (int j = 0; j < 4; ++j) { u32x2 w; w.x = pk_bf16(v[j].x, v[j].y); w.y = pk_bf16(v[j].z, v[j].w); o8[64 * j] = w; }
    if (lane == 0) *ss = (u64)(s * SC_SS + 0.5f);
}

__device__ __forceinline__ void transpose_layer(const __attribute__((address_space(4))) Args* ap, unsigned char* ws, int l, LAS float* scr, int gw, int NGW, int lane) {
    const int e = l >> 1;
    if (l & 1) {
        transpose_all(ap->in[11] + (size_t)e * 1024 * 3328, 1024, 3328, ap->in[2] + l * 1024, (bf16_t*)(ws + WS_ODWIN) + (size_t)e * 3328 * 1024, scr, gw, NGW, lane);
        transpose_all(ap->in[18] + (size_t)e * 1280 * 1024, 1280, 1024, nullptr, (bf16_t*)(ws + WS_ODWOUT) + (size_t)e * 1024 * 1280, scr, gw, NGW, lane);
    } else {
        transpose_all(ap->in[3] + (size_t)e * 1024 * 3072, 1024, 3072, ap->in[2] + l * 1024, (bf16_t*)(ws + WS_EVWIN) + (size_t)e * 3072 * 1024, scr, gw, NGW, lane);
        transpose_all(ap->in[10] + (size_t)e * 1024 * 1024, 1024, 1024, nullptr, (bf16_t*)(ws + WS_EVWOUT) + (size_t)e * 1024 * 1024, scr, gw, NGW, lane);
    }
    transpose_all(ap->in[21] + (size_t)l * 1024 * 1024, 1024, 1024, ap->in[19] + l * 1024, (bf16_t*)(ws + WS_WQ) + (size_t)l * 1024 * 1024, scr, gw, NGW, lane);
    transpose_all(ap->in[25] + (size_t)l * 1024 * 1024, 1024, 1024, nullptr, (bf16_t*)(ws + WS_WO) + (size_t)l * 1024 * 1024, scr, gw, NGW, lane);
    transpose_all(ap->in[27] + (size_t)l * 1024 * 4096, 1024, 4096, ap->in[26] + l * 1024, (bf16_t*)(ws + WS_W1) + (size_t)l * 4096 * 1024, scr, gw, NGW, lane);
    transpose_all(ap->in[28] + (size_t)l * 4096 * 1024, 4096, 1024, nullptr, (bf16_t*)(ws + WS_W2) + (size_t)l * 1024 * 4096, scr, gw, NGW, lane);
}

#define XB_TMO      128
#define XB_XCNT(j)  (256  + 64 * (j))
#define XB_XSUB(j)  (1280 + 64 * (j))
#define XB_XGEN(j)  (2304 + 64 * (j))
#define XB_TOP      3328
#define XB_TOPGEN   3392
#define XCD_BAR_WORDS 3456
#define XB_SPIN_CAP (1u << 22)
__device__ __forceinline__ unsigned xb_ld(unsigned* p)              { return __hip_atomic_load(p, __ATOMIC_RELAXED, __HIP_MEMORY_SCOPE_AGENT); }
__device__ __forceinline__ unsigned xb_add(unsigned* p, unsigned v) { return __hip_atomic_fetch_add(p, v, __ATOMIC_RELAXED, __HIP_MEMORY_SCOPE_AGENT); }
__device__ __forceinline__ unsigned xb_xcc_id() { return (unsigned)__builtin_amdgcn_s_getreg((3 << 11) | 20) & 0xFu; }
#define XB_SPIN(cond, bar) do { unsigned _sp = 0; while (cond) { __builtin_amdgcn_s_sleep(1); \
    if ((++_sp & 255u) == 0u) { if (xb_ld(&(bar)[XB_TMO])) break; if (_sp > XB_SPIN_CAP) { atomicAdd(&(bar)[XB_TMO], 1u); break; } } } } while (0)
__device__ __forceinline__ void xcd_barrier_complete(unsigned* bar, unsigned x, unsigned& nloc, unsigned& nx) {
    const unsigned G = gridDim.x * gridDim.y * gridDim.z;
    unsigned sum, cnt, mine, sp = 0u;
    for (;;) {
        sum = 0u; cnt = 0u; mine = 0u;
#pragma unroll
        for (unsigned j = 0; j < 16; ++j) { const unsigned c = xb_ld(&bar[XB_XCNT(j)]); sum += c; cnt += (c > 0u) ? 1u : 0u; mine = (j == x) ? c : mine; }
        if (sum == G) break;
        __builtin_amdgcn_s_sleep(1);
        if ((++sp & 255u) == 0u) { if (xb_ld(&bar[XB_TMO])) break; if (sp > XB_SPIN_CAP) { atomicAdd(&bar[XB_TMO], 1u); break; } }
    }
    nloc = mine > 0u ? mine : 1u; nx = cnt > 0u ? cnt : 1u;
}
__device__ __forceinline__ void xcd_barrier(unsigned* bar, unsigned x, volatile LAS unsigned* st) {
    asm volatile("s_waitcnt vmcnt(0)" ::: "memory");
    __syncthreads();
    if (threadIdx.x == 0) {
        __builtin_amdgcn_s_waitcnt(0);
        unsigned nloc = st[0], nx = st[1];
        if (nloc == 0u) { xcd_barrier_complete(bar, x, nloc, nx); st[0] = nloc; st[1] = nx; }
        const unsigned old = xb_add(&bar[XB_XSUB(x)], 1u);
        const unsigned gen = old / nloc;
        if (old + 1u == (gen + 1u) * nloc) {
            __builtin_amdgcn_fence(__ATOMIC_RELEASE, "agent");
            asm volatile("s_waitcnt vmcnt(0)" ::: "memory");
            const unsigned og = xb_add(&bar[XB_TOP], 1u);
            const unsigned tg = og / nx;
            if (og + 1u == (tg + 1u) * nx) xb_add(&bar[XB_TOPGEN], 1u);
            else XB_SPIN(xb_ld(&bar[XB_TOPGEN]) == tg, bar);
            __builtin_amdgcn_fence(__ATOMIC_ACQUIRE, "agent");
            xb_add(&bar[XB_XGEN(x)], 1u);
            asm volatile("s_waitcnt vmcnt(0)" ::: "memory");
        } else {
            XB_SPIN(xb_ld(&bar[XB_XGEN(x)]) == gen, bar);
            __builtin_amdgcn_fence(__ATOMIC_ACQUIRE, "agent");
            asm volatile("s_waitcnt vmcnt(0)" ::: "memory");
        }
    }
    __syncthreads();
}

__global__ void __launch_bounds__(512, 2) mk_fwd(Args args) {
    extern __shared__ __attribute__((aligned(16))) unsigned char lds_raw[];
    LAS unsigned char* lds = (LAS unsigned char*)lds_raw;
    volatile LAS unsigned* const xst = (volatile LAS unsigned*)((LAS unsigned char*)lds_raw + LDS_BYTES - 64);
    if (threadIdx.x < 2) xst[threadIdx.x] = 0u;
    const unsigned xcc = xb_xcc_id();
    if (args.hi - args.lo > 1 && threadIdx.x == 0) (void)xb_add((unsigned*)(args.ws + ST_BAR) + XB_XCNT(xcc), 1u);
    __syncthreads();
    const __attribute__((address_space(4))) Args* const ap0 = (const __attribute__((address_space(4))) Args*)__builtin_amdgcn_kernarg_segment_ptr();
#ifdef REP_MASK
    for (int ph2 = args.lo * 2; ph2 < args.hi * 2; ++ph2) { const int ph = ph2 >> 1;
    if ((ph2 & 1) && !(ph >= 3 && ((REP_MASK >> ((ph - 3) % 10)) & 1) && ((REP_ODD >> (((ph - 3) / 10) & 1)) & 1))) continue;
#else
    for (int ph = args.lo; ph < args.hi; ++ph) {
#endif
    const __attribute__((address_space(4))) Args* ap = ap0; asm volatile("" : "+s"(ap));
    int tid = threadIdx.x; asm volatile("" : "+v"(tid));
    const int lane = tid & 63, wave = __builtin_amdgcn_readfirstlane(tid >> 6);
    int G = gridDim.x, bx = blockIdx.x; asm volatile("" : "+s"(G), "+s"(bx));
    const int vcu = (G % 8 == 0) ? (bx % 8) * (G / 8) + bx / 8 : bx;
    unsigned char* ws = ap->ws;
    u64* const st_sxz = (u64*)(ws + ST_SXZ); u64* const st_sx0 = (u64*)(ws + ST_SX0);
    bf16_t* const xb = (bf16_t*)(ws + WS_XB);
    bf16_t* const pbuf = (bf16_t*)(ws + WS_P); bf16_t* const mix = (bf16_t*)(ws + WS_MIX);
    float* const rope = (float*)(ws + ST_ROPE); float* const lse = (float*)(ws + ST_LSE);
    {
#ifdef ONLY_S
        if (ph < 0) {
#else
        if (ph == 0) {
#endif
            const int gw = vcu * 8 + wave, NGW = G * 8;
            { u32x4* z = (u32x4*)ws; const size_t n16 = ST_ZERO_BYTES / 16; for (size_t i = (size_t)bx * 512 + tid; i < n16; i += (size_t)G * 512) z[i] = (u32x4){0u, 0u, 0u, 0u}; }
            for (int m = gw * 2; m < NTOK; m += NGW * 2) {
                const f32x4* x0 = (const f32x4*)(ap->in[0] + (size_t)m * DM) + lane; const f32x4* x1 = x0 + DM / 4;
                f32x4 v[8];
#pragma unroll
                for (int j = 0; j < 4; ++j) { v[j] = x0[64 * j]; v[4 + j] = x1[64 * j]; }
                float s0 = 0.f, s1 = 0.f;
#pragma unroll
                for (int j = 0; j < 4; ++j) { s0 += (v[j].x * v[j].x + v[j].y * v[j].y) + (v[j].z * v[j].z + v[j].w * v[j].w); s1 += (v[4 + j].x * v[4 + j].x + v[4 + j].y * v[4 + j].y) + (v[4 + j].z * v[4 + j].z + v[4 + j].w * v[4 + j].w); }
                s0 = wave_sum(s0); s1 = wave_sum(s1);
                u32x2* o0 = (u32x2*)(xb + (size_t)m * DM) + lane; u32x2* o1 = o0 + DM / 4;
#pragma unroll
                for (int j = 0; j < 4; ++j) { u32x2 w; w.x = pk_bf16(v[j].x, v[j].y); w.y = pk_bf16(v[j].z, v[j].w); o0[64 * j] = w; u32x2 w1; w1.x = pk_bf16(v[4 + j].x, v[4 + j].y); w1.y = pk_bf16(v[4 + j].z, v[4 + j].w); o1[64 * j] = w1; }
                if (lane == 0) { st_sx0[m] = (u64)(s0 * SC_SS + 0.5f); st_sx0[m + 1] = (u64)(s1 * SC_SS + 0.5f); }
            }
            { bf16_t* memb = (bf16_t*)(ws + WS_MEMB); u64* smem = (u64*)(ws + ST_SMEM);
              for (int m = gw; m < 4096; m += NGW) row_to_bf16(ap->in[1] + (size_t)m * DM, memb + (size_t)m * DM, smem + m, lane); }
            LAS float* scr = (LAS float*)(lds + wave * 16384);
            for (int l = 0; l < 4; ++l)
                transpose_all(ap->in[22] + (size_t)l * 1024 * 2048, 1024, 2048, ap->in[20] + l * 1024, (bf16_t*)(ws + WS_WKV) + (size_t)l * 2048 * 1024, scr, gw, NGW, lane);
            for (int l = 0; l < ((G >= 128) ? 1 : 4); ++l) transpose_layer(ap, ws, l, scr, gw, NGW, lane);
            for (int i = bx * 512 + tid; i < 4096 * 8; i += G * 512) {
                const int t = i >> 3, j = i & 7;
                const float invf[8] = {1.0f, 0.19392274474868576f, 0.03760603093086393f, 0.007292664737217109f, 0.001414213562373095f, 0.0002742481756762073f, 5.318295896944988e-05f, 1.031338537721246e-05f};
                float fj = invf[0];
#pragma unroll
                for (int q = 1; q < 8; ++q) fj = (j == q) ? invf[q] : fj;
                const float ang = (float)t * fj;
                const double a = (double)ang; const double k = __builtin_rint(a * 0.15915494309189535); const float r = (float)(a - k * 6.283185307179586);
                rope[t * 16 + j] = __cosf(r); rope[t * 16 + 8 + j] = __sinf(r);
            }
#ifdef ONLY_S
        } else if (ph < 0) {
#else
        } else if (ph == 1) {
#endif
            pg8::Gemm g{(const bf16_t*)(ws + WS_MEMB), (const bf16_t*)(ws + WS_WKV), 1024, 1024, 1024, 16, 8, 4, 1, 0, 0, 2048 * 1024, 0, 0};
            pg8::EpiP E{(bf16_t*)(ws + WS_KVRAW), 2048, 4096, (const u64*)(ws + ST_SMEM), 1.0f / (1024.0f * SC_SS), 0, (u64*)(ws + ST_KST), 8, 1, 0};
            pg8::gemm_phase<pg8::EpiP>(lds, tid, g, G, bx, E);
#ifdef ONLY_S
        } else if (ph < 0) {
#else
        } else if (ph == 2) {
#endif
            const int gw = vcu * 8 + wave, NGW = G * 8;
            const bf16_t* kvraw = (const bf16_t*)(ws + WS_KVRAW); bf16_t* kt = (bf16_t*)(ws + WS_KT); bf16_t* vt = (bf16_t*)(ws + WS_VT); const u64* kst = (const u64*)(ws + ST_KST);
            for (int r = gw; r < 4 * 4096; r += NGW) {
                const int l = r >> 12;
                const float* gk = ap->in[24] + l * 256; const float* gq = ap->in[23] + l * 256;
#pragma unroll
                for (int c2 = 0; c2 < 2; ++c2) {
                    const int ch = lane + 64 * c2, h = ch >> 5, e0 = (ch & 31) * 8;
                    const float rs = rsqrtf((float)kst[(size_t)r * 8 + h] * (1.0f / (256.0f * SC_SS)) + EPSF) * 0.0625f;
                    const u32x4 raw = *(const u32x4*)(kvraw + (size_t)r * 2048 + ch * 8); float f[8]; unpack8(raw, f);
#pragma unroll
                    for (int i = 0; i < 8; ++i) f[i] = f[i] * rs * gk[e0 + i] * gq[e0 + i];
                    *(u32x4*)(kt + (size_t)r * 1024 + ch * 8) = pack8(f);
                }
            }
            for (int idx = bx * 512 + tid; idx < 4 * 4096 * 128; idx += G * 512) {
                const int ch = idx & 127, r = idx >> 7;
                *(u32x4*)(vt + (size_t)r * 1024 + ch * 8) = *(const u32x4*)(kvraw + (size_t)r * 2048 + 1024 + ch * 8);
            }
        } else {
            #ifdef ONLY_S
            const int l = (ph - 3) / 10, s = ONLY_S, odd = ONLY_ODD, eo = l >> 1;
#else
            const int l = (ph - 3) / 10, s = (ph - 3) % 10, odd = l & 1, eo = l >> 1;
#endif
            u64* const sx_mix = (l == 0) ? st_sx0 : st_sxz + (size_t)(3 * l - 1) * NTOK;
            u64* const sx_xat = st_sxz + (size_t)(3 * l) * NTOK;
            u64* const sx_mlp = st_sxz + (size_t)(3 * l + 1) * NTOK;
            u64* const sx_next = st_sxz + (size_t)(3 * l + 2) * NTOK;
            u64* const qst = (u64*)(ws + ST_QST) + (size_t)l * NTOK * 4;
            u64* const lsum = (u64*)(ws + ST_LSUM) + (size_t)l * NTOK * 4;
            const int PW = odd ? 3328 : 3072, MW = odd ? 1280 : 1024;
            if (s == 6) continue;
            if (s == 0) {
                const bf16_t* wt = odd ? (const bf16_t*)(ws + WS_ODWIN) + (size_t)eo * 3328 * 1024 : (const bf16_t*)(ws + WS_EVWIN) + (size_t)eo * 3072 * 1024;
                pg8::Gemm g{xb, wt, 1024, 1024, 1024, 256, PW / 256, 1, 1, 0, 0, 0, 0, 0};
                pg8::EpiP E{pbuf, PW, NTOK, sx_mix, 1.0f / (1024.0f * SC_SS), odd ? 1 : 0, nullptr, 0, 1, 0};
                pg8::Gemm gv{(const bf16_t*)(ws + WS_WO) + (size_t)l * 1024 * 1024, (const bf16_t*)(ws + WS_VT) + (size_t)l * 4096 * 1024, 1024, 1024, 256, 4, 1, 64, 4, 0, 256, 256 * 1024, 256, 0};
                pg8::EpiP Ev{(bf16_t*)(ws + WS_VP), 1024, 1024, nullptr, 0.f, 0, nullptr, 0, 4, 256};
#pragma unroll 1
                for (int pass = 0; pass < 2; ++pass)
                    pg8::gemm_phase<pg8::EpiP>(lds, tid, pass ? gv : g, G, bx, pass ? Ev : E);
            } else if (s == 1 && !odd) {
#if !defined(NO_HGRN)
                {
                    const int fr = lane & 15, fq = lane >> 4, tr_r = (lane & 15) >> 2, tr_c = lane & 3;
                    const int kch = tid >> 2, tq = tid & 3;
                    constexpr int HB = 17920;
                    for (int item = vcu; item < 64; item += G) {
                        const int b = item >> 2, h = item & 3;
                        float lbv = 0.f; if (eo == 1) { const int c = h * 128 + kch; lbv = sigmoidf_(ap->in[8][512 + c] - ap->in[8][c]); }
                        f32x4 Sacc[8];
#pragma unroll
                        for (int kt = 0; kt < 8; ++kt) Sacc[kt] = (f32x4){0.f, 0.f, 0.f, 0.f};
                        const bf16_t* pq = pbuf + ((size_t)b * SEQ + 4 * tq) * 3072 + 1024 + h * 128 + kch;
                        const bf16_t* pi = pbuf + ((size_t)b * SEQ + (tid >> 5)) * 3072 + 2048 + h * 128 + (tid & 31) * 4;
                        unsigned rqr[4], rfr[4]; u32x2 rir;
#define HG_LOAD(blk_) do { const bf16_t* p_ = pq + (size_t)(blk_) * 16 * 3072; \
                            _Pragma("unroll") for (int j = 0; j < 4; ++j) { rqr[j] = p_[(size_t)j * 3072]; rfr[j] = p_[(size_t)j * 3072 + 512]; } \
                            rir = *(const u32x2*)(pi + (size_t)(blk_) * 16 * 3072); } while (0)
#define HG_ELEM(buf_) do { LAS bf16_t* QT_ = (LAS bf16_t*)(lds + (buf_) * HB); LAS bf16_t* KT_ = QT_ + 2176; LAS bf16_t* KB_ = QT_ + 4352; LAS bf16_t* IV_ = QT_ + 6528; LAS float* EL_ = (LAS float*)(lds + (buf_) * HB + 17408); \
                            float cj[4], fk[4], qv[4]; float c_ = 0.f; \
                            _Pragma("unroll") for (int j = 0; j < 4; ++j) { const float fp = __uint_as_float(rfr[j] << 16); const float f = lbv + (1.0f - lbv) * sigmoidf_(fp); c_ += __logf(f); cj[j] = c_; fk[j] = 1.0f - f; qv[j] = __uint_as_float(rqr[j] << 16); } \
                            const float T0 = dppf<0x00>(c_), T1 = dppf<0x55>(c_), T2 = dppf<0xAA>(c_), T3 = dppf<0xFF>(c_); \
                            const float P_ = (tq > 0 ? T0 : 0.f) + (tq > 1 ? T1 : 0.f) + (tq > 2 ? T2 : 0.f); \
                            const float ELv = __expf(fmaxf((T0 + T1) + (T2 + T3), -80.f)); \
                            _Pragma("unroll") for (int j = 0; j < 4; ++j) { const float Bv = fmaxf(P_ + cj[j], -80.f); const float E = __expf(Bv), Ei = __expf(-Bv); const float kt_ = fk[j] * Ei; const int t_ = 4 * tq + j; \
                                QT_[t_ * 136 + kch] = (bf16_t)(pk_bf16(qv[j] * E, 0.f) & 0xffffu); KT_[t_ * 136 + kch] = (bf16_t)(pk_bf16(kt_, 0.f) & 0xffffu); KB_[t_ * 136 + kch] = (bf16_t)(pk_bf16(kt_ * ELv, 0.f) & 0xffffu); } \
                            if (tq == 0) EL_[kch] = ELv; \
                            *(LAS u32x2*)(IV_ + (tid >> 5) * 136 + (tid & 31) * 4) = rir; } while (0)
                        HG_LOAD(0);
                        {
                            LAS float* fL = (LAS float*)(lds + 40960); LAS float* qL = fL + 2048; LAS float* iL = fL + 4096; LAS float* SD = (LAS float*)(lds + 65536);
#pragma unroll
                            for (int j = 0; j < 4; ++j) { const float fp = __uint_as_float(rfr[j] << 16); fL[(4 * tq + j) * 128 + kch] = lbv + (1.0f - lbv) * sigmoidf_(fp); qL[(4 * tq + j) * 128 + kch] = __uint_as_float(rqr[j] << 16); }
                            *(LAS f32x4*)(iL + (tid >> 5) * 128 + (tid & 31) * 4) = (f32x4){bf_lo(rir.x), bf_hi(rir.x), bf_lo(rir.y), bf_hi(rir.y)};
                            asm volatile("s_waitcnt lgkmcnt(0)" ::: "memory"); __builtin_amdgcn_s_barrier(); asm volatile("" ::: "memory");
                            const int kg = lane & 15, vq = wave * 4 + (lane >> 4);
                            float S0[8][4];
#pragma unroll
                            for (int j = 0; j < 8; ++j)
#pragma unroll
                                for (int c = 0; c < 4; ++c) S0[j][c] = 0.f;
#pragma unroll 2
                            for (int t = 0; t < 16; ++t) {
                                const f32x4 fa = *(const LAS f32x4*)(fL + t * 128 + kg * 8), fb = *(const LAS f32x4*)(fL + t * 128 + kg * 8 + 4);
                                const f32x4 qa = *(const LAS f32x4*)(qL + t * 128 + kg * 8), qb = *(const LAS f32x4*)(qL + t * 128 + kg * 8 + 4);
                                const f32x4 iv = *(const LAS f32x4*)(iL + t * 128 + vq * 4);
                                float a[4] = {0.f, 0.f, 0.f, 0.f};
#pragma unroll
                                for (int j = 0; j < 8; ++j) { const float fj = j < 4 ? fa[j] : fb[j - 4], qj = j < 4 ? qa[j] : qb[j - 4];
#pragma unroll
                                    for (int c = 0; c < 4; ++c) { const float d0 = S0[j][c] - iv[c]; S0[j][c] = __builtin_fmaf(fj, d0, iv[c]); a[c] = __builtin_fmaf(qj, S0[j][c], a[c]); } }
#pragma unroll
                                for (int c = 0; c < 4; ++c) a[c] = row16_sum(a[c]);
                                if (kg == 0) { u32x2 wv; wv.x = pk_bf16(a[0], a[1]); wv.y = pk_bf16(a[2], a[3]); *(u32x2*)(mix + ((size_t)b * SEQ + t) * 1024 + 512 + h * 128 + vq * 4) = wv; }
                            }
#pragma unroll
                            for (int j = 0; j < 8; ++j) *(LAS f32x4*)(SD + (kg * 8 + j) * 128 + vq * 4) = (f32x4){S0[j][0], S0[j][1], S0[j][2], S0[j][3]};
                            asm volatile("s_waitcnt lgkmcnt(0)" ::: "memory"); __builtin_amdgcn_s_barrier(); asm volatile("" ::: "memory");
#pragma unroll
                            for (int kt = 0; kt < 8; ++kt)
#pragma unroll
                                for (int i = 0; i < 4; ++i) Sacc[kt][i] = SD[(16 * kt + 4 * fq + i) * 128 + 16 * wave + fr];
                        }
                        HG_LOAD(1); HG_ELEM(1); HG_LOAD(2);
                        asm volatile("s_waitcnt lgkmcnt(0)" ::: "memory"); __builtin_amdgcn_s_barrier(); asm volatile("" ::: "memory");
                        for (int blk = 1; blk < 256; ++blk) {
                            const int cur = blk & 1;
                            if (wave < 4 && blk + 1 < 256) { HG_ELEM(cur ^ 1); if (blk + 2 < 256) HG_LOAD(blk + 2); }
                            const LAS bf16_t* QT = (const LAS bf16_t*)(lds + cur * HB); const LAS bf16_t* KT = QT + 2176; const LAS bf16_t* KB = QT + 4352; const LAS bf16_t* IV = QT + 6528; const LAS float* EL = (const LAS float*)(lds + cur * HB + 17408);
                            const v4i16_t itv = __builtin_amdgcn_ds_read_tr16_b64_v4i16((LAS v4i16_t*)(IV + (4 * fq + tr_r) * 136 + 16 * wave + 4 * tr_c));
                            bf16x8 AX[4], AY[4]; u32x2 QY0[4], QY1[4]; f32x4 ELv4[8]; v4i16_t KX[8];
#pragma unroll
                            for (int ks = 0; ks < 4; ++ks) { AX[ks] = *(const LAS bf16x8*)(KT + fr * 136 + ks * 32 + fq * 8); AY[ks] = *(const LAS bf16x8*)(QT + fr * 136 + ks * 32 + fq * 8); }
#pragma unroll
                            for (int p = 0; p < 4; ++p) { QY0[p] = *(const LAS u32x2*)(QT + fr * 136 + 32 * p + 4 * fq); QY1[p] = *(const LAS u32x2*)(QT + fr * 136 + 32 * p + 16 + 4 * fq); }
#pragma unroll
                            for (int kt = 0; kt < 8; ++kt) { ELv4[kt] = *(const LAS f32x4*)(EL + 16 * kt + 4 * fq); KX[kt] = __builtin_amdgcn_ds_read_tr16_b64_v4i16((LAS v4i16_t*)(KB + (4 * fq + tr_r) * 136 + kt * 16 + 4 * tr_c)); }
                            __builtin_amdgcn_sched_barrier(0);
                            const bf16x8 IT = (bf16x8){itv[0], itv[1], itv[2], itv[3], 0, 0, 0, 0};
                            f32x4 A = (f32x4){0.f, 0.f, 0.f, 0.f};
#pragma unroll
                            for (int ks = 0; ks < 4; ++ks) A = __builtin_amdgcn_mfma_f32_16x16x32_bf16(AX[ks], AY[ks], A, 0, 0, 0);
#pragma unroll
                            for (int i = 0; i < 4; ++i) A[i] = (4 * fq + i > fr) ? 0.f : A[i];
                            const u32x4 apk = (u32x4){pk_bf16(A[0], A[1]), pk_bf16(A[2], A[3]), 0u, 0u};
                            f32x4 o = __builtin_amdgcn_mfma_f32_16x16x32_bf16(IT, __builtin_bit_cast(bf16x8, apk), (f32x4){0.f, 0.f, 0.f, 0.f}, 0, 0, 0);
#pragma unroll
                            for (int p = 0; p < 4; ++p) {
                                const u32x4 sx = (u32x4){pk_bf16(Sacc[2 * p][0], Sacc[2 * p][1]), pk_bf16(Sacc[2 * p][2], Sacc[2 * p][3]), pk_bf16(Sacc[2 * p + 1][0], Sacc[2 * p + 1][1]), pk_bf16(Sacc[2 * p + 1][2], Sacc[2 * p + 1][3])};
                                const u32x4 yy = (u32x4){QY0[p].x, QY0[p].y, QY1[p].x, QY1[p].y};
                                o = __builtin_amdgcn_mfma_f32_16x16x32_bf16(__builtin_bit_cast(bf16x8, sx), __builtin_bit_cast(bf16x8, yy), o, 0, 0, 0);
                            }
                            { u32x2 wv; wv.x = pk_bf16(o[0], o[1]); wv.y = pk_bf16(o[2], o[3]);
                              *(u32x2*)(mix + ((size_t)b * SEQ + blk * 16 + fr) * 1024 + 512 + h * 128 + 16 * wave + 4 * fq) = wv; }
#pragma unroll
                            for (int kt = 0; kt < 8; ++kt) {
                                const bf16x8 X = (bf16x8){KX[kt][0], KX[kt][1], KX[kt][2], KX[kt][3], 0, 0, 0, 0};
                                Sacc[kt] = __builtin_amdgcn_mfma_f32_16x16x32_bf16(X, IT, Sacc[kt] * ELv4[kt], 0, 0, 0);
                            }
                            if (wave >= 4 && blk + 1 < 256) { HG_ELEM(cur ^ 1); if (blk + 2 < 256) HG_LOAD(blk + 2); }
                            asm volatile("s_waitcnt lgkmcnt(0)" ::: "memory"); __builtin_amdgcn_s_barrier(); asm volatile("" ::: "memory");
                        }
#undef HG_LOAD
#undef HG_ELEM
                    }
                }
#endif
#if !defined(NO_CONV)
                {
                    LAS unsigned* hL32 = (LAS unsigned*)lds; LAS float* yL = (LAS float*)(lds + 65536);
                    const float* cw = ap->in[4] + (size_t)eo * 31 * 512; const float* cb = ap->in[5] + eo * 512;
                    const float* lng = ap->in[6] + eo * 512; const float* lnb = ap->in[7] + eo * 512;
                    const int cp = tid & 255, th = tid >> 8;
                    const bool split_ = (G >= 128);
                    for (int item = split_ ? vcu - 64 : vcu; item < 2048; item += split_ ? G - 64 : G) {
                        if (item < 0) break;
                        const int ritem = 2047 - item;
                        const int b = ritem >> 7, t0 = (ritem & 127) * 32;
                        {
                            u32x4 av[8], gv[8];
#pragma unroll
                            for (int q = 0; q < 8; ++q) {
                                const int idx = tid + 512 * q, r = idx >> 6, c8 = idx & 63, t = t0 - 30 + r;
                                av[q] = (u32x4){0u, 0u, 0u, 0u}; gv[q] = av[q];
                                if (idx < 62 * 64 && t >= 0) { const bf16_t* pr = pbuf + ((size_t)b * SEQ + t) * 3072 + c8 * 8; av[q] = *(const u32x4*)pr; gv[q] = *(const u32x4*)(pr + 512); }
                            }
#pragma unroll
                            for (int q = 0; q < 8; ++q) {
                                const int idx = tid + 512 * q, r = idx >> 6, c8 = idx & 63;
                                float a[8], g8[8]; unpack8(av[q], a); unpack8(gv[q], g8);
#pragma unroll
                                for (int i = 0; i < 8; ++i) a[i] *= sigmoidf_(g8[i]);
                                if (idx < 62 * 64) *(LAS u32x4*)(hL32 + r * 256 + c8 * 4) = pack8(a);
                            }
                        }
                        __syncthreads();
#pragma unroll 1
                        for (int sb = 0; sb < 2; ++sb) {
                            float y0[8], y1[8];
                            const float b0 = cb[2 * cp], b1 = cb[2 * cp + 1];
#pragma unroll
                            for (int t = 0; t < 8; ++t) { y0[t] = b0; y1[t] = b1; }
                            unsigned in[38];
#pragma unroll
                            for (int r = 0; r < 38; ++r) in[r] = hL32[(th * 16 + sb * 8 + r) * 256 + cp];
#pragma unroll
                            for (int j = 0; j < 31; ++j) {
                                const f32x2 wj = *(const f32x2*)(cw + j * 512 + 2 * cp);
#pragma unroll
                                for (int t = 0; t < 8; ++t) { y0[t] = __builtin_fmaf(wj.x, bf_lo(in[t + j]), y0[t]); y1[t] = __builtin_fmaf(wj.y, bf_hi(in[t + j]), y1[t]); }
                            }
#pragma unroll
                            for (int t = 0; t < 8; ++t) *(LAS f32x2*)(yL + (th * 16 + sb * 8 + t) * 512 + 2 * cp) = (f32x2){y0[t], y1[t]};
                        }
                        __syncthreads();
#pragma unroll
                        for (int q = 0; q < 4; ++q) {
                            const int tok = wave * 4 + q;
                            const f32x4 v0 = *(const LAS f32x4*)(yL + tok * 512 + lane * 8), v1 = *(const LAS f32x4*)(yL + tok * 512 + lane * 8 + 4);
                            float sm = (v0[0] + v0[1]) + (v0[2] + v0[3]) + (v1[0] + v1[1]) + (v1[2] + v1[3]);
                            sm = wave_sum(sm); const float mu = sm * (1.0f / 512.0f);
                            float f[8] = {v0[0] - mu, v0[1] - mu, v0[2] - mu, v0[3] - mu, v1[0] - mu, v1[1] - mu, v1[2] - mu, v1[3] - mu};
                            float sq = 0.f;
#pragma unroll
                            for (int i = 0; i < 8; ++i) sq += f[i] * f[i];
                            sq = wave_sum(sq); const float rstd = rsqrtf(sq * (1.0f / 512.0f) + EPSF);
#pragma unroll
                            for (int i = 0; i < 8; ++i) { const float yv = f[i] * rstd * lng[lane * 8 + i] + lnb[lane * 8 + i]; f[i] = yv * sigmoidf_(yv); }
                            *(u32x4*)(mix + ((size_t)b * SEQ + t0 + tok) * 1024 + lane * 8) = pack8(f);
                        }
                        __syncthreads();
                    }
                    if (split_ && vcu >= 64) {
                        LAS float* scr = (LAS float*)(lds + wave * 16384);
                        const int gw2 = (vcu - 64) * 8 + wave, NGW2 = (G - 64) * 8;
                        if (l == 0) { transpose_layer(ap, ws, 1, scr, gw2, NGW2, lane); transpose_layer(ap, ws, 2, scr, gw2, NGW2, lane); }
                        else transpose_layer(ap, ws, 3, scr, gw2, NGW2, lane);
                    }
                }
#endif
            } else if (s == 2 && !odd) {
                const int gw = vcu * 8 + wave, NGW = G * 8;
                const float* og = ap->in[9] + eo * 128;
                for (int m0 = gw * 4; m0 < NTOK; m0 += NGW * 4) {
                    u32x4 ov[4], gv[4];
#pragma unroll
                    for (int q = 0; q < 4; ++q) { ov[q] = *(const u32x4*)(mix + (size_t)(m0 + q) * 1024 + 512 + lane * 8); gv[q] = *(const u32x4*)(pbuf + (size_t)(m0 + q) * 3072 + 2560 + lane * 8); }
#pragma unroll
                    for (int q = 0; q < 4; ++q) {
                        float o[8], g8[8]; unpack8(ov[q], o); unpack8(gv[q], g8);
                        float ss = 0.f;
#pragma unroll
                        for (int i = 0; i < 8; ++i) ss += o[i] * o[i];
                        ss = row16_sum(ss);
                        const float rs = rsqrtf(ss * (1.0f / 128.0f) + EPSF);
                        const int c0 = (lane & 15) * 8;
#pragma unroll
                        for (int i = 0; i < 8; ++i) o[i] = o[i] * rs * og[c0 + i] * (g8[i] * sigmoidf_(g8[i]));
                        *(u32x4*)(mix + (size_t)(m0 + q) * 1024 + 512 + lane * 8) = pack8(o);
                    }
                }
            } else if (s == 1 && odd) {
#if !defined(NO_SGU)
                {
                    LAS bf16_t* VN = (LAS bf16_t*)lds;
                    const float* lng = ap->in[12] + eo * 512; const float* lnb = ap->in[13] + eo * 512;
                    const int wr = wave >> 2, wc = wave & 3, fr = lane & 15, fq = lane >> 4, tr_r = (lane & 15) >> 2, tr_c = lane & 3;
                    for (int item = vcu; item < 512; item += G) {
                        const int ritem = 511 - item;
                        const int b = ritem >> 5, n = ritem & 31;
                        const size_t row0 = (size_t)b * SEQ + n * 128;
                        const int sT = tid >> 2, qd = tid & 3;
                        {
                            const bf16_t* pr = pbuf + (row0 + sT) * 3328 + 512 + qd * 128;
                            float sm = 0.f, sq = 0.f;
#pragma unroll 4
                            for (int i = 0; i < 16; ++i) { const u32x4 rawv = *(const u32x4*)(pr + i * 8); float f[8]; unpack8(rawv, f);
#pragma unroll
                                for (int j = 0; j < 8; ++j) { sm += f[j]; sq += f[j] * f[j]; } }
                            sm += __shfl_xor(sm, 1); sm += __shfl_xor(sm, 2); sq += __shfl_xor(sq, 1); sq += __shfl_xor(sq, 2);
                            const float mu = sm * (1.0f / 512.0f); const float var = fmaxf(sq * (1.0f / 512.0f) - mu * mu, 0.f); const float rstd = rsqrtf(var + EPSF);
#pragma unroll 2
                            for (int i = 0; i < 16; ++i) { const u32x4 rawv = *(const u32x4*)(pr + i * 8); float f[8]; unpack8(rawv, f);
                                const f32x4 g0 = *(const f32x4*)(lng + qd * 128 + i * 8), g1 = *(const f32x4*)(lng + qd * 128 + i * 8 + 4);
                                const f32x4 b0 = *(const f32x4*)(lnb + qd * 128 + i * 8), b1 = *(const f32x4*)(lnb + qd * 128 + i * 8 + 4);
#pragma unroll
                                for (int j = 0; j < 4; ++j) { f[j] = (f[j] - mu) * rstd * g0[j] + b0[j]; f[4 + j] = (f[4 + j] - mu) * rstd * g1[j] + b1[j]; }
                                *(LAS u32x4*)(VN + sT * 520 + qd * 128 + i * 8) = pack8(f); }
                        }
                        asm volatile("s_waitcnt lgkmcnt(0)" ::: "memory"); __builtin_amdgcn_s_barrier(); asm volatile("" ::: "memory");
#pragma unroll 1
                        for (int gI = 0; gI < 4; ++gI) {
                            const float* wg = ap->in[14] + ((size_t)eo * 4 + gI) * 128 * 128; const float* bsg = ap->in[15] + (eo * 4 + gI) * 128;
                            f32x4 acc[4][2];
#pragma unroll
                            for (int m = 0; m < 4; ++m) { acc[m][0] = (f32x4){0.f, 0.f, 0.f, 0.f}; acc[m][1] = (f32x4){0.f, 0.f, 0.f, 0.f}; }
#pragma unroll
                            for (int k0 = 0; k0 < 128; k0 += 32) {
                                if (k0 <= wr * 64 + 63) {
                                    f32x4 wv[4][2];
#pragma unroll
                                    for (int m = 0; m < 4; ++m) { wv[m][0] = (f32x4){0.f, 0.f, 0.f, 0.f}; wv[m][1] = wv[m][0];
                                        if (k0 <= wr * 64 + m * 16 + 15) { const int t = wr * 64 + m * 16 + fr, s0 = k0 + fq * 8; wv[m][0] = *(const f32x4*)(wg + t * 128 + s0); wv[m][1] = *(const f32x4*)(wg + t * 128 + s0 + 4); } }
                                    asm volatile("" ::: "memory");
                                    bf16x8 X[2];
#pragma unroll
                                    for (int nn = 0; nn < 2; ++nn) {
                                        const LAS bf16_t* vp = VN + (k0 + fq * 8 + tr_r) * 520 + gI * 128 + wc * 32 + nn * 16 + 4 * tr_c;
                                        const v4i16_t lo = __builtin_amdgcn_ds_read_tr16_b64_v4i16((LAS v4i16_t*)vp), hi = __builtin_amdgcn_ds_read_tr16_b64_v4i16((LAS v4i16_t*)(vp + 4 * 520));
                                        X[nn] = (bf16x8){lo[0], lo[1], lo[2], lo[3], hi[0], hi[1], hi[2], hi[3]};
                                    }
#pragma unroll
                                    for (int m = 0; m < 4; ++m) {
                                        if (k0 <= wr * 64 + m * 16 + 15) {
                                            const int t = wr * 64 + m * 16 + fr, s0 = k0 + fq * 8;
                                            const f32x4 w0 = wv[m][0], w1 = wv[m][1];
                                            float wf[8] = {w0[0], w0[1], w0[2], w0[3], w1[0], w1[1], w1[2], w1[3]};
#pragma unroll
                                            for (int i = 0; i < 8; ++i) wf[i] = (s0 + i <= t) ? wf[i] : 0.f;
                                            const u32x4 yp = pack8(wf); const bf16x8 Y = __builtin_bit_cast(bf16x8, yp);
                                            acc[m][0] = __builtin_amdgcn_mfma_f32_16x16x32_bf16(X[0], Y, acc[m][0], 0, 0, 0);
                                            acc[m][1] = __builtin_amdgcn_mfma_f32_16x16x32_bf16(X[1], Y, acc[m][1], 0, 0, 0);
                                        }
                                    }
                                }
                            }
                            u32x2 uva[4][2]; float bia[4];
#pragma unroll
                            for (int m = 0; m < 4; ++m) { const int t = wr * 64 + m * 16 + fr; bia[m] = bsg[t];
#pragma unroll
                                for (int nn = 0; nn < 2; ++nn) uva[m][nn] = *(const u32x2*)(pbuf + (row0 + t) * 3328 + gI * 128 + wc * 32 + nn * 16 + 4 * fq); }
                            asm volatile("" ::: "memory");
#pragma unroll
                            for (int m = 0; m < 4; ++m) {
                                const int t = wr * 64 + m * 16 + fr; const float bias = bia[m];
#pragma unroll
                                for (int nn = 0; nn < 2; ++nn) {
                                    const int c0 = wc * 32 + nn * 16 + 4 * fq;
                                    const u32x2 uv = uva[m][nn];
                                    const float o0 = bf_lo(uv.x) * (acc[m][nn][0] + bias), o1 = bf_hi(uv.x) * (acc[m][nn][1] + bias), o2 = bf_lo(uv.y) * (acc[m][nn][2] + bias), o3 = bf_hi(uv.y) * (acc[m][nn][3] + bias);
                                    u32x2 w; w.x = pk_bf16(o0, o1); w.y = pk_bf16(o2, o3);
                                    *(u32x2*)(mix + (row0 + t) * 1280 + gI * 128 + c0) = w;
                                }
                            }
                        }
                        asm volatile("s_waitcnt lgkmcnt(0)" ::: "memory"); __builtin_amdgcn_s_barrier(); asm volatile("" ::: "memory");
                    }
                }
#endif
#if !defined(NO_ATTN)
                {
                    LAS bf16_t* QL = (LAS bf16_t*)lds; LAS bf16_t* KL = (LAS bf16_t*)(lds + 18432); LAS bf16_t* VL = (LAS bf16_t*)(lds + 55296);
                    const int fr = lane & 15, fq = lane >> 4, tr_r = (lane & 15) >> 2, tr_c = lane & 3;
                    float gq16[16], gk16[16];
#pragma unroll
                    for (int i = 0; i < 16; ++i) { gq16[i] = ap->in[16][eo * 64 + (tid & 3) * 16 + i] * 0.125f; gk16[i] = ap->in[17][eo * 64 + (tid & 3) * 16 + i]; }
                    u32x4 rq[3][2], rv[4];
#pragma unroll
                    for (int i_ = 0; i_ < 3; ++i_) { rq[i_][0] = (u32x4){0u, 0u, 0u, 0u}; rq[i_][1] = (u32x4){0u, 0u, 0u, 0u}; }
#pragma unroll
                    for (int i_ = 0; i_ < 4; ++i_) rv[i_] = (u32x4){0u, 0u, 0u, 0u};
#define ATT_DECODE(it) const int rit_ = 6143 - (it); const int bj_ = rit_ / 96, q96_ = rit_ % 96, b = bj_ >> 2, j = bj_ & 3, cfg = q96_ >> 5, qq_ = q96_ & 31; \
                        const int sh = cfg * 2, r = (cfg == 0) ? 0 : (cfg == 1 ? (qq_ >> 3) : (qq_ >> 1)), n = (cfg == 0) ? qq_ : (cfg == 1 ? (qq_ & 7) : (qq_ & 1)); \
                        const int hd = cfg * 4 + j; const size_t rowb = (size_t)b * SEQ; (void)hd; (void)rowb; (void)n; (void)r; (void)sh;
#define ATT_LOAD(it) do { ATT_DECODE(it) \
                        _Pragma("unroll") for (int r3 = 0; r3 < 3; ++r3) { const int idx = tid + 512 * r3, rowi = idx >> 2, part = idx & 3; const bool isq = rowi < 128; \
                            const int sub = isq ? (n * 128 + rowi) : ((n - 1) * 128 + (rowi - 128)); const bool valid = sub >= 0; const int tok = valid ? ((sub << sh) + r) : 0; \
                            const bf16_t* src = pbuf + (rowb + tok) * 3328 + (isq ? 1024 : 1792) + hd * 64 + part * 16; \
                            rq[r3][0] = (u32x4){0u, 0u, 0u, 0u}; rq[r3][1] = rq[r3][0]; if (valid) { rq[r3][0] = *(const u32x4*)src; rq[r3][1] = *(const u32x4*)(src + 8); } } \
                        _Pragma("unroll") for (int r4 = 0; r4 < 4; ++r4) { const int idx = tid + 512 * r4, ks = idx >> 3, c8 = idx & 7; const int sub = (n - 1) * 128 + ks; \
                            rv[r4] = (u32x4){0u, 0u, 0u, 0u}; if (sub >= 0) rv[r4] = *(const u32x4*)(pbuf + (rowb + ((sub << sh) + r)) * 3328 + 2560 + hd * 64 + c8 * 8); } } while (0)
                    if (vcu < 6144) ATT_LOAD(vcu);
                    for (int item = vcu; item < 6144; item += G) {
                        ATT_DECODE(item)
#pragma unroll
                        for (int r3 = 0; r3 < 3; ++r3) {
                            const int idx = tid + 512 * r3, rowi = idx >> 2, part = idx & 3;
                            const bool isq = rowi < 128;
                            const int sub = isq ? (n * 128 + rowi) : ((n - 1) * 128 + (rowi - 128));
                            const int tok = (sub >= 0) ? ((sub << sh) + r) : 0;
                            float f[16]; unpack8(rq[r3][0], f); unpack8(rq[r3][1], f + 8);
                            float ss = 0.f;
#pragma unroll
                            for (int i = 0; i < 16; ++i) ss += f[i] * f[i];
                            ss += __shfl_xor(ss, 1); ss += __shfl_xor(ss, 2);
                            const float rs = rsqrtf(ss * (1.0f / 64.0f) + EPSF);
#pragma unroll
                            for (int i = 0; i < 16; ++i) f[i] = f[i] * rs * (r3 == 0 ? gq16[i] : gk16[i]);
                            if (part == 0) {
                                const float tf = (float)tok;
                                const float crev[8] = {0.15915494309189535f, 0.03086376340470123f, 0.005985185712713705f, 0.001160663641240061f, 0.00022507907903927653f, 4.364795279280289e-05f, 8.464330808241401e-06f, 1.6414262627950345e-06f};
#pragma unroll
                                for (int i = 0; i < 8; ++i) { const float rev = __builtin_amdgcn_fractf(tf * crev[i]); const float c = __builtin_amdgcn_cosf(rev), sn = __builtin_amdgcn_sinf(rev), x1 = f[i], x2 = f[8 + i]; f[i] = x1 * c - x2 * sn; f[8 + i] = x2 * c + x1 * sn; }
                            }
                            LAS bf16_t* dst = isq ? (QL + rowi * 72 + part * 16) : (KL + (rowi - 128) * 72 + part * 16);
                            *(LAS u32x4*)dst = pack8(f); *(LAS u32x4*)(dst + 8) = pack8(f + 8);
                        }
#pragma unroll
                        for (int r4 = 0; r4 < 4; ++r4) { const int idx = tid + 512 * r4, ks = idx >> 3, c8 = idx & 7; *(LAS u32x4*)(VL + ks * 72 + c8 * 8) = rv[r4]; }
                        if (item + G < 6144) ATT_LOAD(item + G);
                        asm volatile("s_waitcnt lgkmcnt(0)" ::: "memory"); __builtin_amdgcn_s_barrier(); asm volatile("" ::: "memory");
                        {
                            const int w = wave, qi = w * 16 + fr;
                            const bf16x8 Y0 = *(const LAS bf16x8*)(QL + qi * 72 + fq * 8), Y1 = *(const LAS bf16x8*)(QL + qi * 72 + 32 + fq * 8);
                            f32x4 sc[10];
                            {
                                bf16x8 KX0[9], KX1[9];
#pragma unroll
                                for (int jt = 0; jt < 9; ++jt) { const LAS bf16_t* kp = KL + ((w + jt) * 16 + fr) * 72 + fq * 8; KX0[jt] = *(const LAS bf16x8*)kp; KX1[jt] = *(const LAS bf16x8*)(kp + 32); }
                                __builtin_amdgcn_sched_barrier(0);
#pragma unroll
                                for (int jt = 0; jt < 9; ++jt) {
                                    f32x4 a = (f32x4){0.f, 0.f, 0.f, 0.f};
                                    a = __builtin_amdgcn_mfma_f32_16x16x32_bf16(KX0[jt], Y0, a, 0, 0, 0);
                                    a = __builtin_amdgcn_mfma_f32_16x16x32_bf16(KX1[jt], Y1, a, 0, 0, 0);
                                    sc[jt] = a;
                                }
                            }
                            float mx = -INFINITY;
#pragma unroll
                            for (int jt = 0; jt < 9; ++jt)
#pragma unroll
                                for (int i = 0; i < 4; ++i) {
                                    const int c = 4 * fq + i;
                                    bool ok = (n > 0) || (w + jt >= 8);
                                    if (jt == 0) ok = ok && (fr <= c);
                                    if (jt == 8) ok = ok && (fr >= c);
                                    const float v = ok ? sc[jt][i] : -INFINITY; sc[jt][i] = v; mx = fmaxf(mx, v);
                                }
                            mx = fmaxf(mx, __shfl_xor(mx, 16)); mx = fmaxf(mx, __shfl_xor(mx, 32));
                            float den = 0.f;
#pragma unroll
                            for (int jt = 0; jt < 9; ++jt)
#pragma unroll
                                for (int i = 0; i < 4; ++i) { const float e = __expf(sc[jt][i] - mx); sc[jt][i] = e; den += e; }
                            sc[9] = (f32x4){0.f, 0.f, 0.f, 0.f};
                            den += __shfl_xor(den, 16); den += __shfl_xor(den, 32);
                            f32x4 oa[4];
#pragma unroll
                            for (int et = 0; et < 4; ++et) oa[et] = (f32x4){0.f, 0.f, 0.f, 0.f};
                            v4i16_t VLO[5][4], VHI[5][4];
#pragma unroll
                            for (int jj = 0; jj < 5; ++jj) {
                                const int t0r = (w + 2 * jj) * 16, t1r = (jj < 4) ? (w + 2 * jj + 1) * 16 : t0r;
#pragma unroll
                                for (int et = 0; et < 4; ++et) {
                                    VLO[jj][et] = __builtin_amdgcn_ds_read_tr16_b64_v4i16((LAS v4i16_t*)(VL + (t0r + 4 * fq + tr_r) * 72 + et * 16 + 4 * tr_c));
                                    VHI[jj][et] = __builtin_amdgcn_ds_read_tr16_b64_v4i16((LAS v4i16_t*)(VL + (t1r + 4 * fq + tr_r) * 72 + et * 16 + 4 * tr_c));
                                }
                            }
                            __builtin_amdgcn_sched_barrier(0);
#pragma unroll
                            for (int jj = 0; jj < 5; ++jj) {
                                u32x4 pp; pp.x = pk_bf16(sc[2 * jj][0], sc[2 * jj][1]); pp.y = pk_bf16(sc[2 * jj][2], sc[2 * jj][3]); pp.z = pk_bf16(sc[2 * jj + 1][0], sc[2 * jj + 1][1]); pp.w = pk_bf16(sc[2 * jj + 1][2], sc[2 * jj + 1][3]);
                                const bf16x8 Pf = __builtin_bit_cast(bf16x8, pp);
#pragma unroll
                                for (int et = 0; et < 4; ++et) {
                                    const v4i16_t lo = VLO[jj][et], hi = VHI[jj][et];
                                    const bf16x8 xv = (bf16x8){lo[0], lo[1], lo[2], lo[3], hi[0], hi[1], hi[2], hi[3]};
                                    oa[et] = __builtin_amdgcn_mfma_f32_16x16x32_bf16(xv, Pf, oa[et], 0, 0, 0);
                                }
                            }
                            const float inv = 1.0f / den;
                            const int tokq = ((n * 128 + qi) << sh) + r;
                            bf16_t* op = mix + (rowb + tokq) * 1280 + 512 + hd * 64 + 4 * fq;
#pragma unroll
                            for (int et = 0; et < 4; ++et) { u32x2 wv; wv.x = pk_bf16(oa[et][0] * inv, oa[et][1] * inv); wv.y = pk_bf16(oa[et][2] * inv, oa[et][3] * inv); *(u32x2*)(op + et * 16) = wv; }
                            if (fq == 0) lse[(rowb + tokq) * 12 + hd] = mx + __logf(den);
                        }
                        asm volatile("s_waitcnt lgkmcnt(0)" ::: "memory"); __builtin_amdgcn_s_barrier(); asm volatile("" ::: "memory");
                    }
#undef ATT_LOAD
#undef ATT_DECODE
                }
#endif
            } else if (s == 2 && odd) {
                const int gw = vcu * 8 + wave, NGW = G * 8;
                for (int m0 = gw * 2; m0 < NTOK; m0 += NGW * 2) {
                    u32x4 v[2][2]; float al[2][2];
#pragma unroll
                    for (int q = 0; q < 2; ++q)
#pragma unroll
                        for (int c2 = 0; c2 < 2; ++c2) {
                            const int ch = lane + 64 * c2; v[q][c2] = (u32x4){0u, 0u, 0u, 0u}; al[q][c2] = 0.f;
                            if (ch < 96) {
                                const size_t m = (size_t)(m0 + q);
                                const int hd = ch >> 3, cfg = hd >> 2, j = hd & 3;
                                const float l0 = lse[m * 12 + j], l1 = lse[m * 12 + 4 + j], l2 = lse[m * 12 + 8 + j];
                                v[q][c2] = *(const u32x4*)(mix + m * 1280 + 512 + ch * 8);
                                const float mxl = fmaxf(l0, fmaxf(l1, l2));
                                const float e0 = __expf(l0 - mxl), e1 = __expf(l1 - mxl), e2 = __expf(l2 - mxl);
                                al[q][c2] = ((cfg == 0) ? e0 : (cfg == 1 ? e1 : e2)) / (e0 + e1 + e2);
                            }
                        }
#pragma unroll
                    for (int q = 0; q < 2; ++q)
#pragma unroll
                        for (int c2 = 0; c2 < 2; ++c2) {
                            const int ch = lane + 64 * c2;
                            if (ch < 96) { float f[8]; unpack8(v[q][c2], f);
#pragma unroll
                                for (int i = 0; i < 8; ++i) f[i] *= al[q][c2];
                                *(u32x4*)(mix + (size_t)(m0 + q) * 1280 + 512 + ch * 8) = pack8(f); }
                        }
                }
            } else if (s == 3) {
                const bf16_t* wt = odd ? (const bf16_t*)(ws + WS_ODWOUT) + (size_t)eo * 1024 * 1280 : (const bf16_t*)(ws + WS_EVWOUT) + (size_t)eo * 1024 * 1024;
                pg8::Gemm g{mix, wt, MW, MW, MW, 256, 4, 1, 1, 0, 0, 0, 0, 0};
                pg8::EpiR E{nullptr, xb, sx_xat, 0};
                pg8::gemm_phase<pg8::EpiR>(lds, tid, g, G, bx, E);
            } else if (s == 4) {
                pg8::Gemm g{xb, (const bf16_t*)(ws + WS_WQ) + (size_t)l * 1024 * 1024, 1024, 1024, 1024, 256, 4, 1, 1, 0, 0, 0, 0, 0};
                pg8::EpiP E{(bf16_t*)(ws + WS_QX), 1024, NTOK, sx_xat, 1.0f / (1024.0f * SC_SS), 0, qst, 4, 1, 0};
                pg8::gemm_phase<pg8::EpiP>(lds, tid, g, G, bx, E);
            } else if (s == 5) {
                pg8::Gemm g{(const bf16_t*)(ws + WS_QX), (const bf16_t*)(ws + WS_KT) + (size_t)l * 4096 * 1024, 1024, 1024, 256, 16, 1, 64, 4, SEQ * 1024, 256, 256 * 1024, 256, 0};
                pg8::EpiS E{(bf16_t*)(ws + WS_PB), qst, (LAS float*)(lds + 131072)};
                pg8::gemm_phase<pg8::EpiS>(lds, tid, g, G, bx, E);
            } else if (s == 7) {
                pg8::Gemm g{(const bf16_t*)(ws + WS_PB), (const bf16_t*)(ws + WS_VP), 1024, 1024, 1024, 16, 4, 16, 1, SEQ * 1024, 0, 1024 * 1024, 0, 0};
                pg8::EpiR E{nullptr, xb, sx_mlp, SEQ};
                pg8::gemm_phase<pg8::EpiR>(lds, tid, g, G, bx, E);
            } else if (s == 8) {
                pg8::Gemm g{xb, (const bf16_t*)(ws + WS_W1) + (size_t)l * 4096 * 1024, 1024, 1024, 1024, 256, 16, 1, 1, 0, 0, 0, 0, 0};
                pg8::EpiP E{(bf16_t*)(ws + WS_HMID), 4096, NTOK, sx_mlp, 1.0f / (1024.0f * SC_SS), 2, nullptr, 0, 1, 0};
                pg8::gemm_phase<pg8::EpiP>(lds, tid, g, G, bx, E);
            } else {
                pg8::Gemm g{(const bf16_t*)(ws + WS_HMID), (const bf16_t*)(ws + WS_W2) + (size_t)l * 1024 * 4096, 4096, 4096, 4096, 256, 4, 1, 1, 0, 0, 0, 0, 1};
                pg8::EpiR E{(l == 3) ? ap->out : nullptr, xb, (l == 3) ? (u64*)(ws + ST_QST) : sx_next, 0};
                pg8::gemm_phase<pg8::EpiR>(lds, tid, g, G, bx, E);
            }
        }
        }
        if (ph + 1 < args.hi) { if (ph == 0) cg::this_grid().sync(); else xcd_barrier((unsigned*)(ws + ST_BAR), xcc, xst); }
    }
}

constexpr int N_PHASES = 43;
extern "C" void kernel_launch(void* const* d_in, const int* in_sizes, int n_in, void* d_out, int out_size, void* d_ws, size_t ws_size, hipStream_t stream) {
    static int grid = 0;
    if (grid == 0) {
        if (n_in != 29 || ws_size < WS_END) { fprintf(stderr, "kernel_launch: need 29 inputs and %zu bytes of workspace; got %d, %zu\n", (size_t)WS_END, n_in, ws_size); grid = -1; return; }
        int dev = 0, cus = 0, per_cu = 0;
        hipGetDevice(&dev); hipDeviceGetAttribute(&cus, hipDeviceAttributeMultiprocessorCount, dev);
        if (hipFuncSetAttribute((const void*)mk_fwd, hipFuncAttributeMaxDynamicSharedMemorySize, LDS_BYTES) != hipSuccess) { fprintf(stderr, "kernel_launch: hipFuncSetAttribute failed\n"); grid = -1; return; }
        if (hipOccupancyMaxActiveBlocksPerMultiprocessor(&per_cu, (const void*)mk_fwd, 512, LDS_BYTES) != hipSuccess || per_cu < 1) per_cu = 1;
        (void)hipGetLastError();
        grid = cus * per_cu;
        fprintf(stderr, "kernel_launch: grid %d (cus %d x %d)\n", grid, cus, per_cu);
    }
    if (grid < 0) return;
    Args a{};
    for (int i = 0; i < 29; ++i) a.in[i] = (const float*)d_in[i];
    a.out = (float*)d_out; a.ws = (unsigned char*)d_ws;
#if MK_MULTI
    for (int ph = 0; ph < N_PHASES; ++ph) { a.lo = ph; a.hi = ph + 1; hipLaunchKernelGGL(mk_fwd, dim3(grid), dim3(512), LDS_BYTES, stream, a); }
#else
    a.lo = 0; a.hi = N_PHASES;
    if (hipMemsetAsync((char*)d_ws + ST_BAR, 0, 16384, stream) != hipSuccess) { fprintf(stderr, "kernel_launch: memset failed\n"); return; }
    void* kargs[] = {&a};
    hipError_t e = hipLaunchCooperativeKernel((const void*)mk_fwd, dim3(grid), dim3(512), kargs, LDS_BYTES, stream);
    if (e != hipSuccess) fprintf(stderr, "cooperative launch failed: %s (grid %d)\n", hipGetErrorString(e), grid);
#endif
}
```

```cpp
#include <hip/hip_runtime.h>
#include <hip/hip_cooperative_groups.h>
#include <cstdio>
#include <cstdint>
namespace cg = cooperative_groups;

#ifndef MK_MULTI
#define MK_MULTI 0
#endif

#define LAS __attribute__((address_space(3)))
typedef unsigned short bf16_t;
typedef short bf16x8 __attribute__((ext_vector_type(8)));
typedef float f32x4 __attribute__((ext_vector_type(4)));
typedef float f32x2 __attribute__((ext_vector_type(2)));
typedef unsigned u32x4 __attribute__((ext_vector_type(4)));
typedef unsigned u32x2 __attribute__((ext_vector_type(2)));
typedef __bf16 bf16x2_t __attribute__((ext_vector_type(2)));
typedef short v4i16_t __attribute__((ext_vector_type(4)));

constexpr int NTOK = 65536, DM = 1024, SEQ = 4096, NBATCH = 16;
constexpr float EPSF = 1e-6f;
constexpr size_t MiB = 1u << 20;
typedef unsigned long long u64;
constexpr float SC_SS = 1048576.0f, SC_L = 16777216.0f;
constexpr size_t ST_SXZ = 0;
constexpr size_t ST_QST = 11 * 512 * 1024;
constexpr size_t ST_LSUM = ST_QST + 8 * MiB;
constexpr size_t ST_KST = ST_LSUM + 8 * MiB;
constexpr size_t ST_ZERO_BYTES = ST_KST + 1 * MiB;
constexpr size_t ST_SX0 = ST_ZERO_BYTES;
constexpr size_t ST_SMEM = ST_SX0 + 512 * 1024;
constexpr size_t ST_BAR = ST_SX0 + 768 * 1024;
constexpr size_t ST_LSE = 24 * MiB;
constexpr size_t ST_ROPE = 27 * MiB;
constexpr size_t WB = 16 * MiB;
constexpr size_t WS_EVWIN = WB + 16 * MiB, WS_ODWIN = WB + 28 * MiB, WS_EVWOUT = WB + 41 * MiB, WS_ODWOUT = WB + 45 * MiB, WS_WQ = WB + 50 * MiB, WS_WKV = WB + 58 * MiB,
                 WS_WO = WB + 74 * MiB, WS_W1 = WB + 82 * MiB, WS_W2 = WB + 114 * MiB, WS_MEMB = WB + 146 * MiB, WS_KT = WB + 154 * MiB, WS_VT = WB + 186 * MiB, WS_XB = WB + 218 * MiB,
                 WS_A = WB + 346 * MiB;
constexpr size_t WS_P = WS_A, WS_MIX = WS_A + 416 * MiB, WS_KVRAW = WS_A, WS_QX = WS_A, WS_PB = WS_A + 128 * MiB, WS_AO = WS_A + 256 * MiB, WS_HMID = WS_A;
constexpr size_t WS_VP = WS_A + 576 * MiB;
constexpr size_t WS_END = WS_VP + 32 * MiB;
constexpr int LDS_BYTES = 147456;

__device__ __forceinline__ unsigned pk_bf16(float lo, float hi) { f32x2 v = {lo, hi}; bf16x2_t b = __builtin_convertvector(v, bf16x2_t); return __builtin_bit_cast(unsigned, b); }
__device__ __forceinline__ float bf_lo(unsigned u) { return __uint_as_float(u << 16); }
__device__ __forceinline__ float bf_hi(unsigned u) { return __uint_as_float(u & 0xffff0000u); }
__device__ __forceinline__ void unpack8(const u32x4 v, float* f) { f[0] = bf_lo(v.x); f[1] = bf_hi(v.x); f[2] = bf_lo(v.y); f[3] = bf_hi(v.y); f[4] = bf_lo(v.z); f[5] = bf_hi(v.z); f[6] = bf_lo(v.w); f[7] = bf_hi(v.w); }
__device__ __forceinline__ u32x4 pack8(const float* f) { u32x4 w; w.x = pk_bf16(f[0], f[1]); w.y = pk_bf16(f[2], f[3]); w.z = pk_bf16(f[4], f[5]); w.w = pk_bf16(f[6], f[7]); return w; }
__device__ __forceinline__ float sigmoidf_(float x) { return __builtin_amdgcn_rcpf(1.0f + __expf(-x)); }
__device__ __forceinline__ float wave_sum(float v) {
#pragma unroll
    for (int o = 1; o < 64; o <<= 1) v += __shfl_xor(v, o);
    return v;
}
template <int CTRL> __device__ __forceinline__ float dppf(float v) { return __int_as_float(__builtin_amdgcn_update_dpp(0, __float_as_int(v), CTRL, 0xf, 0xf, true)); }
__device__ __forceinline__ float row16_sum(float v) { v += dppf<0x128>(v); v += dppf<0x124>(v); v += dppf<0x122>(v); v += dppf<0x121>(v); return v; }
__device__ __forceinline__ f32x2 gelu_pk(f32x2 v) {
    const f32x2 av = __builtin_elementwise_abs(v), d = av * 0.2316418882f + 1.0f;
    f32x2 t; t.x = __builtin_amdgcn_rcpf(d.x); t.y = __builtin_amdgcn_rcpf(d.y);
    f32x2 q = t * 0.5307027145f + (-0.7265760135f); q = q * t + 0.7107068705f; q = q * t + (-0.142248368f); q = q * t + 0.127414796f; q = q * t;
    const f32x2 s = (v * v) * (-0.72134752044f);
    f32x2 e; e.x = __builtin_amdgcn_exp2f(s.x); e.y = __builtin_amdgcn_exp2f(s.y);
    const f32x2 m = v * (q * e), r = v - m;
    f32x2 o; o.x = v.x < 0.f ? m.x : r.x; o.y = v.y < 0.f ? m.y : r.y; return o;
}

namespace pg8 {
constexpr int BM = 256, BK = 64, HALF = 128, HTB = HALF * BK * 2, STAGE_BYTES = 8 * HTB, WGM = 8;
__host__ __device__ __forceinline__ int lds_byte(int r, int c) { const int st = (r >> 4) * 2 + (c >> 5), rr = r & 15, cc = c & 31, ob = rr * 64 + cc * 2; return st * 1024 + (ob ^ (((ob >> 9) & 1) << 5)); }
__host__ __device__ __forceinline__ void stage_rc(int b, int& R, int& C) { const int st = b / 1024, sb = b % 1024, swz = sb ^ (((sb >> 9) & 1) << 5); R = (st >> 1) * 16 + swz / 64; C = (st & 1) * 32 + (swz % 64) / 2; }
__host__ __device__ __forceinline__ int perm32(int rho) { const int n = rho >> 4, i = rho & 15; return 8 * (i >> 2) + 4 * n + (i & 3); }

struct Unit { int pm, pn, z; };
struct Gemm { const bf16_t* A; const bf16_t* Bt; int lda, ldb, K, nM, nN, nZ, ZL; int sAh, sAl, sBh, sBl; int rev; };
struct Order {
    int nM, nN, per, nwg, G, c, rev;
    __device__ __forceinline__ void init(const Gemm& g, int G_, int c_) { nM = g.nM; nN = g.nN; per = nM * nN; nwg = per * g.nZ; G = G_; c = c_; rev = g.rev; }
    __device__ __forceinline__ bool next(int i, Unit& u) const {
        const long L = (long)i * G + c; if (L >= nwg) return false;
        int w = (int)L;
        if ((nwg & 7) == 0) { const int ch = nwg >> 3, off = w >> 3; w = (w & 7) * ch + (rev ? ch - 1 - off : off); }
        u.z = w / per; const int t = w % per;
        const int nig = WGM * nN, gid = t / nig, fm = gid * WGM, gsz = (nM - fm) < WGM ? (nM - fm) : WGM;
        u.pm = fm + ((t % nig) % gsz); u.pn = (t % nig) / gsz; return true;
    }
};
__device__ __forceinline__ const char* a_ptr(const Gemm& g, const Unit& u) { return (const char*)(g.A + ((u.z / g.ZL) * g.sAh + (u.z % g.ZL) * g.sAl + u.pm * BM * g.lda)); }
__device__ __forceinline__ const char* b_ptr(const Gemm& g, const Unit& u) { return (const char*)(g.Bt + ((u.z / g.ZL) * g.sBh + (u.z % g.ZL) * g.sBl + u.pn * BM * g.ldb)); }

struct EpiP {
    static constexpr bool PERM = true;
    bf16_t* O; int ldc; int Mz; const u64* rstat; float rinv; int act; u64* hstat; int hs_ld; int ZLo; int zcol;
    __device__ __forceinline__ void operator()(f32x4 (&acc)[2][2][4][2], const Unit& u, int wr, int wc, int fr, int fq) const {
        const int row0 = u.pm * BM + wr * 64 + fr, col0 = u.pn * BM + wc * 32 + 8 * fq;
        const bool do_gelu = (act == 1) && (u.pn < 4);
        float rsv[8];
#pragma unroll
        for (int q = 0; q < 8; ++q) rsv[q] = 1.f;
        if (rstat) {
            u64 sv[8];
#pragma unroll
            for (int q = 0; q < 8; ++q) sv[q] = rstat[row0 + (q >> 2) * HALF + (q & 3) * 16];
#pragma unroll
            for (int q = 0; q < 8; ++q) rsv[q] = rsqrtf((float)sv[q] * rinv + EPSF);
        }
        asm volatile("" ::: "memory");
#pragma unroll
        for (int ai = 0; ai < 2; ++ai)
#pragma unroll
            for (int m = 0; m < 4; ++m) {
                const int row = row0 + ai * HALF + m * 16;
                const float rs = rsv[ai * 4 + m];
                float hs = 0.f;
                bf16_t* rowp = O + ((long)(u.z / ZLo) * Mz + row) * ldc + (u.z % ZLo) * zcol + col0;
#pragma unroll
                for (int bj = 0; bj < 2; ++bj) {
                    f32x4 v0 = acc[ai][bj][m][0] * rs, v1 = acc[ai][bj][m][1] * rs;
                    if (do_gelu) { f32x2 a = gelu_pk((f32x2){v0[0], v0[1]}), b = gelu_pk((f32x2){v0[2], v0[3]}), c = gelu_pk((f32x2){v1[0], v1[1]}), d = gelu_pk((f32x2){v1[2], v1[3]});
                        v0 = (f32x4){a.x, a.y, b.x, b.y}; v1 = (f32x4){c.x, c.y, d.x, d.y}; }
                    else if (act == 2) {
#pragma unroll
                        for (int i = 0; i < 4; ++i) { const float a = fmaxf(v0[i], 0.f), b = fmaxf(v1[i], 0.f); v0[i] = a * a; v1[i] = b * b; } }
                    hs += (v0[0] * v0[0] + v0[1] * v0[1]) + (v0[2] * v0[2] + v0[3] * v0[3]) + (v1[0] * v1[0] + v1[1] * v1[1]) + (v1[2] * v1[2] + v1[3] * v1[3]);
                    u32x4 w; w.x = pk_bf16(v0[0], v0[1]); w.y = pk_bf16(v0[2], v0[3]); w.z = pk_bf16(v1[0], v1[1]); w.w = pk_bf16(v1[2], v1[3]);
                    *(u32x4*)(rowp + bj * HALF) = w;
                }
                if (hstat) { hs += __shfl_xor(hs, 16); hs += __shfl_xor(hs, 32); if (fq == 0) atomicAdd(hstat + ((long)u.z * Mz + row) * hs_ld + u.pn, (u64)(hs * SC_SS + 0.5f)); }
            }
    }
};
struct EpiS {
    static constexpr bool PERM = true;
    bf16_t* P; const u64* qstat; LAS float* xch;
    __device__ __forceinline__ void operator()(f32x4 (&acc)[2][2][4][2], const Unit& u, int wr, int wc, int fr, int fq) const {
        const int b = u.z >> 2, h = u.z & 3;
        const int row0 = b * SEQ + u.pm * BM + wr * 64 + fr, col0 = h * 256 + wc * 32 + 8 * fq;
        float rsv[8];
        { u64 sv[8];
#pragma unroll
          for (int q = 0; q < 8; ++q) sv[q] = qstat[(long)(row0 + (q >> 2) * HALF + (q & 3) * 16) * 4 + h];
#pragma unroll
          for (int q = 0; q < 8; ++q) rsv[q] = rsqrtf((float)sv[q] * (1.0f / (256.0f * SC_SS)) + EPSF) * 1.4426950408889634f; }
#pragma unroll
        for (int ai = 0; ai < 2; ++ai)
#pragma unroll
            for (int m = 0; m < 4; ++m) {
                const int rl = ai * HALF + wr * 64 + m * 16 + fr;
                const float rs = rsv[ai * 4 + m];
                float sum = 0.f;
#pragma unroll
                for (int bj = 0; bj < 2; ++bj)
#pragma unroll
                    for (int n = 0; n < 2; ++n)
#pragma unroll
                        for (int i = 0; i < 4; ++i) { const float e = __builtin_amdgcn_exp2f(acc[ai][bj][m][n][i] * rs); acc[ai][bj][m][n][i] = e; sum += e; }
                sum += __shfl_xor(sum, 16); sum += __shfl_xor(sum, 32);
                if (fq == 0) xch[rl * 4 + wc] = sum;
            }
        asm volatile("s_waitcnt lgkmcnt(0)" ::: "memory"); __builtin_amdgcn_s_barrier(); asm volatile("" ::: "memory");
#pragma unroll
        for (int ai = 0; ai < 2; ++ai)
#pragma unroll
            for (int m = 0; m < 4; ++m) {
                const int row = row0 + ai * HALF + m * 16, rl = ai * HALF + wr * 64 + m * 16 + fr;
                const f32x4 t = *(const LAS f32x4*)(xch + rl * 4);
                const float inv = 1.0f / ((t[0] + t[1]) + (t[2] + t[3]));
                bf16_t* rowp = P + (long)row * 1024 + col0;
#pragma unroll
                for (int bj = 0; bj < 2; ++bj) {
                    const f32x4 v0 = acc[ai][bj][m][0] * inv, v1 = acc[ai][bj][m][1] * inv;
                    u32x4 w; w.x = pk_bf16(v0[0], v0[1]); w.y = pk_bf16(v0[2], v0[3]); w.z = pk_bf16(v1[0], v1[1]); w.w = pk_bf16(v1[2], v1[3]);
                    *(u32x4*)(rowp + bj * HALF) = w;
                }
            }
    }
};
struct EpiO {
    static constexpr bool PERM = true;
    bf16_t* O; const u64* lsum;
    __device__ __forceinline__ void operator()(f32x4 (&acc)[2][2][4][2], const Unit& u, int wr, int wc, int fr, int fq) const {
        const int b = u.z >> 2, h = u.z & 3;
        const int row0 = b * SEQ + u.pm * BM + wr * 64 + fr, col0 = h * 256 + wc * 32 + 8 * fq;
#pragma unroll
        for (int ai = 0; ai < 2; ++ai)
#pragma unroll
            for (int m = 0; m < 4; ++m) {
                const int row = row0 + ai * HALF + m * 16;
                const float inv = SC_L / (float)lsum[(long)row * 4 + h];
                bf16_t* rowp = O + (long)row * 1024 + col0;
#pragma unroll
                for (int bj = 0; bj < 2; ++bj) {
                    const f32x4 v0 = acc[ai][bj][m][0] * inv, v1 = acc[ai][bj][m][1] * inv;
                    u32x4 w; w.x = pk_bf16(v0[0], v0[1]); w.y = pk_bf16(v0[2], v0[3]); w.z = pk_bf16(v1[0], v1[1]); w.w = pk_bf16(v1[2], v1[3]);
                    *(u32x4*)(rowp + bj * HALF) = w;
                }
            }
    }
};
struct EpiR {
    static constexpr bool PERM = true;
    float* out; bf16_t* xb; u64* stat; int Mz;
    __device__ __forceinline__ bool can_repeat() const { return false; }
    __device__ __forceinline__ void operator()(f32x4 (&acc)[2][2][4][2], const Unit& u, int wr, int wc, int fr, int fq) const {
        const int row0 = u.z * Mz + u.pm * BM + wr * 64 + fr, col0 = u.pn * BM + wc * 32 + 8 * fq;
#pragma unroll
        for (int ai = 0; ai < 2; ++ai) {
            u32x4 xv[4][2];
#pragma unroll
            for (int m = 0; m < 4; ++m)
#pragma unroll
                for (int bj = 0; bj < 2; ++bj) xv[m][bj] = *(const u32x4*)(xb + (size_t)(row0 + ai * HALF + m * 16) * DM + col0 + bj * HALF);
            asm volatile("" ::: "memory");
#pragma unroll
            for (int m = 0; m < 4; ++m) {
                const int row = row0 + ai * HALF + m * 16; const size_t off = (size_t)row * DM + col0;
                float ss = 0.f;
#pragma unroll
                for (int bj = 0; bj < 2; ++bj) {
                    float f[8]; unpack8(xv[m][bj], f);
#pragma unroll
                    for (int i = 0; i < 4; ++i) { f[i] += acc[ai][bj][m][0][i]; f[4 + i] += acc[ai][bj][m][1][i]; }
#pragma unroll
                    for (int i = 0; i < 8; ++i) ss += f[i] * f[i];
                    *(u32x4*)(xb + off + bj * HALF) = pack8(f);
                    if (out) { *(f32x4*)(out + off + bj * HALF) = (f32x4){f[0], f[1], f[2], f[3]}; *(f32x4*)(out + off + bj * HALF + 4) = (f32x4){f[4], f[5], f[6], f[7]}; }
                }
                ss += __shfl_xor(ss, 16); ss += __shfl_xor(ss, 32);
                if (fq == 0) atomicAdd(stat + row, (u64)(ss * SC_SS + 0.5f));
            }
        }
    }
};

template <class Epi>
__device__ __forceinline__ void gemm_phase(LAS unsigned char* lds, const int tid, const Gemm g, const int G, const int cidx, const Epi& E) {
    const int wid = __builtin_amdgcn_readfirstlane(tid >> 6), lane = tid & 63, wr = wid >> 2, wc = wid & 3, fr = lane & 15, fq = lane >> 4;
    Order S; S.init(g, G, cidx);
    const int K = g.K, nt = K / BK;
    unsigned voffA[2], voffB[2];
#pragma unroll
    for (int i = 0; i < 2; ++i) { int R, C; stage_rc(tid * 16 + i * 8192, R, C); const int Rb = Epi::PERM ? ((R & ~31) + perm32(R & 31)) : R;
        voffA[i] = (unsigned)(R * g.lda + C) * 2u; voffB[i] = (unsigned)(Rb * g.ldb + C) * 2u; }
    const size_t kstep = (size_t)(BK * 2);
    const size_t hstepA = (size_t)HALF * g.lda * 2, hstepB = (size_t)HALF * g.ldb * 2;
    const unsigned ldsw = (unsigned)wid * 1024u;
    const int aoff = lds_byte(wr * 64 + fr, fq * 8), boff = lds_byte(wc * 32 + fr, fq * 8);
#define PG8_SA(b, h) (((b) * 2 + (h)) * HTB)
#define PG8_SB(b, h) ((4 + (b) * 2 + (h)) * HTB)
#define PG8_STAGE(bufoff, gbase, voff) do { _Pragma("unroll") for (int _i = 0; _i < 2; ++_i) \
        __builtin_amdgcn_global_load_lds((const unsigned*)((const char*)(gbase) + (voff)[_i]), (LAS unsigned*)(lds + (bufoff) + ldsw + _i * 8192), 16, 0, 0); } while (0)
#define PG8_LDA(dst, b, h) do { _Pragma("unroll") for (int m = 0; m < 4; ++m) _Pragma("unroll") for (int k = 0; k < 2; ++k) dst[m][k] = *(const LAS bf16x8*)(lds + PG8_SA(b, h) + aoff + m * 2048 + k * 1024); } while (0)
#define PG8_LDB(dst, b, h) do { _Pragma("unroll") for (int n = 0; n < 2; ++n) _Pragma("unroll") for (int k = 0; k < 2; ++k) dst[n][k] = *(const LAS bf16x8*)(lds + PG8_SB(b, h) + boff + n * 2048 + k * 1024); } while (0)
#define PG8_MMA(ai, bj, At, Bt) do { __builtin_amdgcn_s_setprio(1); _Pragma("unroll") for (int m = 0; m < 4; ++m) _Pragma("unroll") for (int n = 0; n < 2; ++n) _Pragma("unroll") for (int k = 0; k < 2; ++k) \
        acc[ai][bj][m][n] = __builtin_amdgcn_mfma_f32_16x16x32_bf16(Bt[n][k], At[m][k], acc[ai][bj][m][n], 0, 0, 0); __builtin_amdgcn_s_setprio(0); } while (0)
#define PG8_WAIT_V(n) asm volatile("s_waitcnt vmcnt(" #n ")" ::: "memory")
#define PG8_WAIT_L(n) asm volatile("s_waitcnt lgkmcnt(" #n ")" ::: "memory")
#define PG8_BAR __builtin_amdgcn_s_barrier()
#define PG8_SCHED __builtin_amdgcn_sched_barrier(0)
    Unit cur, nxt; int ui = 0;
    if (!S.next(0, cur)) return;
    f32x4 acc[2][2][4][2];
#pragma unroll
    for (int a = 0; a < 2; ++a)
#pragma unroll
        for (int b = 0; b < 2; ++b)
#pragma unroll
            for (int m = 0; m < 4; ++m)
#pragma unroll
                for (int n = 0; n < 2; ++n) acc[a][b][m][n] = (f32x4){0.f, 0.f, 0.f, 0.f};
    bf16x8 At[4][2], B0[2][2], B1[2][2];
    const char* cA = a_ptr(g, cur); const char* cB = b_ptr(g, cur);
    PG8_STAGE(PG8_SB(0, 0), cB, voffB); PG8_STAGE(PG8_SB(0, 1), cB + hstepB, voffB); PG8_STAGE(PG8_SA(0, 0), cA, voffA); PG8_STAGE(PG8_SA(0, 1), cA + hstepA, voffA);
    if (wr == 1) PG8_BAR;
    PG8_WAIT_V(2); PG8_BAR;
    PG8_STAGE(PG8_SB(1, 0), cB + kstep, voffB); PG8_STAGE(PG8_SA(1, 0), cA + kstep, voffA); PG8_STAGE(PG8_SB(1, 1), cB + hstepB + kstep, voffB);
    PG8_WAIT_V(6); PG8_BAR;
    for (;;) {
        const bool has_next = S.next(ui + 1, nxt);
        const char* nA = has_next ? a_ptr(g, nxt) : cA; const char* nB = has_next ? b_ptr(g, nxt) : cB;
        for (int t = 0; t < nt; t += 2) {
            const bool last = (t == nt - 2);
            const char* a1 = cA + (size_t)(t + 1) * kstep;
            const char* a2 = last ? nA : cA + (size_t)(t + 2) * kstep; const char* b2 = last ? nB : cB + (size_t)(t + 2) * kstep;
            const char* a3 = a2 + kstep; const char* b3 = b2 + kstep;
            PG8_LDB(B0, 0, 0); PG8_LDB(B1, 0, 1); PG8_SCHED; PG8_LDA(At, 0, 0); PG8_STAGE(PG8_SA(1, 1), a1 + hstepA, voffA);
            PG8_WAIT_V(8); PG8_WAIT_L(0); PG8_BAR; PG8_MMA(0, 0, At, B0); PG8_MMA(0, 1, At, B1); PG8_BAR; PG8_SCHED;
            PG8_LDA(At, 0, 1); PG8_STAGE(PG8_SB(0, 0), b2, voffB); PG8_STAGE(PG8_SB(0, 1), b2 + hstepB, voffB); PG8_STAGE(PG8_SA(0, 0), a2, voffA);
            PG8_WAIT_V(8); PG8_WAIT_L(0); PG8_BAR; PG8_MMA(1, 0, At, B0); PG8_MMA(1, 1, At, B1); PG8_BAR; PG8_SCHED;
            PG8_LDB(B0, 1, 0); PG8_LDB(B1, 1, 1); PG8_SCHED; PG8_LDA(At, 1, 0); PG8_STAGE(PG8_SA(0, 1), a2 + hstepA, voffA);
            PG8_WAIT_V(8); PG8_WAIT_L(0); PG8_BAR; PG8_MMA(0, 0, At, B0); PG8_MMA(0, 1, At, B1); PG8_BAR; PG8_SCHED;
            PG8_LDA(At, 1, 1); PG8_STAGE(PG8_SB(1, 0), b3, voffB); PG8_STAGE(PG8_SB(1, 1), b3 + hstepB, voffB); PG8_STAGE(PG8_SA(1, 0), a3, voffA);
            PG8_WAIT_V(8); PG8_WAIT_L(0); PG8_BAR; PG8_MMA(1, 0, At, B0); PG8_MMA(1, 1, At, B1); PG8_BAR; PG8_SCHED;
        }
        if (wr == 0) PG8_BAR;
        E(acc, cur, wr, wc, fr, fq);
        if (!has_next) break;
#pragma unroll
        for (int a = 0; a < 2; ++a)
#pragma unroll
            for (int b = 0; b < 2; ++b)
#pragma unroll
                for (int m = 0; m < 4; ++m)
#pragma unroll
                    for (int n = 0; n < 2; ++n) acc[a][b][m][n] = (f32x4){0.f, 0.f, 0.f, 0.f};
        cur = nxt; cA = nA; cB = nB; ++ui;
        if (wr == 1) PG8_BAR;
    }
    PG8_WAIT_V(0);
    PG8_BAR;
#undef PG8_SA
#undef PG8_SB
#undef PG8_STAGE
#undef PG8_LDA
#undef PG8_LDB
#undef PG8_MMA
#undef PG8_WAIT_V
#undef PG8_WAIT_L
#undef PG8_BAR
#undef PG8_SCHED
}
}

struct Args { const float* in[29]; float* out; unsigned char* ws; int lo, hi; };

__device__ __forceinline__ void transpose_item(const float* W, int K, int N, const float* gain, bf16_t* WT, LAS float* scr, int item, int lane) {
    const int nblk = N / 32, kb = item / nblk, nb = item % nblk, k0 = 64 * kb, n0 = 32 * nb;
    {
        float wv[32]; const float* wp = W + (size_t)(k0 + (lane >> 5)) * N + n0 + (lane & 31);
#pragma unroll
        for (int i = 0; i < 32; ++i) wv[i] = wp[(size_t)(2 * i) * N];
        if (gain) { const float* gp = gain + k0 + (lane >> 5);
#pragma unroll
            for (int i = 0; i < 32; ++i) wv[i] *= gp[2 * i]; }
#pragma unroll
        for (int i = 0; i < 32; ++i) scr[(2 * i + (lane >> 5)) * 33 + (lane & 31)] = wv[i];
    }
    asm volatile("s_waitcnt lgkmcnt(0)" ::: "memory");
    const int c = lane & 7;
#pragma unroll
    for (int j = 0; j < 4; ++j) { const int n = (lane >> 3) + 8 * j; const LAS float* s = scr + (8 * c) * 33 + n;
        u32x4 o; o.x = pk_bf16(s[0 * 33], s[1 * 33]); o.y = pk_bf16(s[2 * 33], s[3 * 33]); o.z = pk_bf16(s[4 * 33], s[5 * 33]); o.w = pk_bf16(s[6 * 33], s[7 * 33]);
        *(u32x4*)(WT + (size_t)(n0 + n) * K + k0 + 8 * c) = o; }
    asm volatile("s_waitcnt lgkmcnt(0)" ::: "memory");
}
__device__ __forceinline__ void transpose_all(const float* W, int K, int N, const float* gain, bf16_t* WT, LAS float* scr, int gw, int NGW, int lane) {
    const int nitems = (K / 64) * (N / 32);
    for (int it = gw; it < nitems; it += NGW) transpose_item(W, K, N, gain, WT, scr, it, lane);
}
__device__ __forceinline__ void row_to_bf16(const float* xrow, bf16_t* orow, u64* ss, int lane) {
    const f32x4* xr = (const f32x4*)xrow + lane; float s = 0.f; f32x4 v[4];
#pragma unroll
    for (int j = 0; j < 4; ++j) { v[j] = xr[64 * j]; s += (v[j].x * v[j].x + v[j].y * v[j].y) + (v[j].z * v[j].z + v[j].w * v[j].w); }
    s = wave_sum(s);
    u32x2* o8 = (u32x2*)orow + lane;
#pragma unroll
    for (int j = 0; j < 4; ++j) { u32x2 w; w.x = pk_bf16(v[j].x, v[j].y); w.y = pk_bf16(v[j].z, v[j].w); o8[64 * j] = w; }
    if (lane == 0) *ss = (u64)(s * SC_SS + 0.5f);
}

__device__ __forceinline__ void transpose_layer(const __attribute__((address_space(4))) Args* ap, unsigned char* ws, int l, LAS float* scr, int gw, int NGW, int lane) {
    const int e = l >> 1;
    if (l & 1) {
        transpose_all(ap->in[11] + (size_t)e * 1024 * 3328, 1024, 3328, ap->in[2] + l * 1024, (bf16_t*)(ws + WS_ODWIN) + (size_t)e * 3328 * 1024, scr, gw, NGW, lane);
        transpose_all(ap->in[18] + (size_t)e * 1280 * 1024, 1280, 1024, nullptr, (bf16_t*)(ws + WS_ODWOUT) + (size_t)e * 1024 * 1280, scr, gw, NGW, lane);
    } else {
        transpose_all(ap->in[3] + (size_t)e * 1024 * 3072, 1024, 3072, ap->in[2] + l * 1024, (bf16_t*)(ws + WS_EVWIN) + (size_t)e * 3072 * 1024, scr, gw, NGW, lane);
        transpose_all(ap->in[10] + (size_t)e * 1024 * 1024, 1024, 1024, nullptr, (bf16_t*)(ws + WS_EVWOUT) + (size_t)e * 1024 * 1024, scr, gw, NGW, lane);
    }
    transpose_all(ap->in[21] + (size_t)l * 1024 * 1024, 1024, 1024, ap->in[19] + l * 1024, (bf16_t*)(ws + WS_WQ) + (size_t)l * 1024 * 1024, scr, gw, NGW, lane);
    transpose_all(ap->in[25] + (size_t)l * 1024 * 1024, 1024, 1024, nullptr, (bf16_t*)(ws + WS_WO) + (size_t)l * 1024 * 1024, scr, gw, NGW, lane);
    transpose_all(ap->in[27] + (size_t)l * 1024 * 4096, 1024, 4096, ap->in[26] + l * 1024, (bf16_t*)(ws + WS_W1) + (size_t)l * 4096 * 1024, scr, gw, NGW, lane);
    transpose_all(ap->in[28] + (size_t)l * 4096 * 1024, 4096, 1024, nullptr, (bf16_t*)(ws + WS_W2) + (size_t)l * 1024 * 4096, scr, gw, NGW, lane);
}

#define XB_TMO      128
#define XB_XCNT(j)  (256  + 64 * (j))
#define XB_XSUB(j)  (1280 + 64 * (j))
#define XB_XGEN(j)  (2304 + 64 * (j))
#define XB_TOP      3328
#define XB_TOPGEN   3392
#define XCD_BAR_WORDS 3456
#define XB_SPIN_CAP (1u << 22)
__device__ __forceinline__ unsigned xb_ld(unsigned* p)              { return __hip_atomic_load(p, __ATOMIC_RELAXED, __HIP_MEMORY_SCOPE_AGENT); }
__device__ __forceinline__ unsigned xb_add(unsigned* p, unsigned v) { return __hip_atomic_fetch_add(p, v, __ATOMIC_RELAXED, __HIP_MEMORY_SCOPE_AGENT); }
__device__ __forceinline__ unsigned xb_xcc_id() { return (unsigned)__builtin_amdgcn_s_getreg((3 << 11) | 20) & 0xFu; }
#define XB_SPIN(cond, bar) do { unsigned _sp = 0; while (cond) { __builtin_amdgcn_s_sleep(1); \
    if ((++_sp & 255u) == 0u) { if (xb_ld(&(bar)[XB_TMO])) break; if (_sp > XB_SPIN_CAP) { atomicAdd(&(bar)[XB_TMO], 1u); break; } } } } while (0)
__device__ __forceinline__ void xcd_barrier_complete(unsigned* bar, unsigned x, unsigned& nloc, unsigned& nx) {
    const unsigned G = gridDim.x * gridDim.y * gridDim.z;
    unsigned sum, cnt, mine, sp = 0u;
    for (;;) {
        sum = 0u; cnt = 0u; mine = 0u;
#pragma unroll
        for (unsigned j = 0; j < 16; ++j) { const unsigned c = xb_ld(&bar[XB_XCNT(j)]); sum += c; cnt += (c > 0u) ? 1u : 0u; mine = (j == x) ? c : mine; }
        if (sum == G) break;
        __builtin_amdgcn_s_sleep(1);
        if ((++sp & 255u) == 0u) { if (xb_ld(&bar[XB_TMO])) break; if (sp > XB_SPIN_CAP) { atomicAdd(&bar[XB_TMO], 1u); break; } }
    }
    nloc = mine > 0u ? mine : 1u; nx = cnt > 0u ? cnt : 1u;
}
__device__ __forceinline__ void xcd_barrier(unsigned* bar, unsigned x, volatile LAS unsigned* st) {
    asm volatile("s_waitcnt vmcnt(0)" ::: "memory");
    __syncthreads();
    if (threadIdx.x == 0) {
        __builtin_amdgcn_s_waitcnt(0);
        unsigned nloc = st[0], nx = st[1];
        if (nloc == 0u) { xcd_barrier_complete(bar, x, nloc, nx); st[0] = nloc; st[1] = nx; }
        const unsigned old = xb_add(&bar[XB_XSUB(x)], 1u);
        const unsigned gen = old / nloc;
        if (old + 1u == (gen + 1u) * nloc) {
            __builtin_amdgcn_fence(__ATOMIC_RELEASE, "agent");
            asm volatile("s_waitcnt vmcnt(0)" ::: "memory");
            const unsigned og = xb_add(&bar[XB_TOP], 1u);
            const unsigned tg = og / nx;
            if (og + 1u == (tg + 1u) * nx) xb_add(&bar[XB_TOPGEN], 1u);
            else XB_SPIN(xb_ld(&bar[XB_TOPGEN]) == tg, bar);
            __builtin_amdgcn_fence(__ATOMIC_ACQUIRE, "agent");
            xb_add(&bar[XB_XGEN(x)], 1u);
            asm volatile("s_waitcnt vmcnt(0)" ::: "memory");
        } else {
            XB_SPIN(xb_ld(&bar[XB_XGEN(x)]) == gen, bar);
            __builtin_amdgcn_fence(__ATOMIC_ACQUIRE, "agent");
            asm volatile("s_waitcnt vmcnt(0)" ::: "memory");
        }
    }
    __syncthreads();
}

__global__ void __launch_bounds__(512, 2) mk_fwd(Args args) {
    extern __shared__ __attribute__((aligned(16))) unsigned char lds_raw[];
    LAS unsigned char* lds = (LAS unsigned char*)lds_raw;
    volatile LAS unsigned* const xst = (volatile LAS unsigned*)((LAS unsigned char*)lds_raw + LDS_BYTES - 64);
    if (threadIdx.x < 2) xst[threadIdx.x] = 0u;
    const unsigned xcc = xb_xcc_id();
    if (args.hi - args.lo > 1 && threadIdx.x == 0) (void)xb_add((unsigned*)(args.ws + ST_BAR) + XB_XCNT(xcc), 1u);
    __syncthreads();
    const __attribute__((address_space(4))) Args* const ap0 = (const __attribute__((address_space(4))) Args*)__builtin_amdgcn_kernarg_segment_ptr();
#ifdef REP_MASK
    for (int ph2 = args.lo * 2; ph2 < args.hi * 2; ++ph2) { const int ph = ph2 >> 1;
    if ((ph2 & 1) && !(ph >= 3 && ((REP_MASK >> ((ph - 3) % 10)) & 1) && ((REP_ODD >> (((ph - 3) / 10) & 1)) & 1))) continue;
#else
    for (int ph = args.lo; ph < args.hi; ++ph) {
#endif
    const __attribute__((address_space(4))) Args* ap = ap0; asm volatile("" : "+s"(ap));
    int tid = threadIdx.x; asm volatile("" : "+v"(tid));
    const int lane = tid & 63, wave = __builtin_amdgcn_readfirstlane(tid >> 6);
    int G = gridDim.x, bx = blockIdx.x; asm volatile("" : "+s"(G), "+s"(bx));
    const int vcu = (G % 8 == 0) ? (bx % 8) * (G / 8) + bx / 8 : bx;
    unsigned char* ws = ap->ws;
    u64* const st_sxz = (u64*)(ws + ST_SXZ); u64* const st_sx0 = (u64*)(ws + ST_SX0);
    bf16_t* const xb = (bf16_t*)(ws + WS_XB);
    bf16_t* const pbuf = (bf16_t*)(ws + WS_P); bf16_t* const mix = (bf16_t*)(ws + WS_MIX);
    float* const rope = (float*)(ws + ST_ROPE); float* const lse = (float*)(ws + ST_LSE);
    {
#ifdef ONLY_S
        if (ph < 0) {
#else
        if (ph == 0) {
#endif
            const int gw = vcu * 8 + wave, NGW = G * 8;
            { u32x4* z = (u32x4*)ws; const size_t n16 = ST_ZERO_BYTES / 16; for (size_t i = (size_t)bx * 512 + tid; i < n16; i += (size_t)G * 512) z[i] = (u32x4){0u, 0u, 0u, 0u}; }
            for (int m = gw * 2; m < NTOK; m += NGW * 2) {
                const f32x4* x0 = (const f32x4*)(ap->in[0] + (size_t)m * DM) + lane; const f32x4* x1 = x0 + DM / 4;
                f32x4 v[8];
#pragma unroll
                for (int j = 0; j < 4; ++j) { v[j] = x0[64 * j]; v[4 + j] = x1[64 * j]; }
                float s0 = 0.f, s1 = 0.f;
#pragma unroll
                for (int j = 0; j < 4; ++j) { s0 += (v[j].x * v[j].x + v[j].y * v[j].y) + (v[j].z * v[j].z + v[j].w * v[j].w); s1 += (v[4 + j].x * v[4 + j].x + v[4 + j].y * v[4 + j].y) + (v[4 + j].z * v[4 + j].z + v[4 + j].w * v[4 + j].w); }
                s0 = wave_sum(s0); s1 = wave_sum(s1);
                u32x2* o0 = (u32x2*)(xb + (size_t)m * DM) + lane; u32x2* o1 = o0 + DM / 4;
#pragma unroll
                for (int j = 0; j < 4; ++j) { u32x2 w; w.x = pk_bf16(v[j].x, v[j].y); w.y = pk_bf16(v[j].z, v[j].w); o0[64 * j] = w; u32x2 w1; w1.x = pk_bf16(v[4 + j].x, v[4 + j].y); w1.y = pk_bf16(v[4 + j].z, v[4 + j].w); o1[64 * j] = w1; }
                if (lane == 0) { st_sx0[m] = (u64)(s0 * SC_SS + 0.5f); st_sx0[m + 1] = (u64)(s1 * SC_SS + 0.5f); }
            }
            { bf16_t* memb = (bf16_t*)(ws + WS_MEMB); u64* smem = (u64*)(ws + ST_SMEM);
              for (int m = gw; m < 4096; m += NGW) row_to_bf16(ap->in[1] + (size_t)m * DM, memb + (size_t)m * DM, smem + m, lane); }
            LAS float* scr = (LAS float*)(lds + wave * 16384);
            for (int l = 0; l < 4; ++l)
                transpose_all(ap->in[22] + (size_t)l * 1024 * 2048, 1024, 2048, ap->in[20] + l * 1024, (bf16_t*)(ws + WS_WKV) + (size_t)l * 2048 * 1024, scr, gw, NGW, lane);
            for (int l = 0; l < ((G >= 128) ? 1 : 4); ++l) transpose_layer(ap, ws, l, scr, gw, NGW, lane);
            for (int i = bx * 512 + tid; i < 4096 * 8; i += G * 512) {
                const int t = i >> 3, j = i & 7;
                const float invf[8] = {1.0f, 0.19392274474868576f, 0.03760603093086393f, 0.007292664737217109f, 0.001414213562373095f, 0.0002742481756762073f, 5.318295896944988e-05f, 1.031338537721246e-05f};
                float fj = invf[0];
#pragma unroll
                for (int q = 1; q < 8; ++q) fj = (j == q) ? invf[q] : fj;
                const float ang = (float)t * fj;
                const double a = (double)ang; const double k = __builtin_rint(a * 0.15915494309189535); const float r = (float)(a - k * 6.283185307179586);
                rope[t * 16 + j] = __cosf(r); rope[t * 16 + 8 + j] = __sinf(r);
            }
#ifdef ONLY_S
        } else if (ph < 0) {
#else
        } else if (ph == 1) {
#endif
            pg8::Gemm g{(const bf16_t*)(ws + WS_MEMB), (const bf16_t*)(ws + WS_WKV), 1024, 1024, 1024, 16, 8, 4, 1, 0, 0, 2048 * 1024, 0, 0};
            pg8::EpiP E{(bf16_t*)(ws + WS_KVRAW), 2048, 4096, (const u64*)(ws + ST_SMEM), 1.0f / (1024.0f * SC_SS), 0, (u64*)(ws + ST_KST), 8, 1, 0};
            pg8::gemm_phase<pg8::EpiP>(lds, tid, g, G, bx, E);
#ifdef ONLY_S
        } else if (ph < 0) {
#else
        } else if (ph == 2) {
#endif
            const int gw = vcu * 8 + wave, NGW = G * 8;
            const bf16_t* kvraw = (const bf16_t*)(ws + WS_KVRAW); bf16_t* kt = (bf16_t*)(ws + WS_KT); bf16_t* vt = (bf16_t*)(ws + WS_VT); const u64* kst = (const u64*)(ws + ST_KST);
            for (int r = gw; r < 4 * 4096; r += NGW) {
                const int l = r >> 12;
                const float* gk = ap->in[24] + l * 256; const float* gq = ap->in[23] + l * 256;
#pragma unroll
                for (int c2 = 0; c2 < 2; ++c2) {
                    const int ch = lane + 64 * c2, h = ch >> 5, e0 = (ch & 31) * 8;
                    const float rs = rsqrtf((float)kst[(size_t)r * 8 + h] * (1.0f / (256.0f * SC_SS)) + EPSF) * 0.0625f;
                    const u32x4 raw = *(const u32x4*)(kvraw + (size_t)r * 2048 + ch * 8); float f[8]; unpack8(raw, f);
#pragma unroll
                    for (int i = 0; i < 8; ++i) f[i] = f[i] * rs * gk[e0 + i] * gq[e0 + i];
                    *(u32x4*)(kt + (size_t)r * 1024 + ch * 8) = pack8(f);
                }
            }
            for (int idx0 = bx * 512 + tid; idx0 < 4 * 4096 * 128; idx0 += G * 512 * 4) {
                u32x4 cv[4];
#pragma unroll
                for (int q = 0; q < 4; ++q) { const int idx = idx0 + q * G * 512; cv[q] = (u32x4){0u, 0u, 0u, 0u}; if (idx < 4 * 4096 * 128) cv[q] = *(const u32x4*)(kvraw + (size_t)(idx >> 7) * 2048 + 1024 + (idx & 127) * 8); }
#pragma unroll
                for (int q = 0; q < 4; ++q) { const int idx = idx0 + q * G * 512; if (idx < 4 * 4096 * 128) *(u32x4*)(vt + (size_t)(idx >> 7) * 1024 + (idx & 127) * 8) = cv[q]; }
            }
        } else {
            #ifdef ONLY_S
            const int l = (ph - 3) / 10, s = ONLY_S, odd = ONLY_ODD, eo = l >> 1;
#else
            const int l = (ph - 3) / 10, s = (ph - 3) % 10, odd = l & 1, eo = l >> 1;
#endif
            u64* const sx_mix = (l == 0) ? st_sx0 : st_sxz + (size_t)(3 * l - 1) * NTOK;
            u64* const sx_xat = st_sxz + (size_t)(3 * l) * NTOK;
            u64* const sx_mlp = st_sxz + (size_t)(3 * l + 1) * NTOK;
            u64* const sx_next = st_sxz + (size_t)(3 * l + 2) * NTOK;
            u64* const qst = (u64*)(ws + ST_QST) + (size_t)l * NTOK * 4;
            u64* const lsum = (u64*)(ws + ST_LSUM) + (size_t)l * NTOK * 4;
            const int PW = odd ? 3328 : 3072, MW = odd ? 1280 : 1024;
            if (s == 6) continue;
            if (s == 0) {
                const bf16_t* wt = odd ? (const bf16_t*)(ws + WS_ODWIN) + (size_t)eo * 3328 * 1024 : (const bf16_t*)(ws + WS_EVWIN) + (size_t)eo * 3072 * 1024;
                pg8::Gemm g{xb, wt, 1024, 1024, 1024, 256, PW / 256, 1, 1, 0, 0, 0, 0, 0};
                pg8::EpiP E{pbuf, PW, NTOK, sx_mix, 1.0f / (1024.0f * SC_SS), odd ? 1 : 0, nullptr, 0, 1, 0};
                pg8::Gemm gv{(const bf16_t*)(ws + WS_WO) + (size_t)l * 1024 * 1024, (const bf16_t*)(ws + WS_VT) + (size_t)l * 4096 * 1024, 1024, 1024, 256, 4, 1, 64, 4, 0, 256, 256 * 1024, 256, 0};
                pg8::EpiP Ev{(bf16_t*)(ws + WS_VP), 1024, 1024, nullptr, 0.f, 0, nullptr, 0, 4, 256};
#pragma unroll 1
                for (int pass = 0; pass < 2; ++pass)
                    pg8::gemm_phase<pg8::EpiP>(lds, tid, pass ? gv : g, G, bx, pass ? Ev : E);
            } else if (s == 1 && !odd) {
#if !defined(NO_HGRN)
                {
                    const int fr = lane & 15, fq = lane >> 4, tr_r = (lane & 15) >> 2, tr_c = lane & 3;
                    const int kch = tid >> 2, tq = tid & 3;
                    constexpr int HB = 17920;
                    for (int item = vcu; item < 64; item += G) {
                        const int b = item >> 2, h = item & 3;
                        float lbv = 0.f; if (eo == 1) { const int c = h * 128 + kch; lbv = sigmoidf_(ap->in[8][512 + c] - ap->in[8][c]); }
                        f32x4 Sacc[8];
#pragma unroll
                        for (int kt = 0; kt < 8; ++kt) Sacc[kt] = (f32x4){0.f, 0.f, 0.f, 0.f};
                        const bf16_t* pq = pbuf + ((size_t)b * SEQ + 4 * tq) * 3072 + 1024 + h * 128 + kch;
                        const bf16_t* pi = pbuf + ((size_t)b * SEQ + (tid >> 5)) * 3072 + 2048 + h * 128 + (tid & 31) * 4;
                        unsigned rqr[4], rfr[4]; u32x2 rir;
#define HG_LOAD(blk_) do { const bf16_t* p_ = pq + (size_t)(blk_) * 16 * 3072; \
                            _Pragma("unroll") for (int j = 0; j < 4; ++j) { rqr[j] = p_[(size_t)j * 3072]; rfr[j] = p_[(size_t)j * 3072 + 512]; } \
                            rir = *(const u32x2*)(pi + (size_t)(blk_) * 16 * 3072); } while (0)
#define HG_ELEM(buf_) do { LAS bf16_t* QT_ = (LAS bf16_t*)(lds + (buf_) * HB); LAS bf16_t* KT_ = QT_ + 2176; LAS bf16_t* KB_ = QT_ + 4352; LAS bf16_t* IV_ = QT_ + 6528; LAS float* EL_ = (LAS float*)(lds + (buf_) * HB + 17408); \
                            float cj[4], fk[4], qv[4]; float c_ = 0.f; \
                            _Pragma("unroll") for (int j = 0; j < 4; ++j) { const float fp = __uint_as_float(rfr[j] << 16); const float f = lbv + (1.0f - lbv) * sigmoidf_(fp); c_ += __logf(f); cj[j] = c_; fk[j] = 1.0f - f; qv[j] = __uint_as_float(rqr[j] << 16); } \
                            const float T0 = dppf<0x00>(c_), T1 = dppf<0x55>(c_), T2 = dppf<0xAA>(c_), T3 = dppf<0xFF>(c_); \
                            const float P_ = (tq > 0 ? T0 : 0.f) + (tq > 1 ? T1 : 0.f) + (tq > 2 ? T2 : 0.f); \
                            const float ELv = __expf(fmaxf((T0 + T1) + (T2 + T3), -80.f)); \
                            _Pragma("unroll") for (int j = 0; j < 4; ++j) { const float Bv = fmaxf(P_ + cj[j], -80.f); const float E = __expf(Bv), Ei = __expf(-Bv); const float kt_ = fk[j] * Ei; const int t_ = 4 * tq + j; \
                                QT_[t_ * 136 + kch] = (bf16_t)(pk_bf16(qv[j] * E, 0.f) & 0xffffu); KT_[t_ * 136 + kch] = (bf16_t)(pk_bf16(kt_, 0.f) & 0xffffu); KB_[t_ * 136 + kch] = (bf16_t)(pk_bf16(kt_ * ELv, 0.f) & 0xffffu); } \
                            if (tq == 0) EL_[kch] = ELv; \
                            *(LAS u32x2*)(IV_ + (tid >> 5) * 136 + (tid & 31) * 4) = rir; } while (0)
                        HG_LOAD(0);
                        {
                            LAS float* fL = (LAS float*)(lds + 40960); LAS float* qL = fL + 2048; LAS float* iL = fL + 4096; LAS float* SD = (LAS float*)(lds + 65536);
#pragma unroll
                            for (int j = 0; j < 4; ++j) { const float fp = __uint_as_float(rfr[j] << 16); fL[(4 * tq + j) * 128 + kch] = lbv + (1.0f - lbv) * sigmoidf_(fp); qL[(4 * tq + j) * 128 + kch] = __uint_as_float(rqr[j] << 16); }
                            *(LAS f32x4*)(iL + (tid >> 5) * 128 + (tid & 31) * 4) = (f32x4){bf_lo(rir.x), bf_hi(rir.x), bf_lo(rir.y), bf_hi(rir.y)};
                            asm volatile("s_waitcnt lgkmcnt(0)" ::: "memory"); __builtin_amdgcn_s_barrier(); asm volatile("" ::: "memory");
                            const int kg = lane & 15, vq = wave * 4 + (lane >> 4);
                            float S0[8][4];
#pragma unroll
                            for (int j = 0; j < 8; ++j)
#pragma unroll
                                for (int c = 0; c < 4; ++c) S0[j][c] = 0.f;
#pragma unroll 2
                            for (int t = 0; t < 16; ++t) {
                                const f32x4 fa = *(const LAS f32x4*)(fL + t * 128 + kg * 8), fb = *(const LAS f32x4*)(fL + t * 128 + kg * 8 + 4);
                                const f32x4 qa = *(const LAS f32x4*)(qL + t * 128 + kg * 8), qb = *(const LAS f32x4*)(qL + t * 128 + kg * 8 + 4);
                                const f32x4 iv = *(const LAS f32x4*)(iL + t * 128 + vq * 4);
                                float a[4] = {0.f, 0.f, 0.f, 0.f};
#pragma unroll
                                for (int j = 0; j < 8; ++j) { const float fj = j < 4 ? fa[j] : fb[j - 4], qj = j < 4 ? qa[j] : qb[j - 4];
#pragma unroll
                                    for (int c = 0; c < 4; ++c) { const float d0 = S0[j][c] - iv[c]; S0[j][c] = __builtin_fmaf(fj, d0, iv[c]); a[c] = __builtin_fmaf(qj, S0[j][c], a[c]); } }
#pragma unroll
                                for (int c = 0; c < 4; ++c) a[c] = row16_sum(a[c]);
                                if (kg == 0) { u32x2 wv; wv.x = pk_bf16(a[0], a[1]); wv.y = pk_bf16(a[2], a[3]); *(u32x2*)(mix + ((size_t)b * SEQ + t) * 1024 + 512 + h * 128 + vq * 4) = wv; }
                            }
#pragma unroll
                            for (int j = 0; j < 8; ++j) *(LAS f32x4*)(SD + (kg * 8 + j) * 128 + vq * 4) = (f32x4){S0[j][0], S0[j][1], S0[j][2], S0[j][3]};
                            asm volatile("s_waitcnt lgkmcnt(0)" ::: "memory"); __builtin_amdgcn_s_barrier(); asm volatile("" ::: "memory");
#pragma unroll
                            for (int kt = 0; kt < 8; ++kt)
#pragma unroll
                                for (int i = 0; i < 4; ++i) Sacc[kt][i] = SD[(16 * kt + 4 * fq + i) * 128 + 16 * wave + fr];
                        }
                        HG_LOAD(1); HG_ELEM(1); HG_LOAD(2);
                        asm volatile("s_waitcnt lgkmcnt(0)" ::: "memory"); __builtin_amdgcn_s_barrier(); asm volatile("" ::: "memory");
                        for (int blk = 1; blk < 256; ++blk) {
                            const int cur = blk & 1;
                            if (wave < 4 && blk + 1 < 256) { HG_ELEM(cur ^ 1); if (blk + 2 < 256) HG_LOAD(blk + 2); }
                            const LAS bf16_t* QT = (const LAS bf16_t*)(lds + cur * HB); const LAS bf16_t* KT = QT + 2176; const LAS bf16_t* KB = QT + 4352; const LAS bf16_t* IV = QT + 6528; const LAS float* EL = (const LAS float*)(lds + cur * HB + 17408);
                            const v4i16_t itv = __builtin_amdgcn_ds_read_tr16_b64_v4i16((LAS v4i16_t*)(IV + (4 * fq + tr_r) * 136 + 16 * wave + 4 * tr_c));
                            bf16x8 AX[4], AY[4]; u32x2 QY0[4], QY1[4]; f32x4 ELv4[8]; v4i16_t KX[8];
#pragma unroll
                            for (int ks = 0; ks < 4; ++ks) { AX[ks] = *(const LAS bf16x8*)(KT + fr * 136 + ks * 32 + fq * 8); AY[ks] = *(const LAS bf16x8*)(QT + fr * 136 + ks * 32 + fq * 8); }
#pragma unroll
                            for (int p = 0; p < 4; ++p) { QY0[p] = *(const LAS u32x2*)(QT + fr * 136 + 32 * p + 4 * fq); QY1[p] = *(const LAS u32x2*)(QT + fr * 136 + 32 * p + 16 + 4 * fq); }
#pragma unroll
                            for (int kt = 0; kt < 8; ++kt) { ELv4[kt] = *(const LAS f32x4*)(EL + 16 * kt + 4 * fq); KX[kt] = __builtin_amdgcn_ds_read_tr16_b64_v4i16((LAS v4i16_t*)(KB + (4 * fq + tr_r) * 136 + kt * 16 + 4 * tr_c)); }
                            __builtin_amdgcn_sched_barrier(0);
                            const bf16x8 IT = (bf16x8){itv[0], itv[1], itv[2], itv[3], 0, 0, 0, 0};
                            f32x4 A = (f32x4){0.f, 0.f, 0.f, 0.f};
#pragma unroll
                            for (int ks = 0; ks < 4; ++ks) A = __builtin_amdgcn_mfma_f32_16x16x32_bf16(AX[ks], AY[ks], A, 0, 0, 0);
#pragma unroll
                            for (int i = 0; i < 4; ++i) A[i] = (4 * fq + i > fr) ? 0.f : A[i];
                            const u32x4 apk = (u32x4){pk_bf16(A[0], A[1]), pk_bf16(A[2], A[3]), 0u, 0u};
                            f32x4 o = __builtin_amdgcn_mfma_f32_16x16x32_bf16(IT, __builtin_bit_cast(bf16x8, apk), (f32x4){0.f, 0.f, 0.f, 0.f}, 0, 0, 0);
#pragma unroll
                            for (int p = 0; p < 4; ++p) {
                                const u32x4 sx = (u32x4){pk_bf16(Sacc[2 * p][0], Sacc[2 * p][1]), pk_bf16(Sacc[2 * p][2], Sacc[2 * p][3]), pk_bf16(Sacc[2 * p + 1][0], Sacc[2 * p + 1][1]), pk_bf16(Sacc[2 * p + 1][2], Sacc[2 * p + 1][3])};
                                const u32x4 yy = (u32x4){QY0[p].x, QY0[p].y, QY1[p].x, QY1[p].y};
                                o = __builtin_amdgcn_mfma_f32_16x16x32_bf16(__builtin_bit_cast(bf16x8, sx), __builtin_bit_cast(bf16x8, yy), o, 0, 0, 0);
                            }
                            { u32x2 wv; wv.x = pk_bf16(o[0], o[1]); wv.y = pk_bf16(o[2], o[3]);
                              *(u32x2*)(mix + ((size_t)b * SEQ + blk * 16 + fr) * 1024 + 512 + h * 128 + 16 * wave + 4 * fq) = wv; }
#pragma unroll
                            for (int kt = 0; kt < 8; ++kt) {
                                const bf16x8 X = (bf16x8){KX[kt][0], KX[kt][1], KX[kt][2], KX[kt][3], 0, 0, 0, 0};
                                Sacc[kt] = __builtin_amdgcn_mfma_f32_16x16x32_bf16(X, IT, Sacc[kt] * ELv4[kt], 0, 0, 0);
                            }
                            if (wave >= 4 && blk + 1 < 256) { HG_ELEM(cur ^ 1); if (blk + 2 < 256) HG_LOAD(blk + 2); }
                            asm volatile("s_waitcnt lgkmcnt(0)" ::: "memory"); __builtin_amdgcn_s_barrier(); asm volatile("" ::: "memory");
                        }
#undef HG_LOAD
#undef HG_ELEM
                    }
                }
#endif
#if !defined(NO_CONV)
                {
                    LAS unsigned* hL32 = (LAS unsigned*)lds; LAS float* yL = (LAS float*)(lds + 65536);
                    const float* cw = ap->in[4] + (size_t)eo * 31 * 512; const float* cb = ap->in[5] + eo * 512;
                    const float* lng = ap->in[6] + eo * 512; const float* lnb = ap->in[7] + eo * 512;
                    const int cp = tid & 255, th = tid >> 8;
                    const bool split_ = (G >= 128);
                    for (int item = split_ ? vcu - 64 : vcu; item < 2048; item += split_ ? G - 64 : G) {
                        if (item < 0) break;
                        const int ritem = 2047 - item;
                        const int b = ritem >> 7, t0 = (ritem & 127) * 32;
                        {
                            u32x4 av[8], gv[8];
#pragma unroll
                            for (int q = 0; q < 8; ++q) {
                                const int idx = tid + 512 * q, r = idx >> 6, c8 = idx & 63, t = t0 - 30 + r;
                                av[q] = (u32x4){0u, 0u, 0u, 0u}; gv[q] = av[q];
                                if (idx < 62 * 64 && t >= 0) { const bf16_t* pr = pbuf + ((size_t)b * SEQ + t) * 3072 + c8 * 8; av[q] = *(const u32x4*)pr; gv[q] = *(const u32x4*)(pr + 512); }
                            }
#pragma unroll
                            for (int q = 0; q < 8; ++q) {
                                const int idx = tid + 512 * q, r = idx >> 6, c8 = idx & 63;
                                float a[8], g8[8]; unpack8(av[q], a); unpack8(gv[q], g8);
#pragma unroll
                                for (int i = 0; i < 8; ++i) a[i] *= sigmoidf_(g8[i]);
                                if (idx < 62 * 64) *(LAS u32x4*)(hL32 + r * 256 + c8 * 4) = pack8(a);
                            }
                        }
                        __syncthreads();
#pragma unroll 1
                        for (int sb = 0; sb < 2; ++sb) {
                            float y0[8], y1[8];
                            const float b0 = cb[2 * cp], b1 = cb[2 * cp + 1];
#pragma unroll
                            for (int t = 0; t < 8; ++t) { y0[t] = b0; y1[t] = b1; }
                            unsigned in[38];
#pragma unroll
                            for (int r = 0; r < 38; ++r) in[r] = hL32[(th * 16 + sb * 8 + r) * 256 + cp];
#pragma unroll
                            for (int j = 0; j < 31; ++j) {
                                const f32x2 wj = *(const f32x2*)(cw + j * 512 + 2 * cp);
#pragma unroll
                                for (int t = 0; t < 8; ++t) { y0[t] = __builtin_fmaf(wj.x, bf_lo(in[t + j]), y0[t]); y1[t] = __builtin_fmaf(wj.y, bf_hi(in[t + j]), y1[t]); }
                            }
#pragma unroll
                            for (int t = 0; t < 8; ++t) *(LAS f32x2*)(yL + (th * 16 + sb * 8 + t) * 512 + 2 * cp) = (f32x2){y0[t], y1[t]};
                        }
                        __syncthreads();
                        u32x4 lnres[4];
#pragma unroll
                        for (int q = 0; q < 4; ++q) {
                            const int tok = wave * 4 + q;
                            const f32x4 v0 = *(const LAS f32x4*)(yL + tok * 512 + lane * 8), v1 = *(const LAS f32x4*)(yL + tok * 512 + lane * 8 + 4);
                            float sm = (v0[0] + v0[1]) + (v0[2] + v0[3]) + (v1[0] + v1[1]) + (v1[2] + v1[3]);
                            sm = wave_sum(sm); const float mu = sm * (1.0f / 512.0f);
                            float f[8] = {v0[0] - mu, v0[1] - mu, v0[2] - mu, v0[3] - mu, v1[0] - mu, v1[1] - mu, v1[2] - mu, v1[3] - mu};
                            float sq = 0.f;
#pragma unroll
                            for (int i = 0; i < 8; ++i) sq += f[i] * f[i];
                            sq = wave_sum(sq); const float rstd = rsqrtf(sq * (1.0f / 512.0f) + EPSF);
#pragma unroll
                            for (int i = 0; i < 8; ++i) { const float yv = f[i] * rstd * lng[lane * 8 + i] + lnb[lane * 8 + i]; f[i] = yv * sigmoidf_(yv); }
                            lnres[q] = pack8(f);
                        }
#pragma unroll
                        for (int q = 0; q < 4; ++q) *(u32x4*)(mix + ((size_t)b * SEQ + t0 + wave * 4 + q) * 1024 + lane * 8) = lnres[q];
                        __syncthreads();
                    }
                    if (split_ && vcu >= 64) {
                        LAS float* scr = (LAS float*)(lds + wave * 16384);
                        const int gw2 = (vcu - 64) * 8 + wave, NGW2 = (G - 64) * 8;
                        if (l == 0) { transpose_layer(ap, ws, 1, scr, gw2, NGW2, lane); transpose_layer(ap, ws, 2, scr, gw2, NGW2, lane); }
                        else transpose_layer(ap, ws, 3, scr, gw2, NGW2, lane);
                    }
                }
#endif
            } else if (s == 2 && !odd) {
                const int gw = vcu * 8 + wave, NGW = G * 8;
                const float* og = ap->in[9] + eo * 128;
                float ogr[8];
#pragma unroll
                for (int i = 0; i < 8; ++i) ogr[i] = og[(lane & 15) * 8 + i];
                for (int m0 = gw * 4; m0 < NTOK; m0 += NGW * 4) {
                    u32x4 ov[4], gv[4];
#pragma unroll
                    for (int q = 0; q < 4; ++q) { ov[q] = *(const u32x4*)(mix + (size_t)(m0 + q) * 1024 + 512 + lane * 8); gv[q] = *(const u32x4*)(pbuf + (size_t)(m0 + q) * 3072 + 2560 + lane * 8); }
#pragma unroll
                    for (int q = 0; q < 4; ++q) {
                        float o[8], g8[8]; unpack8(ov[q], o); unpack8(gv[q], g8);
                        float ss = 0.f;
#pragma unroll
                        for (int i = 0; i < 8; ++i) ss += o[i] * o[i];
                        ss = row16_sum(ss);
                        const float rs = rsqrtf(ss * (1.0f / 128.0f) + EPSF);
                        const int c0 = (lane & 15) * 8;
#pragma unroll
                        for (int i = 0; i < 8; ++i) o[i] = o[i] * rs * ogr[i] * (g8[i] * sigmoidf_(g8[i]));
                        *(u32x4*)(mix + (size_t)(m0 + q) * 1024 + 512 + lane * 8) = pack8(o);
                    }
                }
            } else if (s == 1 && odd) {
#if !defined(NO_SGU)
                {
                    LAS bf16_t* VN = (LAS bf16_t*)lds;
                    const float* lng = ap->in[12] + eo * 512; const float* lnb = ap->in[13] + eo * 512;
                    const int wr = wave >> 2, wc = wave & 3, fr = lane & 15, fq = lane >> 4, tr_r = (lane & 15) >> 2, tr_c = lane & 3;
                    for (int item = vcu; item < 512; item += G) {
                        const int ritem = 511 - item;
                        const int b = ritem >> 5, n = ritem & 31;
                        const size_t row0 = (size_t)b * SEQ + n * 128;
                        const int sT = tid >> 2, qd = tid & 3;
                        {
                            const bf16_t* pr = pbuf + (row0 + sT) * 3328 + 512 + qd * 128;
                            float sm = 0.f, sq = 0.f;
#pragma unroll 4
                            for (int i = 0; i < 16; ++i) { const u32x4 rawv = *(const u32x4*)(pr + i * 8); float f[8]; unpack8(rawv, f);
#pragma unroll
                                for (int j = 0; j < 8; ++j) { sm += f[j]; sq += f[j] * f[j]; } }
                            sm += __shfl_xor(sm, 1); sm += __shfl_xor(sm, 2); sq += __shfl_xor(sq, 1); sq += __shfl_xor(sq, 2);
                            const float mu = sm * (1.0f / 512.0f); const float var = fmaxf(sq * (1.0f / 512.0f) - mu * mu, 0.f); const float rstd = rsqrtf(var + EPSF);
#pragma unroll 2
                            for (int i = 0; i < 16; ++i) { const u32x4 rawv = *(const u32x4*)(pr + i * 8); float f[8]; unpack8(rawv, f);
                                const f32x4 g0 = *(const f32x4*)(lng + qd * 128 + i * 8), g1 = *(const f32x4*)(lng + qd * 128 + i * 8 + 4);
                                const f32x4 b0 = *(const f32x4*)(lnb + qd * 128 + i * 8), b1 = *(const f32x4*)(lnb + qd * 128 + i * 8 + 4);
#pragma unroll
                                for (int j = 0; j < 4; ++j) { f[j] = (f[j] - mu) * rstd * g0[j] + b0[j]; f[4 + j] = (f[4 + j] - mu) * rstd * g1[j] + b1[j]; }
                                *(LAS u32x4*)(VN + sT * 520 + qd * 128 + i * 8) = pack8(f); }
                        }
                        asm volatile("s_waitcnt lgkmcnt(0)" ::: "memory"); __builtin_amdgcn_s_barrier(); asm volatile("" ::: "memory");
#pragma unroll 1
                        for (int gI = 0; gI < 4; ++gI) {
                            const float* wg = ap->in[14] + ((size_t)eo * 4 + gI) * 128 * 128; const float* bsg = ap->in[15] + (eo * 4 + gI) * 128;
                            f32x4 acc[4][2];
#pragma unroll
                            for (int m = 0; m < 4; ++m) { acc[m][0] = (f32x4){0.f, 0.f, 0.f, 0.f}; acc[m][1] = (f32x4){0.f, 0.f, 0.f, 0.f}; }
#pragma unroll
                            for (int k0 = 0; k0 < 128; k0 += 32) {
                                if (k0 <= wr * 64 + 63) {
                                    f32x4 wv[4][2];
#pragma unroll
                                    for (int m = 0; m < 4; ++m) { wv[m][0] = (f32x4){0.f, 0.f, 0.f, 0.f}; wv[m][1] = wv[m][0];
                                        if (k0 <= wr * 64 + m * 16 + 15) { const int t = wr * 64 + m * 16 + fr, s0 = k0 + fq * 8; wv[m][0] = *(const f32x4*)(wg + t * 128 + s0); wv[m][1] = *(const f32x4*)(wg + t * 128 + s0 + 4); } }
                                    asm volatile("" ::: "memory");
                                    bf16x8 X[2];
#pragma unroll
                                    for (int nn = 0; nn < 2; ++nn) {
                                        const LAS bf16_t* vp = VN + (k0 + fq * 8 + tr_r) * 520 + gI * 128 + wc * 32 + nn * 16 + 4 * tr_c;
                                        const v4i16_t lo = __builtin_amdgcn_ds_read_tr16_b64_v4i16((LAS v4i16_t*)vp), hi = __builtin_amdgcn_ds_read_tr16_b64_v4i16((LAS v4i16_t*)(vp + 4 * 520));
                                        X[nn] = (bf16x8){lo[0], lo[1], lo[2], lo[3], hi[0], hi[1], hi[2], hi[3]};
                                    }
#pragma unroll
                                    for (int m = 0; m < 4; ++m) {
                                        if (k0 <= wr * 64 + m * 16 + 15) {
                                            const int t = wr * 64 + m * 16 + fr, s0 = k0 + fq * 8;
                                            const f32x4 w0 = wv[m][0], w1 = wv[m][1];
                                            float wf[8] = {w0[0], w0[1], w0[2], w0[3], w1[0], w1[1], w1[2], w1[3]};
#pragma unroll
                                            for (int i = 0; i < 8; ++i) wf[i] = (s0 + i <= t) ? wf[i] : 0.f;
                                            const u32x4 yp = pack8(wf); const bf16x8 Y = __builtin_bit_cast(bf16x8, yp);
                                            acc[m][0] = __builtin_amdgcn_mfma_f32_16x16x32_bf16(X[0], Y, acc[m][0], 0, 0, 0);
                                            acc[m][1] = __builtin_amdgcn_mfma_f32_16x16x32_bf16(X[1], Y, acc[m][1], 0, 0, 0);
                                        }
                                    }
                                }
                            }
                            u32x2 uva[4][2]; float bia[4];
#pragma unroll
                            for (int m = 0; m < 4; ++m) { const int t = wr * 64 + m * 16 + fr; bia[m] = bsg[t];
#pragma unroll
                                for (int nn = 0; nn < 2; ++nn) uva[m][nn] = *(const u32x2*)(pbuf + (row0 + t) * 3328 + gI * 128 + wc * 32 + nn * 16 + 4 * fq); }
                            asm volatile("" ::: "memory");
#pragma unroll
                            for (int m = 0; m < 4; ++m) {
                                const int t = wr * 64 + m * 16 + fr; const float bias = bia[m];
#pragma unroll
                                for (int nn = 0; nn < 2; ++nn) {
                                    const int c0 = wc * 32 + nn * 16 + 4 * fq;
                                    const u32x2 uv = uva[m][nn];
                                    const float o0 = bf_lo(uv.x) * (acc[m][nn][0] + bias), o1 = bf_hi(uv.x) * (acc[m][nn][1] + bias), o2 = bf_lo(uv.y) * (acc[m][nn][2] + bias), o3 = bf_hi(uv.y) * (acc[m][nn][3] + bias);
                                    u32x2 w; w.x = pk_bf16(o0, o1); w.y = pk_bf16(o2, o3);
                                    *(u32x2*)(mix + (row0 + t) * 1280 + gI * 128 + c0) = w;
                                }
                            }
                        }
                        asm volatile("s_waitcnt lgkmcnt(0)" ::: "memory"); __builtin_amdgcn_s_barrier(); asm volatile("" ::: "memory");
                    }
                }
#endif
#if !defined(NO_ATTN)
                {
                    LAS bf16_t* QL = (LAS bf16_t*)lds; LAS bf16_t* KL = (LAS bf16_t*)(lds + 18432); LAS bf16_t* VL = (LAS bf16_t*)(lds + 55296);
                    const int fr = lane & 15, fq = lane >> 4, tr_r = (lane & 15) >> 2, tr_c = lane & 3;
                    float gq16[16], gk16[16];
#pragma unroll
                    for (int i = 0; i < 16; ++i) { gq16[i] = ap->in[16][eo * 64 + (tid & 3) * 16 + i] * 0.125f; gk16[i] = ap->in[17][eo * 64 + (tid & 3) * 16 + i]; }
                    u32x4 rq[3][2], rv[4];
#pragma unroll
                    for (int i_ = 0; i_ < 3; ++i_) { rq[i_][0] = (u32x4){0u, 0u, 0u, 0u}; rq[i_][1] = (u32x4){0u, 0u, 0u, 0u}; }
#pragma unroll
                    for (int i_ = 0; i_ < 4; ++i_) rv[i_] = (u32x4){0u, 0u, 0u, 0u};
#define ATT_DECODE(it) const int rit_ = 6143 - (it); const int bj_ = rit_ / 96, q96_ = rit_ % 96, b = bj_ >> 2, j = bj_ & 3, cfg = q96_ >> 5, qq_ = q96_ & 31; \
                        const int sh = cfg * 2, r = (cfg == 0) ? 0 : (cfg == 1 ? (qq_ >> 3) : (qq_ >> 1)), n = (cfg == 0) ? qq_ : (cfg == 1 ? (qq_ & 7) : (qq_ & 1)); \
                        const int hd = cfg * 4 + j; const size_t rowb = (size_t)b * SEQ; (void)hd; (void)rowb; (void)n; (void)r; (void)sh;
#define ATT_LOAD(it) do { ATT_DECODE(it) \
                        _Pragma("unroll") for (int r3 = 0; r3 < 3; ++r3) { const int idx = tid + 512 * r3, rowi = idx >> 2, part = idx & 3; const bool isq = rowi < 128; \
                            const int sub = isq ? (n * 128 + rowi) : ((n - 1) * 128 + (rowi - 128)); const bool valid = sub >= 0; const int tok = valid ? ((sub << sh) + r) : 0; \
                            const bf16_t* src = pbuf + (rowb + tok) * 3328 + (isq ? 1024 : 1792) + hd * 64 + part * 16; \
                            rq[r3][0] = (u32x4){0u, 0u, 0u, 0u}; rq[r3][1] = rq[r3][0]; if (valid) { rq[r3][0] = *(const u32x4*)src; rq[r3][1] = *(const u32x4*)(src + 8); } } \
                        _Pragma("unroll") for (int r4 = 0; r4 < 4; ++r4) { const int idx = tid + 512 * r4, ks = idx >> 3, c8 = idx & 7; const int sub = (n - 1) * 128 + ks; \
                            rv[r4] = (u32x4){0u, 0u, 0u, 0u}; if (sub >= 0) rv[r4] = *(const u32x4*)(pbuf + (rowb + ((sub << sh) + r)) * 3328 + 2560 + hd * 64 + c8 * 8); } } while (0)
                    if (vcu < 6144) ATT_LOAD(vcu);
                    for (int item = vcu; item < 6144; item += G) {
                        ATT_DECODE(item)
#pragma unroll
                        for (int r3 = 0; r3 < 3; ++r3) {
                            const int idx = tid + 512 * r3, rowi = idx >> 2, part = idx & 3;
                            const bool isq = rowi < 128;
                            const int sub = isq ? (n * 128 + rowi) : ((n - 1) * 128 + (rowi - 128));
                            const int tok = (sub >= 0) ? ((sub << sh) + r) : 0;
                            float f[16]; unpack8(rq[r3][0], f); unpack8(rq[r3][1], f + 8);
                            float ss = 0.f;
#pragma unroll
                            for (int i = 0; i < 16; ++i) ss += f[i] * f[i];
                            ss += __shfl_xor(ss, 1); ss += __shfl_xor(ss, 2);
                            const float rs = rsqrtf(ss * (1.0f / 64.0f) + EPSF);
#pragma unroll
                            for (int i = 0; i < 16; ++i) f[i] = f[i] * rs * (r3 == 0 ? gq16[i] : gk16[i]);
                            if (part == 0) {
                                const float tf = (float)tok;
                                const float crev[8] = {0.15915494309189535f, 0.03086376340470123f, 0.005985185712713705f, 0.001160663641240061f, 0.00022507907903927653f, 4.364795279280289e-05f, 8.464330808241401e-06f, 1.6414262627950345e-06f};
#pragma unroll
                                for (int i = 0; i < 8; ++i) { const float rev = __builtin_amdgcn_fractf(tf * crev[i]); const float c = __builtin_amdgcn_cosf(rev), sn = __builtin_amdgcn_sinf(rev), x1 = f[i], x2 = f[8 + i]; f[i] = x1 * c - x2 * sn; f[8 + i] = x2 * c + x1 * sn; }
                            }
                            LAS bf16_t* dst = isq ? (QL + rowi * 72 + part * 16) : (KL + (rowi - 128) * 72 + part * 16);
                            *(LAS u32x4*)dst = pack8(f); *(LAS u32x4*)(dst + 8) = pack8(f + 8);
                        }
#pragma unroll
                        for (int r4 = 0; r4 < 4; ++r4) { const int idx = tid + 512 * r4, ks = idx >> 3, c8 = idx & 7; *(LAS u32x4*)(VL + ks * 72 + c8 * 8) = rv[r4]; }
                        if (item + G < 6144) ATT_LOAD(item + G);
                        asm volatile("s_waitcnt lgkmcnt(0)" ::: "memory"); __builtin_amdgcn_s_barrier(); asm volatile("" ::: "memory");
                        {
                            const int w = wave, qi = w * 16 + fr;
                            const bf16x8 Y0 = *(const LAS bf16x8*)(QL + qi * 72 + fq * 8), Y1 = *(const LAS bf16x8*)(QL + qi * 72 + 32 + fq * 8);
                            f32x4 sc[10];
                            {
                                bf16x8 KX0[9], KX1[9];
#pragma unroll
                                for (int jt = 0; jt < 9; ++jt) { const LAS bf16_t* kp = KL + ((w + jt) * 16 + fr) * 72 + fq * 8; KX0[jt] = *(const LAS bf16x8*)kp; KX1[jt] = *(const LAS bf16x8*)(kp + 32); }
                                __builtin_amdgcn_sched_barrier(0);
#pragma unroll
                                for (int jt = 0; jt < 9; ++jt) {
                                    f32x4 a = (f32x4){0.f, 0.f, 0.f, 0.f};
                                    a = __builtin_amdgcn_mfma_f32_16x16x32_bf16(KX0[jt], Y0, a, 0, 0, 0);
                                    a = __builtin_amdgcn_mfma_f32_16x16x32_bf16(KX1[jt], Y1, a, 0, 0, 0);
                                    sc[jt] = a;
                                }
                            }
                            float mx = -INFINITY;
#pragma unroll
                            for (int jt = 0; jt < 9; ++jt)
#pragma unroll
                                for (int i = 0; i < 4; ++i) {
                                    const int c = 4 * fq + i;
                                    bool ok = (n > 0) || (w + jt >= 8);
                                    if (jt == 0) ok = ok && (fr <= c);
                                    if (jt == 8) ok = ok && (fr >= c);
                                    const float v = ok ? sc[jt][i] : -INFINITY; sc[jt][i] = v; mx = fmaxf(mx, v);
                                }
                            mx = fmaxf(mx, __shfl_xor(mx, 16)); mx = fmaxf(mx, __shfl_xor(mx, 32));
                            float den = 0.f;
#pragma unroll
                            for (int jt = 0; jt < 9; ++jt)
#pragma unroll
                                for (int i = 0; i < 4; ++i) { const float e = __expf(sc[jt][i] - mx); sc[jt][i] = e; den += e; }
                            sc[9] = (f32x4){0.f, 0.f, 0.f, 0.f};
                            den += __shfl_xor(den, 16); den += __shfl_xor(den, 32);
                            f32x4 oa[4];
#pragma unroll
                            for (int et = 0; et < 4; ++et) oa[et] = (f32x4){0.f, 0.f, 0.f, 0.f};
                            v4i16_t VLO[5][4], VHI[5][4];
#pragma unroll
                            for (int jj = 0; jj < 5; ++jj) {
                                const int t0r = (w + 2 * jj) * 16, t1r = (jj < 4) ? (w + 2 * jj + 1) * 16 : t0r;
#pragma unroll
                                for (int et = 0; et < 4; ++et) {
                                    VLO[jj][et] = __builtin_amdgcn_ds_read_tr16_b64_v4i16((LAS v4i16_t*)(VL + (t0r + 4 * fq + tr_r) * 72 + et * 16 + 4 * tr_c));
                                    VHI[jj][et] = __builtin_amdgcn_ds_read_tr16_b64_v4i16((LAS v4i16_t*)(VL + (t1r + 4 * fq + tr_r) * 72 + et * 16 + 4 * tr_c));
                                }
                            }
                            __builtin_amdgcn_sched_barrier(0);
#pragma unroll
                            for (int jj = 0; jj < 5; ++jj) {
                                u32x4 pp; pp.x = pk_bf16(sc[2 * jj][0], sc[2 * jj][1]); pp.y = pk_bf16(sc[2 * jj][2], sc[2 * jj][3]); pp.z = pk_bf16(sc[2 * jj + 1][0], sc[2 * jj + 1][1]); pp.w = pk_bf16(sc[2 * jj + 1][2], sc[2 * jj + 1][3]);
                                const bf16x8 Pf = __builtin_bit_cast(bf16x8, pp);
#pragma unroll
                                for (int et = 0; et < 4; ++et) {
                                    const v4i16_t lo = VLO[jj][et], hi = VHI[jj][et];
                                    const bf16x8 xv = (bf16x8){lo[0], lo[1], lo[2], lo[3], hi[0], hi[1], hi[2], hi[3]};
                                    oa[et] = __builtin_amdgcn_mfma_f32_16x16x32_bf16(xv, Pf, oa[et], 0, 0, 0);
                                }
                            }
                            const float inv = 1.0f / den;
                            const int tokq = ((n * 128 + qi) << sh) + r;
                            bf16_t* op = mix + (rowb + tokq) * 1280 + 512 + hd * 64 + 4 * fq;
#pragma unroll
                            for (int et = 0; et < 4; ++et) { u32x2 wv; wv.x = pk_bf16(oa[et][0] * inv, oa[et][1] * inv); wv.y = pk_bf16(oa[et][2] * inv, oa[et][3] * inv); *(u32x2*)(op + et * 16) = wv; }
                            if (fq == 0) lse[(rowb + tokq) * 12 + hd] = mx + __logf(den);
                        }
                        asm volatile("s_waitcnt lgkmcnt(0)" ::: "memory"); __builtin_amdgcn_s_barrier(); asm volatile("" ::: "memory");
                    }
#undef ATT_LOAD
#undef ATT_DECODE
                }
#endif
            } else if (s == 2 && odd) {
                const int gw = vcu * 8 + wave, NGW = G * 8;
                for (int m0 = gw * 2; m0 < NTOK; m0 += NGW * 2) {
                    u32x4 v[2][2]; float al[2][2];
#pragma unroll
                    for (int q = 0; q < 2; ++q)
#pragma unroll
                        for (int c2 = 0; c2 < 2; ++c2) {
                            const int ch = lane + 64 * c2; v[q][c2] = (u32x4){0u, 0u, 0u, 0u}; al[q][c2] = 0.f;
                            if (ch < 96) {
                                const size_t m = (size_t)(m0 + q);
                                const int hd = ch >> 3, cfg = hd >> 2, j = hd & 3;
                                const float l0 = lse[m * 12 + j], l1 = lse[m * 12 + 4 + j], l2 = lse[m * 12 + 8 + j];
                                v[q][c2] = *(const u32x4*)(mix + m * 1280 + 512 + ch * 8);
                                const float mxl = fmaxf(l0, fmaxf(l1, l2));
                                const float e0 = __expf(l0 - mxl), e1 = __expf(l1 - mxl), e2 = __expf(l2 - mxl);
                                al[q][c2] = ((cfg == 0) ? e0 : (cfg == 1 ? e1 : e2)) / (e0 + e1 + e2);
                            }
                        }
#pragma unroll
                    for (int q = 0; q < 2; ++q)
#pragma unroll
                        for (int c2 = 0; c2 < 2; ++c2) {
                            const int ch = lane + 64 * c2;
                            if (ch < 96) { float f[8]; unpack8(v[q][c2], f);
#pragma unroll
                                for (int i = 0; i < 8; ++i) f[i] *= al[q][c2];
                                *(u32x4*)(mix + (size_t)(m0 + q) * 1280 + 512 + ch * 8) = pack8(f); }
                        }
                }
            } else if (s == 3) {
                const bf16_t* wt = odd ? (const bf16_t*)(ws + WS_ODWOUT) + (size_t)eo * 1024 * 1280 : (const bf16_t*)(ws + WS_EVWOUT) + (size_t)eo * 1024 * 1024;
                pg8::Gemm g{mix, wt, MW, MW, MW, 256, 4, 1, 1, 0, 0, 0, 0, 0};
                pg8::EpiR E{nullptr, xb, sx_xat, 0};
                pg8::gemm_phase<pg8::EpiR>(lds, tid, g, G, bx, E);
            } else if (s == 4) {
                pg8::Gemm g{xb, (const bf16_t*)(ws + WS_WQ) + (size_t)l * 1024 * 1024, 1024, 1024, 1024, 256, 4, 1, 1, 0, 0, 0, 0, 0};
                pg8::EpiP E{(bf16_t*)(ws + WS_QX), 1024, NTOK, sx_xat, 1.0f / (1024.0f * SC_SS), 0, qst, 4, 1, 0};
                pg8::gemm_phase<pg8::EpiP>(lds, tid, g, G, bx, E);
            } else if (s == 5) {
                pg8::Gemm g{(const bf16_t*)(ws + WS_QX), (const bf16_t*)(ws + WS_KT) + (size_t)l * 4096 * 1024, 1024, 1024, 256, 16, 1, 64, 4, SEQ * 1024, 256, 256 * 1024, 256, 0};
                pg8::EpiS E{(bf16_t*)(ws + WS_PB), qst, (LAS float*)(lds + 131072)};
                pg8::gemm_phase<pg8::EpiS>(lds, tid, g, G, bx, E);
            } else if (s == 7) {
                pg8::Gemm g{(const bf16_t*)(ws + WS_PB), (const bf16_t*)(ws + WS_VP), 1024, 1024, 1024, 16, 4, 16, 1, SEQ * 1024, 0, 1024 * 1024, 0, 0};
                pg8::EpiR E{nullptr, xb, sx_mlp, SEQ};
                pg8::gemm_phase<pg8::EpiR>(lds, tid, g, G, bx, E);
            } else if (s == 8) {
                pg8::Gemm g{xb, (const bf16_t*)(ws + WS_W1) + (size_t)l * 4096 * 1024, 1024, 1024, 1024, 256, 16, 1, 1, 0, 0, 0, 0, 0};
                pg8::EpiP E{(bf16_t*)(ws + WS_HMID), 4096, NTOK, sx_mlp, 1.0f / (1024.0f * SC_SS), 2, nullptr, 0, 1, 0};
                pg8::gemm_phase<pg8::EpiP>(lds, tid, g, G, bx, E);
            } else {
                pg8::Gemm g{(const bf16_t*)(ws + WS_HMID), (const bf16_t*)(ws + WS_W2) + (size_t)l * 1024 * 4096, 4096, 4096, 4096, 256, 4, 1, 1, 0, 0, 0, 0, 1};
                pg8::EpiR E{(l == 3) ? ap->out : nullptr, xb, (l == 3) ? (u64*)(ws + ST_QST) : sx_next, 0};
                pg8::gemm_phase<pg8::EpiR>(lds, tid, g, G, bx, E);
            }
        }
        }
        if (ph + 1 < args.hi) { if (ph == 0) cg::this_grid().sync(); else xcd_barrier((unsigned*)(ws + ST_BAR), xcc, xst); }
    }
}

constexpr int N_PHASES = 43;
extern "C" void kernel_launch(void* const* d_in, const int* in_sizes, int n_in, void* d_out, int out_size, void* d_ws, size_t ws_size, hipStream_t stream) {
    static int grid = 0;
    if (grid == 0) {
        if (n_in != 29 || ws_size < WS_END) { fprintf(stderr, "kernel_launch: need 29 inputs and %zu bytes of workspace; got %d, %zu\n", (size_t)WS_END, n_in, ws_size); grid = -1; return; }
        int dev = 0, cus = 0, per_cu = 0;
        hipGetDevice(&dev); hipDeviceGetAttribute(&cus, hipDeviceAttributeMultiprocessorCount, dev);
        if (hipFuncSetAttribute((const void*)mk_fwd, hipFuncAttributeMaxDynamicSharedMemorySize, LDS_BYTES) != hipSuccess) { fprintf(stderr, "kernel_launch: hipFuncSetAttribute failed\n"); grid = -1; return; }
        if (hipOccupancyMaxActiveBlocksPerMultiprocessor(&per_cu, (const void*)mk_fwd, 512, LDS_BYTES) != hipSuccess || per_cu < 1) per_cu = 1;
        (void)hipGetLastError();
        grid = cus * per_cu;
        fprintf(stderr, "kernel_launch: grid %d (cus %d x %d)\n", grid, cus, per_cu);
    }
    if (grid < 0) return;
    Args a{};
    for (int i = 0; i < 29; ++i) a.in[i] = (const float*)d_in[i];
    a.out = (float*)d_out; a.ws = (unsigned char*)d_ws;
#if MK_MULTI
    for (int ph = 0; ph < N_PHASES; ++ph) { a.lo = ph; a.hi = ph + 1; hipLaunchKernelGGL(mk_fwd, dim3(grid), dim3(512), LDS_BYTES, stream, a); }
#else
    a.lo = 0; a.hi = N_PHASES;
    if (hipMemsetAsync((char*)d_ws + ST_BAR, 0, 16384, stream) != hipSuccess) { fprintf(stderr, "kernel_launch: memset failed\n"); return; }
    void* kargs[] = {&a};
    hipError_t e = hipLaunchCooperativeKernel((const void*)mk_fwd, dim3(grid), dim3(512), kargs, LDS_BYTES, stream);
    if (e != hipSuccess) fprintf(stderr, "cooperative launch failed: %s (grid %d)\n", hipGetErrorString(e), grid);
#endif
}
```

```cpp
#include <hip/hip_runtime.h>
#include <hip/hip_cooperative_groups.h>
#include <cstdio>
#include <cstdint>
namespace cg = cooperative_groups;

#ifndef MK_MULTI
#define MK_MULTI 0
#endif

#define LAS __attribute__((address_space(3)))
typedef unsigned short bf16_t;
typedef short bf16x8 __attribute__((ext_vector_type(8)));
typedef float f32x4 __attribute__((ext_vector_type(4)));
typedef float f32x2 __attribute__((ext_vector_type(2)));
typedef unsigned u32x4 __attribute__((ext_vector_type(4)));
typedef unsigned u32x2 __attribute__((ext_vector_type(2)));
typedef __bf16 bf16x2_t __attribute__((ext_vector_type(2)));
typedef short v4i16_t __attribute__((ext_vector_type(4)));

constexpr int NTOK = 65536, DM = 1024, SEQ = 4096, NBATCH = 16;
constexpr float EPSF = 1e-6f;
constexpr size_t MiB = 1u << 20;
typedef unsigned long long u64;
constexpr float SC_SS = 1048576.0f, SC_L = 16777216.0f;
constexpr size_t ST_SXZ = 0;
constexpr size_t ST_QST = 11 * 512 * 1024;
constexpr size_t ST_LSUM = ST_QST + 8 * MiB;
constexpr size_t ST_KST = ST_LSUM + 8 * MiB;
constexpr size_t ST_ZERO_BYTES = ST_KST + 1 * MiB;
constexpr size_t ST_SX0 = ST_ZERO_BYTES;
constexpr size_t ST_SMEM = ST_SX0 + 512 * 1024;
constexpr size_t ST_BAR = ST_SX0 + 768 * 1024;
constexpr size_t ST_LSE = 24 * MiB;
constexpr size_t ST_ROPE = 27 * MiB;
constexpr size_t WB = 16 * MiB;
constexpr size_t WS_EVWIN = WB + 16 * MiB, WS_ODWIN = WB + 28 * MiB, WS_EVWOUT = WB + 41 * MiB, WS_ODWOUT = WB + 45 * MiB, WS_WQ = WB + 50 * MiB, WS_WKV = WB + 58 * MiB,
                 WS_WO = WB + 74 * MiB, WS_W1 = WB + 82 * MiB, WS_W2 = WB + 114 * MiB, WS_MEMB = WB + 146 * MiB, WS_KT = WB + 154 * MiB, WS_VT = WB + 186 * MiB, WS_XB = WB + 218 * MiB,
                 WS_A = WB + 346 * MiB;
constexpr size_t WS_P = WS_A, WS_MIX = WS_A + 416 * MiB, WS_KVRAW = WS_A, WS_QX = WS_A, WS_PB = WS_A + 128 * MiB, WS_AO = WS_A + 256 * MiB, WS_HMID = WS_A;
constexpr size_t WS_VP = WS_A + 576 * MiB;
constexpr size_t WS_END = WS_VP + 32 * MiB;
constexpr int LDS_BYTES = 147456;

__device__ __forceinline__ unsigned pk_bf16(float lo, float hi) { f32x2 v = {lo, hi}; bf16x2_t b = __builtin_convertvector(v, bf16x2_t); return __builtin_bit_cast(unsigned, b); }
__device__ __forceinline__ float bf_lo(unsigned u) { return __uint_as_float(u << 16); }
__device__ __forceinline__ float bf_hi(unsigned u) { return __uint_as_float(u & 0xffff0000u); }
__device__ __forceinline__ void unpack8(const u32x4 v, float* f) { f[0] = bf_lo(v.x); f[1] = bf_hi(v.x); f[2] = bf_lo(v.y); f[3] = bf_hi(v.y); f[4] = bf_lo(v.z); f[5] = bf_hi(v.z); f[6] = bf_lo(v.w); f[7] = bf_hi(v.w); }
__device__ __forceinline__ u32x4 pack8(const float* f) { u32x4 w; w.x = pk_bf16(f[0], f[1]); w.y = pk_bf16(f[2], f[3]); w.z = pk_bf16(f[4], f[5]); w.w = pk_bf16(f[6], f[7]); return w; }
__device__ __forceinline__ float sigmoidf_(float x) { return __builtin_amdgcn_rcpf(1.0f + __expf(-x)); }
__device__ __forceinline__ float wave_sum(float v) {
#pragma unroll
    for (int o = 1; o < 64; o <<= 1) v += __shfl_xor(v, o);
    return v;
}
template <int CTRL> __device__ __forceinline__ float dppf(float v) { return __int_as_float(__builtin_amdgcn_update_dpp(0, __float_as_int(v), CTRL, 0xf, 0xf, true)); }
__device__ __forceinline__ float row16_sum(float v) { v += dppf<0x128>(v); v += dppf<0x124>(v); v += dppf<0x122>(v); v += dppf<0x121>(v); return v; }
__device__ __forceinline__ f32x2 gelu_pk(f32x2 v) {
    const f32x2 av = __builtin_elementwise_abs(v), d = av * 0.2316418882f + 1.0f;
    f32x2 t; t.x = __builtin_amdgcn_rcpf(d.x); t.y = __builtin_amdgcn_rcpf(d.y);
    f32x2 q = t * 0.5307027145f + (-0.7265760135f); q = q * t + 0.7107068705f; q = q * t + (-0.142248368f); q = q * t + 0.127414796f; q = q * t;
    const f32x2 s = (v * v) * (-0.72134752044f);
    f32x2 e; e.x = __builtin_amdgcn_exp2f(s.x); e.y = __builtin_amdgcn_exp2f(s.y);
    const f32x2 m = v * (q * e), r = v - m;
    f32x2 o; o.x = v.x < 0.f ? m.x : r.x; o.y = v.y < 0.f ? m.y : r.y; return o;
}

namespace pg8 {
constexpr int BM = 256, BK = 64, HALF = 128, HTB = HALF * BK * 2, STAGE_BYTES = 8 * HTB, WGM = 8;
__host__ __device__ __forceinline__ int lds_byte(int r, int c) { const int st = (r >> 4) * 2 + (c >> 5), rr = r & 15, cc = c & 31, ob = rr * 64 + cc * 2; return st * 1024 + (ob ^ (((ob >> 9) & 1) << 5)); }
__host__ __device__ __forceinline__ void stage_rc(int b, int& R, int& C) { const int st = b / 1024, sb = b % 1024, swz = sb ^ (((sb >> 9) & 1) << 5); R = (st >> 1) * 16 + swz / 64; C = (st & 1) * 32 + (swz % 64) / 2; }
__host__ __device__ __forceinline__ int perm32(int rho) { const int n = rho >> 4, i = rho & 15; return 8 * (i >> 2) + 4 * n + (i & 3); }

struct Unit { int pm, pn, z; };
struct Gemm { const bf16_t* A; const bf16_t* Bt; int lda, ldb, K, nM, nN, nZ, ZL; int sAh, sAl, sBh, sBl; int rev; };
struct Order {
    int nM, nN, per, nwg, G, c, rev;
    __device__ __forceinline__ void init(const Gemm& g, int G_, int c_) { nM = g.nM; nN = g.nN; per = nM * nN; nwg = per * g.nZ; G = G_; c = c_; rev = g.rev; }
    __device__ __forceinline__ bool next(int i, Unit& u) const {
        const long L = (long)i * G + c; if (L >= nwg) return false;
        int w = (int)L;
        if ((nwg & 7) == 0) { const int ch = nwg >> 3, off = w >> 3; w = (w & 7) * ch + (rev ? ch - 1 - off : off); }
        u.z = w / per; const int t = w % per;
        const int nig = WGM * nN, gid = t / nig, fm = gid * WGM, gsz = (nM - fm) < WGM ? (nM - fm) : WGM;
        u.pm = fm + ((t % nig) % gsz); u.pn = (t % nig) / gsz; return true;
    }
};
__device__ __forceinline__ const char* a_ptr(const Gemm& g, const Unit& u) { return (const char*)(g.A + ((u.z / g.ZL) * g.sAh + (u.z % g.ZL) * g.sAl + u.pm * BM * g.lda)); }
__device__ __forceinline__ const char* b_ptr(const Gemm& g, const Unit& u) { return (const char*)(g.Bt + ((u.z / g.ZL) * g.sBh + (u.z % g.ZL) * g.sBl + u.pn * BM * g.ldb)); }

struct EpiP {
    static constexpr bool PERM = true;
    bf16_t* O; int ldc; int Mz; const u64* rstat; float rinv; int act; u64* hstat; int hs_ld; int ZLo; int zcol;
    __device__ __forceinline__ void operator()(f32x4 (&acc)[2][2][4][2], const Unit& u, int wr, int wc, int fr, int fq) const {
        const int row0 = u.pm * BM + wr * 64 + fr, col0 = u.pn * BM + wc * 32 + 8 * fq;
        const bool do_gelu = (act == 1) && (u.pn < 4);
        float rsv[8];
#pragma unroll
        for (int q = 0; q < 8; ++q) rsv[q] = 1.f;
        if (rstat) {
            u64 sv[8];
#pragma unroll
            for (int q = 0; q < 8; ++q) sv[q] = rstat[row0 + (q >> 2) * HALF + (q & 3) * 16];
#pragma unroll
            for (int q = 0; q < 8; ++q) rsv[q] = rsqrtf((float)sv[q] * rinv + EPSF);
        }
        asm volatile("" ::: "memory");
#pragma unroll
        for (int ai = 0; ai < 2; ++ai)
#pragma unroll
            for (int m = 0; m < 4; ++m) {
                const int row = row0 + ai * HALF + m * 16;
                const float rs = rsv[ai * 4 + m];
                float hs = 0.f;
                bf16_t* rowp = O + ((long)(u.z / ZLo) * Mz + row) * ldc + (u.z % ZLo) * zcol + col0;
#pragma unroll
                for (int bj = 0; bj < 2; ++bj) {
                    f32x4 v0 = acc[ai][bj][m][0] * rs, v1 = acc[ai][bj][m][1] * rs;
                    if (do_gelu) { f32x2 a = gelu_pk((f32x2){v0[0], v0[1]}), b = gelu_pk((f32x2){v0[2], v0[3]}), c = gelu_pk((f32x2){v1[0], v1[1]}), d = gelu_pk((f32x2){v1[2], v1[3]});
                        v0 = (f32x4){a.x, a.y, b.x, b.y}; v1 = (f32x4){c.x, c.y, d.x, d.y}; }
                    else if (act == 2) {
#pragma unroll
                        for (int i = 0; i < 4; ++i) { const float a = fmaxf(v0[i], 0.f), b = fmaxf(v1[i], 0.f); v0[i] = a * a; v1[i] = b * b; } }
                    hs += (v0[0] * v0[0] + v0[1] * v0[1]) + (v0[2] * v0[2] + v0[3] * v0[3]) + (v1[0] * v1[0] + v1[1] * v1[1]) + (v1[2] * v1[2] + v1[3] * v1[3]);
                    u32x4 w; w.x = pk_bf16(v0[0], v0[1]); w.y = pk_bf16(v0[2], v0[3]); w.z = pk_bf16(v1[0], v1[1]); w.w = pk_bf16(v1[2], v1[3]);
                    *(u32x4*)(rowp + bj * HALF) = w;
                }
                if (hstat) { hs += __shfl_xor(hs, 16); hs += __shfl_xor(hs, 32); if (fq == 0) atomicAdd(hstat + ((long)u.z * Mz + row) * hs_ld + u.pn, (u64)(hs * SC_SS + 0.5f)); }
            }
    }
};
struct EpiS {
    static constexpr bool PERM = true;
    bf16_t* P; const u64* qstat; LAS float* xch;
    __device__ __forceinline__ void operator()(f32x4 (&acc)[2][2][4][2], const Unit& u, int wr, int wc, int fr, int fq) const {
        const int b = u.z >> 2, h = u.z & 3;
        const int row0 = b * SEQ + u.pm * BM + wr * 64 + fr, col0 = h * 256 + wc * 32 + 8 * fq;
        float rsv[8];
        { u64 sv[8];
#pragma unroll
          for (int q = 0; q < 8; ++q) sv[q] = qstat[(long)(row0 + (q >> 2) * HALF + (q & 3) * 16) * 4 + h];
#pragma unroll
          for (int q = 0; q < 8; ++q) rsv[q] = rsqrtf((float)sv[q] * (1.0f / (256.0f * SC_SS)) + EPSF) * 1.4426950408889634f; }
#pragma unroll
        for (int ai = 0; ai < 2; ++ai)
#pragma unroll
            for (int m = 0; m < 4; ++m) {
                const int rl = ai * HALF + wr * 64 + m * 16 + fr;
                const float rs = rsv[ai * 4 + m];
                float sum = 0.f;
#pragma unroll
                for (int bj = 0; bj < 2; ++bj)
#pragma unroll
                    for (int n = 0; n < 2; ++n)
#pragma unroll
                        for (int i = 0; i < 4; ++i) { const float e = __builtin_amdgcn_exp2f(acc[ai][bj][m][n][i] * rs); acc[ai][bj][m][n][i] = e; sum += e; }
                sum += __shfl_xor(sum, 16); sum += __shfl_xor(sum, 32);
                if (fq == 0) xch[rl * 4 + wc] = sum;
            }
        asm volatile("s_waitcnt lgkmcnt(0)" ::: "memory"); __builtin_amdgcn_s_barrier(); asm volatile("" ::: "memory");
#pragma unroll
        for (int ai = 0; ai < 2; ++ai)
#pragma unroll
            for (int m = 0; m < 4; ++m) {
                const int row = row0 + ai * HALF + m * 16, rl = ai * HALF + wr * 64 + m * 16 + fr;
                const f32x4 t = *(const LAS f32x4*)(xch + rl * 4);
                const float inv = 1.0f / ((t[0] + t[1]) + (t[2] + t[3]));
                bf16_t* rowp = P + (long)row * 1024 + col0;
#pragma unroll
                for (int bj = 0; bj < 2; ++bj) {
                    const f32x4 v0 = acc[ai][bj][m][0] * inv, v1 = acc[ai][bj][m][1] * inv;
                    u32x4 w; w.x = pk_bf16(v0[0], v0[1]); w.y = pk_bf16(v0[2], v0[3]); w.z = pk_bf16(v1[0], v1[1]); w.w = pk_bf16(v1[2], v1[3]);
                    *(u32x4*)(rowp + bj * HALF) = w;
                }
            }
    }
};
struct EpiO {
    static constexpr bool PERM = true;
    bf16_t* O; const u64* lsum;
    __device__ __forceinline__ void operator()(f32x4 (&acc)[2][2][4][2], const Unit& u, int wr, int wc, int fr, int fq) const {
        const int b = u.z >> 2, h = u.z & 3;
        const int row0 = b * SEQ + u.pm * BM + wr * 64 + fr, col0 = h * 256 + wc * 32 + 8 * fq;
#pragma unroll
        for (int ai = 0; ai < 2; ++ai)
#pragma unroll
            for (int m = 0; m < 4; ++m) {
                const int row = row0 + ai * HALF + m * 16;
                const float inv = SC_L / (float)lsum[(long)row * 4 + h];
                bf16_t* rowp = O + (long)row * 1024 + col0;
#pragma unroll
                for (int bj = 0; bj < 2; ++bj) {
                    const f32x4 v0 = acc[ai][bj][m][0] * inv, v1 = acc[ai][bj][m][1] * inv;
                    u32x4 w; w.x = pk_bf16(v0[0], v0[1]); w.y = pk_bf16(v0[2], v0[3]); w.z = pk_bf16(v1[0], v1[1]); w.w = pk_bf16(v1[2], v1[3]);
                    *(u32x4*)(rowp + bj * HALF) = w;
                }
            }
    }
};
struct EpiR {
    static constexpr bool PERM = true;
    float* out; bf16_t* xb; u64* stat; int Mz;
    __device__ __forceinline__ bool can_repeat() const { return false; }
    __device__ __forceinline__ void operator()(f32x4 (&acc)[2][2][4][2], const Unit& u, int wr, int wc, int fr, int fq) const {
        const int row0 = u.z * Mz + u.pm * BM + wr * 64 + fr, col0 = u.pn * BM + wc * 32 + 8 * fq;
        u32x4 xv[2][2][2];
#define EPIR_LOAD(q_, buf_) do { _Pragma("unroll") for (int mm = 0; mm < 2; ++mm) _Pragma("unroll") for (int bj = 0; bj < 2; ++bj) \
            xv[buf_][mm][bj] = *(const u32x4*)(xb + (size_t)(row0 + ((q_) >> 1) * HALF + (((q_) & 1) * 2 + mm) * 16) * DM + col0 + bj * HALF); } while (0)
        EPIR_LOAD(0, 0);
#pragma unroll
        for (int q = 0; q < 4; ++q) {
            if (q < 3) EPIR_LOAD(q + 1, (q + 1) & 1);
            asm volatile("" ::: "memory");
            const int ai = q >> 1;
#pragma unroll
            for (int mm = 0; mm < 2; ++mm) {
                const int m = (q & 1) * 2 + mm;
                const int row = row0 + ai * HALF + m * 16; const size_t off = (size_t)row * DM + col0;
                float ss = 0.f;
#pragma unroll
                for (int bj = 0; bj < 2; ++bj) {
                    float f[8]; unpack8(xv[q & 1][mm][bj], f);
#pragma unroll
                    for (int i = 0; i < 4; ++i) { f[i] += acc[ai][bj][m][0][i]; f[4 + i] += acc[ai][bj][m][1][i]; }
#pragma unroll
                    for (int i = 0; i < 8; ++i) ss += f[i] * f[i];
                    *(u32x4*)(xb + off + bj * HALF) = pack8(f);
                    if (out) { *(f32x4*)(out + off + bj * HALF) = (f32x4){f[0], f[1], f[2], f[3]}; *(f32x4*)(out + off + bj * HALF + 4) = (f32x4){f[4], f[5], f[6], f[7]}; }
                }
                ss += __shfl_xor(ss, 16); ss += __shfl_xor(ss, 32);
                if (fq == 0) atomicAdd(stat + row, (u64)(ss * SC_SS + 0.5f));
            }
            asm volatile("" ::: "memory");
        }
#undef EPIR_LOAD
    }
};

template <class Epi>
__device__ __forceinline__ void gemm_phase(LAS unsigned char* lds, const int tid, const Gemm g, const int G, const int cidx, const Epi& E) {
    const int wid = __builtin_amdgcn_readfirstlane(tid >> 6), lane = tid & 63, wr = wid >> 2, wc = wid & 3, fr = lane & 15, fq = lane >> 4;
    Order S; S.init(g, G, cidx);
    const int K = g.K, nt = K / BK;
    unsigned voffA[2], voffB[2];
#pragma unroll
    for (int i = 0; i < 2; ++i) { int R, C; stage_rc(tid * 16 + i * 8192, R, C); const int Rb = Epi::PERM ? ((R & ~31) + perm32(R & 31)) : R;
        voffA[i] = (unsigned)(R * g.lda + C) * 2u; voffB[i] = (unsigned)(Rb * g.ldb + C) * 2u; }
    const size_t kstep = (size_t)(BK * 2);
    const size_t hstepA = (size_t)HALF * g.lda * 2, hstepB = (size_t)HALF * g.ldb * 2;
    const unsigned ldsw = (unsigned)wid * 1024u;
    const int aoff = lds_byte(wr * 64 + fr, fq * 8), boff = lds_byte(wc * 32 + fr, fq * 8);
#define PG8_SA(b, h) (((b) * 2 + (h)) * HTB)
#define PG8_SB(b, h) ((4 + (b) * 2 + (h)) * HTB)
#define PG8_STAGE(bufoff, gbase, voff) do { _Pragma("unroll") for (int _i = 0; _i < 2; ++_i) \
        __builtin_amdgcn_global_load_lds((const unsigned*)((const char*)(gbase) + (voff)[_i]), (LAS unsigned*)(lds + (bufoff) + ldsw + _i * 8192), 16, 0, 0); } while (0)
#define PG8_LDA(dst, b, h) do { _Pragma("unroll") for (int m = 0; m < 4; ++m) _Pragma("unroll") for (int k = 0; k < 2; ++k) dst[m][k] = *(const LAS bf16x8*)(lds + PG8_SA(b, h) + aoff + m * 2048 + k * 1024); } while (0)
#define PG8_LDB(dst, b, h) do { _Pragma("unroll") for (int n = 0; n < 2; ++n) _Pragma("unroll") for (int k = 0; k < 2; ++k) dst[n][k] = *(const LAS bf16x8*)(lds + PG8_SB(b, h) + boff + n * 2048 + k * 1024); } while (0)
#define PG8_MMA(ai, bj, At, Bt) do { __builtin_amdgcn_s_setprio(1); _Pragma("unroll") for (int m = 0; m < 4; ++m) _Pragma("unroll") for (int n = 0; n < 2; ++n) _Pragma("unroll") for (int k = 0; k < 2; ++k) \
        acc[ai][bj][m][n] = __builtin_amdgcn_mfma_f32_16x16x32_bf16(Bt[n][k], At[m][k], acc[ai][bj][m][n], 0, 0, 0); __builtin_amdgcn_s_setprio(0); } while (0)
#define PG8_WAIT_V(n) asm volatile("s_waitcnt vmcnt(" #n ")" ::: "memory")
#define PG8_WAIT_L(n) asm volatile("s_waitcnt lgkmcnt(" #n ")" ::: "memory")
#define PG8_BAR __builtin_amdgcn_s_barrier()
#define PG8_SCHED __builtin_amdgcn_sched_barrier(0)
    Unit cur, nxt; int ui = 0;
    if (!S.next(0, cur)) return;
    f32x4 acc[2][2][4][2];
#pragma unroll
    for (int a = 0; a < 2; ++a)
#pragma unroll
        for (int b = 0; b < 2; ++b)
#pragma unroll
            for (int m = 0; m < 4; ++m)
#pragma unroll
                for (int n = 0; n < 2; ++n) acc[a][b][m][n] = (f32x4){0.f, 0.f, 0.f, 0.f};
    bf16x8 At[4][2], B0[2][2], B1[2][2];
    const char* cA = a_ptr(g, cur); const char* cB = b_ptr(g, cur);
    PG8_STAGE(PG8_SB(0, 0), cB, voffB); PG8_STAGE(PG8_SB(0, 1), cB + hstepB, voffB); PG8_STAGE(PG8_SA(0, 0), cA, voffA); PG8_STAGE(PG8_SA(0, 1), cA + hstepA, voffA);
    if (wr == 1) PG8_BAR;
    PG8_WAIT_V(2); PG8_BAR;
    PG8_STAGE(PG8_SB(1, 0), cB + kstep, voffB); PG8_STAGE(PG8_SA(1, 0), cA + kstep, voffA); PG8_STAGE(PG8_SB(1, 1), cB + hstepB + kstep, voffB);
    PG8_WAIT_V(6); PG8_BAR;
    for (;;) {
        const bool has_next = S.next(ui + 1, nxt);
        const char* nA = has_next ? a_ptr(g, nxt) : cA; const char* nB = has_next ? b_ptr(g, nxt) : cB;
        for (int t = 0; t < nt; t += 2) {
            const bool last = (t == nt - 2);
            const char* a1 = cA + (size_t)(t + 1) * kstep;
            const char* a2 = last ? nA : cA + (size_t)(t + 2) * kstep; const char* b2 = last ? nB : cB + (size_t)(t + 2) * kstep;
            const char* a3 = a2 + kstep; const char* b3 = b2 + kstep;
            PG8_LDB(B0, 0, 0); PG8_LDB(B1, 0, 1); PG8_SCHED; PG8_LDA(At, 0, 0); PG8_STAGE(PG8_SA(1, 1), a1 + hstepA, voffA);
            PG8_WAIT_V(8); PG8_WAIT_L(0); PG8_BAR; PG8_MMA(0, 0, At, B0); PG8_MMA(0, 1, At, B1); PG8_BAR; PG8_SCHED;
            PG8_LDA(At, 0, 1); PG8_STAGE(PG8_SB(0, 0), b2, voffB); PG8_STAGE(PG8_SB(0, 1), b2 + hstepB, voffB); PG8_STAGE(PG8_SA(0, 0), a2, voffA);
            PG8_WAIT_V(8); PG8_WAIT_L(0); PG8_BAR; PG8_MMA(1, 0, At, B0); PG8_MMA(1, 1, At, B1); PG8_BAR; PG8_SCHED;
            PG8_LDB(B0, 1, 0); PG8_LDB(B1, 1, 1); PG8_SCHED; PG8_LDA(At, 1, 0); PG8_STAGE(PG8_SA(0, 1), a2 + hstepA, voffA);
            PG8_WAIT_V(8); PG8_WAIT_L(0); PG8_BAR; PG8_MMA(0, 0, At, B0); PG8_MMA(0, 1, At, B1); PG8_BAR; PG8_SCHED;
            PG8_LDA(At, 1, 1); PG8_STAGE(PG8_SB(1, 0), b3, voffB); PG8_STAGE(PG8_SB(1, 1), b3 + hstepB, voffB); PG8_STAGE(PG8_SA(1, 0), a3, voffA);
            PG8_WAIT_V(8); PG8_WAIT_L(0); PG8_BAR; PG8_MMA(1, 0, At, B0); PG8_MMA(1, 1, At, B1); PG8_BAR; PG8_SCHED;
        }
        if (wr == 0) PG8_BAR;
        E(acc, cur, wr, wc, fr, fq);
        if (!has_next) break;
#pragma unroll
        for (int a = 0; a < 2; ++a)
#pragma unroll
            for (int b = 0; b < 2; ++b)
#pragma unroll
                for (int m = 0; m < 4; ++m)
#pragma unroll
                    for (int n = 0; n < 2; ++n) acc[a][b][m][n] = (f32x4){0.f, 0.f, 0.f, 0.f};
        cur = nxt; cA = nA; cB = nB; ++ui;
        if (wr == 1) PG8_BAR;
    }
    PG8_WAIT_V(0);
    PG8_BAR;
#undef PG8_SA
#undef PG8_SB
#undef PG8_STAGE
#undef PG8_LDA
#undef PG8_LDB
#undef PG8_MMA
#undef PG8_WAIT_V
#undef PG8_WAIT_L
#undef PG8_BAR
#undef PG8_SCHED
}
}

struct Args { const float* in[29]; float* out; unsigned char* ws; int lo, hi; };

__device__ __forceinline__ void transpose_item(const float* W, int K, int N, const float* gain, bf16_t* WT, LAS float* scr, int item, int lane) {
    const int nblk = N / 32, kb = item / nblk, nb = item % nblk, k0 = 64 * kb, n0 = 32 * nb;
    {
        float wv[32]; const float* wp = W + (size_t)(k0 + (lane >> 5)) * N + n0 + (lane & 31);
#pragma unroll
        for (int i = 0; i < 32; ++i) wv[i] = wp[(size_t)(2 * i) * N];
        if (gain) { const float* gp = gain + k0 + (lane >> 5);
#pragma unroll
            for (int i = 0; i < 32; ++i) wv[i] *= gp[2 * i]; }
#pragma unroll
        for (int i = 0; i < 32; ++i) scr[(2 * i + (lane >> 5)) * 33 + (lane & 31)] = wv[i];
    }
    asm volatile("s_waitcnt lgkmcnt(0)" ::: "memory");
    const int c = lane & 7;
#pragma unroll
    for (int j = 0; j < 4; ++j) { const int n = (lane >> 3) + 8 * j; const LAS float* s = scr + (8 * c) * 33 + n;
        u32x4 o; o.x = pk_bf16(s[0 * 33], s[1 * 33]); o.y = pk_bf16(s[2 * 33], s[3 * 33]); o.z = pk_bf16(s[4 * 33], s[5 * 33]); o.w = pk_bf16(s[6 * 33], s[7 * 33]);
        *(u32x4*)(WT + (size_t)(n0 + n) * K + k0 + 8 * c) = o; }
    asm volatile("s_waitcnt lgkmcnt(0)" ::: "memory");
}
__device__ __forceinline__ void transpose_all(const float* W, int K, int N, const float* gain, bf16_t* WT, LAS float* scr, int gw, int NGW, int lane) {
    const int nitems = (K / 64) * (N / 32);
    for (int it = gw; it < nitems; it += NGW) transpose_item(W, K, N, gain, WT, scr, it, lane);
}
__device__ __forceinline__ void row_to_bf16(const float* xrow, bf16_t* orow, u64* ss, int lane) {
    const f32x4* xr = (const f32x4*)xrow + lane; float s = 0.f; f32x4 v[4];
#pragma unroll
    for (int j = 0; j < 4; ++j) { v[j] = xr[64 * j]; s += (v[j].x * v[j].x + v[j].y * v[j].y) + (v[j].z * v[j].z + v[j].w * v[j].w); }
    s = wave_sum(s);
    u32x2* o8 = (u32x2*)orow + lane;
#pragma unroll
    for (int j = 0; j < 4; ++j) { u32x2 w; w.x = pk_bf16(v[j].x, v[j].y); w.y = pk_bf16(v[j].z, v[j].w); o8[64 * j] = w; }
    if (lane == 0) *ss = (u64)(s * SC_SS + 0.5f);
}

__device__ __forceinline__ void transpose_layer(const __attribute__((address_space(4))) Args* ap, unsigned char* ws, int l, LAS float* scr, int gw, int NGW, int lane) {
    const int e = l >> 1;
    if (l & 1) {
        transpose_all(ap->in[11] + (size_t)e * 1024 * 3328, 1024, 3328, ap->in[2] + l * 1024, (bf16_t*)(ws + WS_ODWIN) + (size_t)e * 3328 * 1024, scr, gw, NGW, lane);
        transpose_all(ap->in[18] + (size_t)e * 1280 * 1024, 1280, 1024, nullptr, (bf16_t*)(ws + WS_ODWOUT) + (size_t)e * 1024 * 1280, scr, gw, NGW, lane);
    } else {
        transpose_all(ap->in[3] + (size_t)e * 1024 * 3072, 1024, 3072, ap->in[2] + l * 1024, (bf16_t*)(ws + WS_EVWIN) + (size_t)e * 3072 * 1024, scr, gw, NGW, lane);
        transpose_all(ap->in[10] + (size_t)e * 1024 * 1024, 1024, 1024, nullptr, (bf16_t*)(ws + WS_EVWOUT) + (size_t)e * 1024 * 1024, scr, gw, NGW, lane);
    }
    transpose_all(ap->in[21] + (size_t)l * 1024 * 1024, 1024, 1024, ap->in[19] + l * 1024, (bf16_t*)(ws + WS_WQ) + (size_t)l * 1024 * 1024, scr, gw, NGW, lane);
    transpose_all(ap->in[25] + (size_t)l * 1024 * 1024, 1024, 1024, nullptr, (bf16_t*)(ws + WS_WO) + (size_t)l * 1024 * 1024, scr, gw, NGW, lane);
    transpose_all(ap->in[27] + (size_t)l * 1024 * 4096, 1024, 4096, ap->in[26] + l * 1024, (bf16_t*)(ws + WS_W1) + (size_t)l * 4096 * 1024, scr, gw, NGW, lane);
    transpose_all(ap->in[28] + (size_t)l * 4096 * 1024, 4096, 1024, nullptr, (bf16_t*)(ws + WS_W2) + (size_t)l * 1024 * 4096, scr, gw, NGW, lane);
}

#define XB_TMO      128
#define XB_XCNT(j)  (256  + 64 * (j))
#define XB_XSUB(j)  (1280 + 64 * (j))
#define XB_XGEN(j)  (2304 + 64 * (j))
#define XB_TOP      3328
#define XB_TOPGEN   3392
#define XCD_BAR_WORDS 3456
#define XB_SPIN_CAP (1u << 22)
__device__ __forceinline__ unsigned xb_ld(unsigned* p)              { return __hip_atomic_load(p, __ATOMIC_RELAXED, __HIP_MEMORY_SCOPE_AGENT); }
__device__ __forceinline__ unsigned xb_add(unsigned* p, unsigned v) { return __hip_atomic_fetch_add(p, v, __ATOMIC_RELAXED, __HIP_MEMORY_SCOPE_AGENT); }
__device__ __forceinline__ unsigned xb_xcc_id() { return (unsigned)__builtin_amdgcn_s_getreg((3 << 11) | 20) & 0xFu; }
#define XB_SPIN(cond, bar) do { unsigned _sp = 0; while (cond) { __builtin_amdgcn_s_sleep(1); \
    if ((++_sp & 255u) == 0u) { if (xb_ld(&(bar)[XB_TMO])) break; if (_sp > XB_SPIN_CAP) { atomicAdd(&(bar)[XB_TMO], 1u); break; } } } } while (0)
__device__ __forceinline__ void xcd_barrier_complete(unsigned* bar, unsigned x, unsigned& nloc, unsigned& nx) {
    const unsigned G = gridDim.x * gridDim.y * gridDim.z;
    unsigned sum, cnt, mine, sp = 0u;
    for (;;) {
        sum = 0u; cnt = 0u; mine = 0u;
#pragma unroll
        for (unsigned j = 0; j < 16; ++j) { const unsigned c = xb_ld(&bar[XB_XCNT(j)]); sum += c; cnt += (c > 0u) ? 1u : 0u; mine = (j == x) ? c : mine; }
        if (sum == G) break;
        __builtin_amdgcn_s_sleep(1);
        if ((++sp & 255u) == 0u) { if (xb_ld(&bar[XB_TMO])) break; if (sp > XB_SPIN_CAP) { atomicAdd(&bar[XB_TMO], 1u); break; } }
    }
    nloc = mine > 0u ? mine : 1u; nx = cnt > 0u ? cnt : 1u;
}
__device__ __forceinline__ void xcd_barrier(unsigned* bar, unsigned x, volatile LAS unsigned* st) {
    asm volatile("s_waitcnt vmcnt(0)" ::: "memory");
    __syncthreads();
    if (threadIdx.x == 0) {
        __builtin_amdgcn_s_waitcnt(0);
        unsigned nloc = st[0], nx = st[1];
        if (nloc == 0u) { xcd_barrier_complete(bar, x, nloc, nx); st[0] = nloc; st[1] = nx; }
        const unsigned old = xb_add(&bar[XB_XSUB(x)], 1u);
        const unsigned gen = old / nloc;
        if (old + 1u == (gen + 1u) * nloc) {
            __builtin_amdgcn_fence(__ATOMIC_RELEASE, "agent");
            asm volatile("s_waitcnt vmcnt(0)" ::: "memory");
            const unsigned og = xb_add(&bar[XB_TOP], 1u);
            const unsigned tg = og / nx;
            if (og + 1u == (tg + 1u) * nx) xb_add(&bar[XB_TOPGEN], 1u);
            else XB_SPIN(xb_ld(&bar[XB_TOPGEN]) == tg, bar);
            __builtin_amdgcn_fence(__ATOMIC_ACQUIRE, "agent");
            xb_add(&bar[XB_XGEN(x)], 1u);
            asm volatile("s_waitcnt vmcnt(0)" ::: "memory");
        } else {
            XB_SPIN(xb_ld(&bar[XB_XGEN(x)]) == gen, bar);
            __builtin_amdgcn_fence(__ATOMIC_ACQUIRE, "agent");
            asm volatile("s_waitcnt vmcnt(0)" ::: "memory");
        }
    }
    __syncthreads();
}

__global__ void __launch_bounds__(512, 2) mk_fwd(Args args) {
    extern __shared__ __attribute__((aligned(16))) unsigned char lds_raw[];
    LAS unsigned char* lds = (LAS unsigned char*)lds_raw;
    volatile LAS unsigned* const xst = (volatile LAS unsigned*)((LAS unsigned char*)lds_raw + LDS_BYTES - 64);
    if (threadIdx.x < 2) xst[threadIdx.x] = 0u;
    const unsigned xcc = xb_xcc_id();
    if (args.hi - args.lo > 1 && threadIdx.x == 0) (void)xb_add((unsigned*)(args.ws + ST_BAR) + XB_XCNT(xcc), 1u);
    __syncthreads();
    const __attribute__((address_space(4))) Args* const ap0 = (const __attribute__((address_space(4))) Args*)__builtin_amdgcn_kernarg_segment_ptr();
#ifdef REP_MASK
    for (int ph2 = args.lo * 2; ph2 < args.hi * 2; ++ph2) { const int ph = ph2 >> 1;
    if ((ph2 & 1) && !(ph >= 3 && ((REP_MASK >> ((ph - 3) % 10)) & 1) && ((REP_ODD >> (((ph - 3) / 10) & 1)) & 1))) continue;
#else
    for (int ph = args.lo; ph < args.hi; ++ph) {
#endif
    const __attribute__((address_space(4))) Args* ap = ap0; asm volatile("" : "+s"(ap));
    int tid = threadIdx.x; asm volatile("" : "+v"(tid));
    const int lane = tid & 63, wave = __builtin_amdgcn_readfirstlane(tid >> 6);
    int G = gridDim.x, bx = blockIdx.x; asm volatile("" : "+s"(G), "+s"(bx));
    const int vcu = (G % 8 == 0) ? (bx % 8) * (G / 8) + bx / 8 : bx;
    unsigned char* ws = ap->ws;
    u64* const st_sxz = (u64*)(ws + ST_SXZ); u64* const st_sx0 = (u64*)(ws + ST_SX0);
    bf16_t* const xb = (bf16_t*)(ws + WS_XB);
    bf16_t* const pbuf = (bf16_t*)(ws + WS_P); bf16_t* const mix = (bf16_t*)(ws + WS_MIX);
    float* const rope = (float*)(ws + ST_ROPE); float* const lse = (float*)(ws + ST_LSE);
    {
#ifdef ONLY_S
        if (ph < 0) {
#else
        if (ph == 0) {
#endif
            const int gw = vcu * 8 + wave, NGW = G * 8;
            { u32x4* z = (u32x4*)ws; const size_t n16 = ST_ZERO_BYTES / 16; for (size_t i = (size_t)bx * 512 + tid; i < n16; i += (size_t)G * 512) z[i] = (u32x4){0u, 0u, 0u, 0u}; }
            for (int m = gw * 2; m < NTOK; m += NGW * 2) {
                const f32x4* x0 = (const f32x4*)(ap->in[0] + (size_t)m * DM) + lane; const f32x4* x1 = x0 + DM / 4;
                f32x4 v[8];
#pragma unroll
                for (int j = 0; j < 4; ++j) { v[j] = x0[64 * j]; v[4 + j] = x1[64 * j]; }
                float s0 = 0.f, s1 = 0.f;
#pragma unroll
                for (int j = 0; j < 4; ++j) { s0 += (v[j].x * v[j].x + v[j].y * v[j].y) + (v[j].z * v[j].z + v[j].w * v[j].w); s1 += (v[4 + j].x * v[4 + j].x + v[4 + j].y * v[4 + j].y) + (v[4 + j].z * v[4 + j].z + v[4 + j].w * v[4 + j].w); }
                s0 = wave_sum(s0); s1 = wave_sum(s1);
                u32x2* o0 = (u32x2*)(xb + (size_t)m * DM) + lane; u32x2* o1 = o0 + DM / 4;
#pragma unroll
                for (int j = 0; j < 4; ++j) { u32x2 w; w.x = pk_bf16(v[j].x, v[j].y); w.y = pk_bf16(v[j].z, v[j].w); o0[64 * j] = w; u32x2 w1; w1.x = pk_bf16(v[4 + j].x, v[4 + j].y); w1.y = pk_bf16(v[4 + j].z, v[4 + j].w); o1[64 * j] = w1; }
                if (lane == 0) { st_sx0[m] = (u64)(s0 * SC_SS + 0.5f); st_sx0[m + 1] = (u64)(s1 * SC_SS + 0.5f); }
            }
            { bf16_t* memb = (bf16_t*)(ws + WS_MEMB); u64* smem = (u64*)(ws + ST_SMEM);
              for (int m = gw; m < 4096; m += NGW) row_to_bf16(ap->in[1] + (size_t)m * DM, memb + (size_t)m * DM, smem + m, lane); }
            LAS float* scr = (LAS float*)(lds + wave * 16384);
            for (int l = 0; l < 4; ++l)
                transpose_all(ap->in[22] + (size_t)l * 1024 * 2048, 1024, 2048, ap->in[20] + l * 1024, (bf16_t*)(ws + WS_WKV) + (size_t)l * 2048 * 1024, scr, gw, NGW, lane);
            for (int l = 0; l < ((G >= 128) ? 1 : 4); ++l) transpose_layer(ap, ws, l, scr, gw, NGW, lane);
            for (int i = bx * 512 + tid; i < 4096 * 8; i += G * 512) {
                const int t = i >> 3, j = i & 7;
                const float invf[8] = {1.0f, 0.19392274474868576f, 0.03760603093086393f, 0.007292664737217109f, 0.001414213562373095f, 0.0002742481756762073f, 5.318295896944988e-05f, 1.031338537721246e-05f};
                float fj = invf[0];
#pragma unroll
                for (int q = 1; q < 8; ++q) fj = (j == q) ? invf[q] : fj;
                const float ang = (float)t * fj;
                const double a = (double)ang; const double k = __builtin_rint(a * 0.15915494309189535); const float r = (float)(a - k * 6.283185307179586);
                rope[t * 16 + j] = __cosf(r); rope[t * 16 + 8 + j] = __sinf(r);
            }
#ifdef ONLY_S
        } else if (ph < 0) {
#else
        } else if (ph == 1) {
#endif
            pg8::Gemm g{(const bf16_t*)(ws + WS_MEMB), (const bf16_t*)(ws + WS_WKV), 1024, 1024, 1024, 16, 8, 4, 1, 0, 0, 2048 * 1024, 0, 0};
            pg8::EpiP E{(bf16_t*)(ws + WS_KVRAW), 2048, 4096, (const u64*)(ws + ST_SMEM), 1.0f / (1024.0f * SC_SS), 0, (u64*)(ws + ST_KST), 8, 1, 0};
            pg8::gemm_phase<pg8::EpiP>(lds, tid, g, G, bx, E);
#ifdef ONLY_S
        } else if (ph < 0) {
#else
        } else if (ph == 2) {
#endif
            const int gw = vcu * 8 + wave, NGW = G * 8;
            const bf16_t* kvraw = (const bf16_t*)(ws + WS_KVRAW); bf16_t* kt = (bf16_t*)(ws + WS_KT); bf16_t* vt = (bf16_t*)(ws + WS_VT); const u64* kst = (const u64*)(ws + ST_KST);
            for (int r = gw; r < 4 * 4096; r += NGW) {
                const int l = r >> 12;
                const float* gk = ap->in[24] + l * 256; const float* gq = ap->in[23] + l * 256;
#pragma unroll
                for (int c2 = 0; c2 < 2; ++c2) {
                    const int ch = lane + 64 * c2, h = ch >> 5, e0 = (ch & 31) * 8;
                    const float rs = rsqrtf((float)kst[(size_t)r * 8 + h] * (1.0f / (256.0f * SC_SS)) + EPSF) * 0.0625f;
                    const u32x4 raw = *(const u32x4*)(kvraw + (size_t)r * 2048 + ch * 8); float f[8]; unpack8(raw, f);
#pragma unroll
                    for (int i = 0; i < 8; ++i) f[i] = f[i] * rs * gk[e0 + i] * gq[e0 + i];
                    *(u32x4*)(kt + (size_t)r * 1024 + ch * 8) = pack8(f);
                }
            }
            for (int idx0 = bx * 512 + tid; idx0 < 4 * 4096 * 128; idx0 += G * 512 * 4) {
                u32x4 cv[4];
#pragma unroll
                for (int q = 0; q < 4; ++q) { const int idx = idx0 + q * G * 512; cv[q] = (u32x4){0u, 0u, 0u, 0u}; if (idx < 4 * 4096 * 128) cv[q] = *(const u32x4*)(kvraw + (size_t)(idx >> 7) * 2048 + 1024 + (idx & 127) * 8); }
#pragma unroll
                for (int q = 0; q < 4; ++q) { const int idx = idx0 + q * G * 512; if (idx < 4 * 4096 * 128) *(u32x4*)(vt + (size_t)(idx >> 7) * 1024 + (idx & 127) * 8) = cv[q]; }
            }
        } else {
            #ifdef ONLY_S
            const int l = (ph - 3) / 10, s = ONLY_S, odd = ONLY_ODD, eo = l >> 1;
#else
            const int l = (ph - 3) / 10, s = (ph - 3) % 10, odd = l & 1, eo = l >> 1;
#endif
            u64* const sx_mix = (l == 0) ? st_sx0 : st_sxz + (size_t)(3 * l - 1) * NTOK;
            u64* const sx_xat = st_sxz + (size_t)(3 * l) * NTOK;
            u64* const sx_mlp = st_sxz + (size_t)(3 * l + 1) * NTOK;
            u64* const sx_next = st_sxz + (size_t)(3 * l + 2) * NTOK;
            u64* const qst = (u64*)(ws + ST_QST) + (size_t)l * NTOK * 4;
            u64* const lsum = (u64*)(ws + ST_LSUM) + (size_t)l * NTOK * 4;
            const int PW = odd ? 3328 : 3072, MW = odd ? 1280 : 1024;
            if (s == 6) continue;
            if (s == 0) {
                const bf16_t* wt = odd ? (const bf16_t*)(ws + WS_ODWIN) + (size_t)eo * 3328 * 1024 : (const bf16_t*)(ws + WS_EVWIN) + (size_t)eo * 3072 * 1024;
                pg8::Gemm g{xb, wt, 1024, 1024, 1024, 256, PW / 256, 1, 1, 0, 0, 0, 0, 0};
                pg8::EpiP E{pbuf, PW, NTOK, sx_mix, 1.0f / (1024.0f * SC_SS), odd ? 1 : 0, nullptr, 0, 1, 0};
                pg8::Gemm gv{(const bf16_t*)(ws + WS_WO) + (size_t)l * 1024 * 1024, (const bf16_t*)(ws + WS_VT) + (size_t)l * 4096 * 1024, 1024, 1024, 256, 4, 1, 64, 4, 0, 256, 256 * 1024, 256, 0};
                pg8::EpiP Ev{(bf16_t*)(ws + WS_VP), 1024, 1024, nullptr, 0.f, 0, nullptr, 0, 4, 256};
#pragma unroll 1
                for (int pass = 0; pass < 2; ++pass)
                    pg8::gemm_phase<pg8::EpiP>(lds, tid, pass ? gv : g, G, bx, pass ? Ev : E);
            } else if (s == 1 && !odd) {
#if !defined(NO_HGRN)
                {
                    const int fr = lane & 15, fq = lane >> 4, tr_r = (lane & 15) >> 2, tr_c = lane & 3;
                    const int kch = tid >> 2, tq = tid & 3;
                    constexpr int HB = 17920;
                    for (int item = vcu; item < 64; item += G) {
                        const int b = item >> 2, h = item & 3;
                        float lbv = 0.f; if (eo == 1) { const int c = h * 128 + kch; lbv = sigmoidf_(ap->in[8][512 + c] - ap->in[8][c]); }
                        f32x4 Sacc[8];
#pragma unroll
                        for (int kt = 0; kt < 8; ++kt) Sacc[kt] = (f32x4){0.f, 0.f, 0.f, 0.f};
                        const bf16_t* pq = pbuf + ((size_t)b * SEQ + 4 * tq) * 3072 + 1024 + h * 128 + kch;
                        const bf16_t* pi = pbuf + ((size_t)b * SEQ + (tid >> 5)) * 3072 + 2048 + h * 128 + (tid & 31) * 4;
                        unsigned rqr[4], rfr[4]; u32x2 rir;
#define HG_LOAD(blk_) do { const bf16_t* p_ = pq + (size_t)(blk_) * 16 * 3072; \
                            _Pragma("unroll") for (int j = 0; j < 4; ++j) { rqr[j] = p_[(size_t)j * 3072]; rfr[j] = p_[(size_t)j * 3072 + 512]; } \
                            rir = *(const u32x2*)(pi + (size_t)(blk_) * 16 * 3072); } while (0)
#define HG_ELEM(buf_) do { LAS bf16_t* QT_ = (LAS bf16_t*)(lds + (buf_) * HB); LAS bf16_t* KT_ = QT_ + 2176; LAS bf16_t* KB_ = QT_ + 4352; LAS bf16_t* IV_ = QT_ + 6528; LAS float* EL_ = (LAS float*)(lds + (buf_) * HB + 17408); \
                            float cj[4], fk[4], qv[4]; float c_ = 0.f; \
                            _Pragma("unroll") for (int j = 0; j < 4; ++j) { const float fp = __uint_as_float(rfr[j] << 16); const float f = lbv + (1.0f - lbv) * sigmoidf_(fp); c_ += __logf(f); cj[j] = c_; fk[j] = 1.0f - f; qv[j] = __uint_as_float(rqr[j] << 16); } \
                            const float T0 = dppf<0x00>(c_), T1 = dppf<0x55>(c_), T2 = dppf<0xAA>(c_), T3 = dppf<0xFF>(c_); \
                            const float P_ = (tq > 0 ? T0 : 0.f) + (tq > 1 ? T1 : 0.f) + (tq > 2 ? T2 : 0.f); \
                            const float ELv = __expf(fmaxf((T0 + T1) + (T2 + T3), -80.f)); \
                            _Pragma("unroll") for (int j = 0; j < 4; ++j) { const float Bv = fmaxf(P_ + cj[j], -80.f); const float E = __expf(Bv), Ei = __expf(-Bv); const float kt_ = fk[j] * Ei; const int t_ = 4 * tq + j; \
                                QT_[t_ * 136 + kch] = (bf16_t)(pk_bf16(qv[j] * E, 0.f) & 0xffffu); KT_[t_ * 136 + kch] = (bf16_t)(pk_bf16(kt_, 0.f) & 0xffffu); KB_[t_ * 136 + kch] = (bf16_t)(pk_bf16(kt_ * ELv, 0.f) & 0xffffu); } \
                            if (tq == 0) EL_[kch] = ELv; \
                            *(LAS u32x2*)(IV_ + (tid >> 5) * 136 + (tid & 31) * 4) = rir; } while (0)
                        HG_LOAD(0);
                        {
                            LAS float* fL = (LAS float*)(lds + 40960); LAS float* qL = fL + 2048; LAS float* iL = fL + 4096; LAS float* SD = (LAS float*)(lds + 65536);
#pragma unroll
                            for (int j = 0; j < 4; ++j) { const float fp = __uint_as_float(rfr[j] << 16); fL[(4 * tq + j) * 128 + kch] = lbv + (1.0f - lbv) * sigmoidf_(fp); qL[(4 * tq + j) * 128 + kch] = __uint_as_float(rqr[j] << 16); }
                            *(LAS f32x4*)(iL + (tid >> 5) * 128 + (tid & 31) * 4) = (f32x4){bf_lo(rir.x), bf_hi(rir.x), bf_lo(rir.y), bf_hi(rir.y)};
                            asm volatile("s_waitcnt lgkmcnt(0)" ::: "memory"); __builtin_amdgcn_s_barrier(); asm volatile("" ::: "memory");
                            const int kg = lane & 15, vq = wave * 4 + (lane >> 4);
                            float S0[8][4];
#pragma unroll
                            for (int j = 0; j < 8; ++j)
#pragma unroll
                                for (int c = 0; c < 4; ++c) S0[j][c] = 0.f;
#pragma unroll 2
                            for (int t = 0; t < 16; ++t) {
                                const f32x4 fa = *(const LAS f32x4*)(fL + t * 128 + kg * 8), fb = *(const LAS f32x4*)(fL + t * 128 + kg * 8 + 4);
                                const f32x4 qa = *(const LAS f32x4*)(qL + t * 128 + kg * 8), qb = *(const LAS f32x4*)(qL + t * 128 + kg * 8 + 4);
                                const f32x4 iv = *(const LAS f32x4*)(iL + t * 128 + vq * 4);
                                float a[4] = {0.f, 0.f, 0.f, 0.f};
#pragma unroll
                                for (int j = 0; j < 8; ++j) { const float fj = j < 4 ? fa[j] : fb[j - 4], qj = j < 4 ? qa[j] : qb[j - 4];
#pragma unroll
                                    for (int c = 0; c < 4; ++c) { const float d0 = S0[j][c] - iv[c]; S0[j][c] = __builtin_fmaf(fj, d0, iv[c]); a[c] = __builtin_fmaf(qj, S0[j][c], a[c]); } }
#pragma unroll
                                for (int c = 0; c < 4; ++c) a[c] = row16_sum(a[c]);
                                if (kg == 0) { u32x2 wv; wv.x = pk_bf16(a[0], a[1]); wv.y = pk_bf16(a[2], a[3]); *(u32x2*)(mix + ((size_t)b * SEQ + t) * 1024 + 512 + h * 128 + vq * 4) = wv; }
                            }
#pragma unroll
                            for (int j = 0; j < 8; ++j) *(LAS f32x4*)(SD + (kg * 8 + j) * 128 + vq * 4) = (f32x4){S0[j][0], S0[j][1], S0[j][2], S0[j][3]};
                            asm volatile("s_waitcnt lgkmcnt(0)" ::: "memory"); __builtin_amdgcn_s_barrier(); asm volatile("" ::: "memory");
#pragma unroll
                            for (int kt = 0; kt < 8; ++kt)
#pragma unroll
                                for (int i = 0; i < 4; ++i) Sacc[kt][i] = SD[(16 * kt + 4 * fq + i) * 128 + 16 * wave + fr];
                        }
                        HG_LOAD(1); HG_ELEM(1); HG_LOAD(2);
                        asm volatile("s_waitcnt lgkmcnt(0)" ::: "memory"); __builtin_amdgcn_s_barrier(); asm volatile("" ::: "memory");
                        for (int blk = 1; blk < 256; ++blk) {
                            const int cur = blk & 1;
                            if (wave < 4 && blk + 1 < 256) { HG_ELEM(cur ^ 1); if (blk + 2 < 256) HG_LOAD(blk + 2); }
                            const LAS bf16_t* QT = (const LAS bf16_t*)(lds + cur * HB); const LAS bf16_t* KT = QT + 2176; const LAS bf16_t* KB = QT + 4352; const LAS bf16_t* IV = QT + 6528; const LAS float* EL = (const LAS float*)(lds + cur * HB + 17408);
                            const v4i16_t itv = __builtin_amdgcn_ds_read_tr16_b64_v4i16((LAS v4i16_t*)(IV + (4 * fq + tr_r) * 136 + 16 * wave + 4 * tr_c));
                            bf16x8 AX[4], AY[4]; u32x2 QY0[4], QY1[4]; f32x4 ELv4[8]; v4i16_t KX[8];
#pragma unroll
                            for (int ks = 0; ks < 4; ++ks) { AX[ks] = *(const LAS bf16x8*)(KT + fr * 136 + ks * 32 + fq * 8); AY[ks] = *(const LAS bf16x8*)(QT + fr * 136 + ks * 32 + fq * 8); }
#pragma unroll
                            for (int p = 0; p < 4; ++p) { QY0[p] = *(const LAS u32x2*)(QT + fr * 136 + 32 * p + 4 * fq); QY1[p] = *(const LAS u32x2*)(QT + fr * 136 + 32 * p + 16 + 4 * fq); }
#pragma unroll
                            for (int kt = 0; kt < 8; ++kt) { ELv4[kt] = *(const LAS f32x4*)(EL + 16 * kt + 4 * fq); KX[kt] = __builtin_amdgcn_ds_read_tr16_b64_v4i16((LAS v4i16_t*)(KB + (4 * fq + tr_r) * 136 + kt * 16 + 4 * tr_c)); }
                            __builtin_amdgcn_sched_barrier(0);
                            const bf16x8 IT = (bf16x8){itv[0], itv[1], itv[2], itv[3], 0, 0, 0, 0};
                            f32x4 A = (f32x4){0.f, 0.f, 0.f, 0.f};
#pragma unroll
                            for (int ks = 0; ks < 4; ++ks) A = __builtin_amdgcn_mfma_f32_16x16x32_bf16(AX[ks], AY[ks], A, 0, 0, 0);
#pragma unroll
                            for (int i = 0; i < 4; ++i) A[i] = (4 * fq + i > fr) ? 0.f : A[i];
                            const u32x4 apk = (u32x4){pk_bf16(A[0], A[1]), pk_bf16(A[2], A[3]), 0u, 0u};
                            f32x4 o = __builtin_amdgcn_mfma_f32_16x16x32_bf16(IT, __builtin_bit_cast(bf16x8, apk), (f32x4){0.f, 0.f, 0.f, 0.f}, 0, 0, 0);
#pragma unroll
                            for (int p = 0; p < 4; ++p) {
                                const u32x4 sx = (u32x4){pk_bf16(Sacc[2 * p][0], Sacc[2 * p][1]), pk_bf16(Sacc[2 * p][2], Sacc[2 * p][3]), pk_bf16(Sacc[2 * p + 1][0], Sacc[2 * p + 1][1]), pk_bf16(Sacc[2 * p + 1][2], Sacc[2 * p + 1][3])};
                                const u32x4 yy = (u32x4){QY0[p].x, QY0[p].y, QY1[p].x, QY1[p].y};
                                o = __builtin_amdgcn_mfma_f32_16x16x32_bf16(__builtin_bit_cast(bf16x8, sx), __builtin_bit_cast(bf16x8, yy), o, 0, 0, 0);
                            }
                            { u32x2 wv; wv.x = pk_bf16(o[0], o[1]); wv.y = pk_bf16(o[2], o[3]);
                              *(u32x2*)(mix + ((size_t)b * SEQ + blk * 16 + fr) * 1024 + 512 + h * 128 + 16 * wave + 4 * fq) = wv; }
#pragma unroll
                            for (int kt = 0; kt < 8; ++kt) {
                                const bf16x8 X = (bf16x8){KX[kt][0], KX[kt][1], KX[kt][2], KX[kt][3], 0, 0, 0, 0};
                                Sacc[kt] = __builtin_amdgcn_mfma_f32_16x16x32_bf16(X, IT, Sacc[kt] * ELv4[kt], 0, 0, 0);
                            }
                            if (wave >= 4 && blk + 1 < 256) { HG_ELEM(cur ^ 1); if (blk + 2 < 256) HG_LOAD(blk + 2); }
                            asm volatile("s_waitcnt lgkmcnt(0)" ::: "memory"); __builtin_amdgcn_s_barrier(); asm volatile("" ::: "memory");
                        }
#undef HG_LOAD
#undef HG_ELEM
                    }
                }
#endif
#if !defined(NO_CONV)
                {
                    LAS unsigned* hL32 = (LAS unsigned*)lds; LAS float* yL = (LAS float*)(lds + 65536);
                    const float* cw = ap->in[4] + (size_t)eo * 31 * 512; const float* cb = ap->in[5] + eo * 512;
                    const float* lng = ap->in[6] + eo * 512; const float* lnb = ap->in[7] + eo * 512;
                    const int cp = tid & 255, th = tid >> 8;
                    const bool split_ = (G >= 128);
                    for (int item = split_ ? vcu - 64 : vcu; item < 2048; item += split_ ? G - 64 : G) {
                        if (item < 0) break;
                        const int ritem = 2047 - item;
                        const int b = ritem >> 7, t0 = (ritem & 127) * 32;
                        {
                            u32x4 av[8], gv[8];
#pragma unroll
                            for (int q = 0; q < 8; ++q) {
                                const int idx = tid + 512 * q, r = idx >> 6, c8 = idx & 63, t = t0 - 30 + r;
                                av[q] = (u32x4){0u, 0u, 0u, 0u}; gv[q] = av[q];
                                if (idx < 62 * 64 && t >= 0) { const bf16_t* pr = pbuf + ((size_t)b * SEQ + t) * 3072 + c8 * 8; av[q] = *(const u32x4*)pr; gv[q] = *(const u32x4*)(pr + 512); }
                            }
#pragma unroll
                            for (int q = 0; q < 8; ++q) {
                                const int idx = tid + 512 * q, r = idx >> 6, c8 = idx & 63;
                                float a[8], g8[8]; unpack8(av[q], a); unpack8(gv[q], g8);
#pragma unroll
                                for (int i = 0; i < 8; ++i) a[i] *= sigmoidf_(g8[i]);
                                if (idx < 62 * 64) *(LAS u32x4*)(hL32 + r * 256 + c8 * 4) = pack8(a);
                            }
                        }
                        __syncthreads();
#pragma unroll 1
                        for (int sb = 0; sb < 2; ++sb) {
                            float y0[8], y1[8];
                            const float b0 = cb[2 * cp], b1 = cb[2 * cp + 1];
#pragma unroll
                            for (int t = 0; t < 8; ++t) { y0[t] = b0; y1[t] = b1; }
                            unsigned in[38];
#pragma unroll
                            for (int r = 0; r < 38; ++r) in[r] = hL32[(th * 16 + sb * 8 + r) * 256 + cp];
#pragma unroll
                            for (int j = 0; j < 31; ++j) {
                                const f32x2 wj = *(const f32x2*)(cw + j * 512 + 2 * cp);
#pragma unroll
                                for (int t = 0; t < 8; ++t) { y0[t] = __builtin_fmaf(wj.x, bf_lo(in[t + j]), y0[t]); y1[t] = __builtin_fmaf(wj.y, bf_hi(in[t + j]), y1[t]); }
                            }
#pragma unroll
                            for (int t = 0; t < 8; ++t) *(LAS f32x2*)(yL + (th * 16 + sb * 8 + t) * 512 + 2 * cp) = (f32x2){y0[t], y1[t]};
                        }
                        __syncthreads();
                        u32x4 lnres[4];
#pragma unroll
                        for (int q = 0; q < 4; ++q) {
                            const int tok = wave * 4 + q;
                            const f32x4 v0 = *(const LAS f32x4*)(yL + tok * 512 + lane * 8), v1 = *(const LAS f32x4*)(yL + tok * 512 + lane * 8 + 4);
                            float sm = (v0[0] + v0[1]) + (v0[2] + v0[3]) + (v1[0] + v1[1]) + (v1[2] + v1[3]);
                            sm = wave_sum(sm); const float mu = sm * (1.0f / 512.0f);
                            float f[8] = {v0[0] - mu, v0[1] - mu, v0[2] - mu, v0[3] - mu, v1[0] - mu, v1[1] - mu, v1[2] - mu, v1[3] - mu};
                            float sq = 0.f;
#pragma unroll
                            for (int i = 0; i < 8; ++i) sq += f[i] * f[i];
                            sq = wave_sum(sq); const float rstd = rsqrtf(sq * (1.0f / 512.0f) + EPSF);
#pragma unroll
                            for (int i = 0; i < 8; ++i) { const float yv = f[i] * rstd * lng[lane * 8 + i] + lnb[lane * 8 + i]; f[i] = yv * sigmoidf_(yv); }
                            lnres[q] = pack8(f);
                        }
#pragma unroll
                        for (int q = 0; q < 4; ++q) *(u32x4*)(mix + ((size_t)b * SEQ + t0 + wave * 4 + q) * 1024 + lane * 8) = lnres[q];
                        __syncthreads();
                    }
                    if (split_ && vcu >= 64) {
                        LAS float* scr = (LAS float*)(lds + wave * 16384);
                        const int gw2 = (vcu - 64) * 8 + wave, NGW2 = (G - 64) * 8;
                        if (l == 0) { transpose_layer(ap, ws, 1, scr, gw2, NGW2, lane); transpose_layer(ap, ws, 2, scr, gw2, NGW2, lane); }
                        else transpose_layer(ap, ws, 3, scr, gw2, NGW2, lane);
                    }
                }
#endif
            } else if (s == 2 && !odd) {
                const int gw = vcu * 8 + wave, NGW = G * 8;
                const float* og = ap->in[9] + eo * 128;
                float ogr[8];
#pragma unroll
                for (int i = 0; i < 8; ++i) ogr[i] = og[(lane & 15) * 8 + i];
                for (int m0 = gw * 4; m0 < NTOK; m0 += NGW * 4) {
                    u32x4 ov[4], gv[4];
#pragma unroll
                    for (int q = 0; q < 4; ++q) { ov[q] = *(const u32x4*)(mix + (size_t)(m0 + q) * 1024 + 512 + lane * 8); gv[q] = *(const u32x4*)(pbuf + (size_t)(m0 + q) * 3072 + 2560 + lane * 8); }
#pragma unroll
                    for (int q = 0; q < 4; ++q) {
                        float o[8], g8[8]; unpack8(ov[q], o); unpack8(gv[q], g8);
                        float ss = 0.f;
#pragma unroll
                        for (int i = 0; i < 8; ++i) ss += o[i] * o[i];
                        ss = row16_sum(ss);
                        const float rs = rsqrtf(ss * (1.0f / 128.0f) + EPSF);
                        const int c0 = (lane & 15) * 8;
#pragma unroll
                        for (int i = 0; i < 8; ++i) o[i] = o[i] * rs * ogr[i] * (g8[i] * sigmoidf_(g8[i]));
                        *(u32x4*)(mix + (size_t)(m0 + q) * 1024 + 512 + lane * 8) = pack8(o);
                    }
                }
            } else if (s == 1 && odd) {
#if !defined(NO_SGU)
                {
                    LAS bf16_t* VN = (LAS bf16_t*)lds;
                    const float* lng = ap->in[12] + eo * 512; const float* lnb = ap->in[13] + eo * 512;
                    const int wr = wave >> 2, wc = wave & 3, fr = lane & 15, fq = lane >> 4, tr_r = (lane & 15) >> 2, tr_c = lane & 3;
                    for (int item = vcu; item < 512; item += G) {
                        const int ritem = 511 - item;
                        const int b = ritem >> 5, n = ritem & 31;
                        const size_t row0 = (size_t)b * SEQ + n * 128;
                        const int sT = tid >> 2, qd = tid & 3;
                        {
                            const bf16_t* pr = pbuf + (row0 + sT) * 3328 + 512 + qd * 128;
                            float sm = 0.f, sq = 0.f;
#pragma unroll 4
                            for (int i = 0; i < 16; ++i) { const u32x4 rawv = *(const u32x4*)(pr + i * 8); float f[8]; unpack8(rawv, f);
#pragma unroll
                                for (int j = 0; j < 8; ++j) { sm += f[j]; sq += f[j] * f[j]; } }
                            sm += __shfl_xor(sm, 1); sm += __shfl_xor(sm, 2); sq += __shfl_xor(sq, 1); sq += __shfl_xor(sq, 2);
                            const float mu = sm * (1.0f / 512.0f); const float var = fmaxf(sq * (1.0f / 512.0f) - mu * mu, 0.f); const float rstd = rsqrtf(var + EPSF);
#pragma unroll 2
                            for (int i = 0; i < 16; ++i) { const u32x4 rawv = *(const u32x4*)(pr + i * 8); float f[8]; unpack8(rawv, f);
                                const f32x4 g0 = *(const f32x4*)(lng + qd * 128 + i * 8), g1 = *(const f32x4*)(lng + qd * 128 + i * 8 + 4);
                                const f32x4 b0 = *(const f32x4*)(lnb + qd * 128 + i * 8), b1 = *(const f32x4*)(lnb + qd * 128 + i * 8 + 4);
#pragma unroll
                                for (int j = 0; j < 4; ++j) { f[j] = (f[j] - mu) * rstd * g0[j] + b0[j]; f[4 + j] = (f[4 + j] - mu) * rstd * g1[j] + b1[j]; }
                                *(LAS u32x4*)(VN + sT * 520 + qd * 128 + i * 8) = pack8(f); }
                        }
                        asm volatile("s_waitcnt lgkmcnt(0)" ::: "memory"); __builtin_amdgcn_s_barrier(); asm volatile("" ::: "memory");
#pragma unroll 1
                        for (int gI = 0; gI < 4; ++gI) {
                            const float* wg = ap->in[14] + ((size_t)eo * 4 + gI) * 128 * 128; const float* bsg = ap->in[15] + (eo * 4 + gI) * 128;
                            f32x4 acc[4][2];
#pragma unroll
                            for (int m = 0; m < 4; ++m) { acc[m][0] = (f32x4){0.f, 0.f, 0.f, 0.f}; acc[m][1] = (f32x4){0.f, 0.f, 0.f, 0.f}; }
#pragma unroll
                            for (int k0 = 0; k0 < 128; k0 += 32) {
                                if (k0 <= wr * 64 + 63) {
                                    f32x4 wv[4][2];
#pragma unroll
                                    for (int m = 0; m < 4; ++m) { wv[m][0] = (f32x4){0.f, 0.f, 0.f, 0.f}; wv[m][1] = wv[m][0];
                                        if (k0 <= wr * 64 + m * 16 + 15) { const int t = wr * 64 + m * 16 + fr, s0 = k0 + fq * 8; wv[m][0] = *(const f32x4*)(wg + t * 128 + s0); wv[m][1] = *(const f32x4*)(wg + t * 128 + s0 + 4); } }
                                    asm volatile("" ::: "memory");
                                    bf16x8 X[2];
#pragma unroll
                                    for (int nn = 0; nn < 2; ++nn) {
                                        const LAS bf16_t* vp = VN + (k0 + fq * 8 + tr_r) * 520 + gI * 128 + wc * 32 + nn * 16 + 4 * tr_c;
                                        const v4i16_t lo = __builtin_amdgcn_ds_read_tr16_b64_v4i16((LAS v4i16_t*)vp), hi = __builtin_amdgcn_ds_read_tr16_b64_v4i16((LAS v4i16_t*)(vp + 4 * 520));
                                        X[nn] = (bf16x8){lo[0], lo[1], lo[2], lo[3], hi[0], hi[1], hi[2], hi[3]};
                                    }
#pragma unroll
                                    for (int m = 0; m < 4; ++m) {
                                        if (k0 <= wr * 64 + m * 16 + 15) {
                                            const int t = wr * 64 + m * 16 + fr, s0 = k0 + fq * 8;
                                            const f32x4 w0 = wv[m][0], w1 = wv[m][1];
                                            float wf[8] = {w0[0], w0[1], w0[2], w0[3], w1[0], w1[1], w1[2], w1[3]};
#pragma unroll
                                            for (int i = 0; i < 8; ++i) wf[i] = (s0 + i <= t) ? wf[i] : 0.f;
                                            const u32x4 yp = pack8(wf); const bf16x8 Y = __builtin_bit_cast(bf16x8, yp);
                                            acc[m][0] = __builtin_amdgcn_mfma_f32_16x16x32_bf16(X[0], Y, acc[m][0], 0, 0, 0);
                                            acc[m][1] = __builtin_amdgcn_mfma_f32_16x16x32_bf16(X[1], Y, acc[m][1], 0, 0, 0);
                                        }
                                    }
                                }
                            }
                            u32x2 uva[4][2]; float bia[4];
#pragma unroll
                            for (int m = 0; m < 4; ++m) { const int t = wr * 64 + m * 16 + fr; bia[m] = bsg[t];
#pragma unroll
                                for (int nn = 0; nn < 2; ++nn) uva[m][nn] = *(const u32x2*)(pbuf + (row0 + t) * 3328 + gI * 128 + wc * 32 + nn * 16 + 4 * fq); }
                            asm volatile("" ::: "memory");
#pragma unroll
                            for (int m = 0; m < 4; ++m) {
                                const int t = wr * 64 + m * 16 + fr; const float bias = bia[m];
#pragma unroll
                                for (int nn = 0; nn < 2; ++nn) {
                                    const int c0 = wc * 32 + nn * 16 + 4 * fq;
                                    const u32x2 uv = uva[m][nn];
                                    const float o0 = bf_lo(uv.x) * (acc[m][nn][0] + bias), o1 = bf_hi(uv.x) * (acc[m][nn][1] + bias), o2 = bf_lo(uv.y) * (acc[m][nn][2] + bias), o3 = bf_hi(uv.y) * (acc[m][nn][3] + bias);
                                    u32x2 w; w.x = pk_bf16(o0, o1); w.y = pk_bf16(o2, o3);
                                    *(u32x2*)(mix + (row0 + t) * 1280 + gI * 128 + c0) = w;
                                }
                            }
                        }
                        asm volatile("s_waitcnt lgkmcnt(0)" ::: "memory"); __builtin_amdgcn_s_barrier(); asm volatile("" ::: "memory");
                    }
                }
#endif
#if !defined(NO_ATTN)
                {
                    LAS bf16_t* QL = (LAS bf16_t*)lds; LAS bf16_t* KL = (LAS bf16_t*)(lds + 18432); LAS bf16_t* VL = (LAS bf16_t*)(lds + 55296);
                    const int fr = lane & 15, fq = lane >> 4, tr_r = (lane & 15) >> 2, tr_c = lane & 3;
                    float gq16[16], gk16[16];
#pragma unroll
                    for (int i = 0; i < 16; ++i) { gq16[i] = ap->in[16][eo * 64 + (tid & 3) * 16 + i] * 0.125f; gk16[i] = ap->in[17][eo * 64 + (tid & 3) * 16 + i]; }
                    u32x4 rq[3][2], rv[4];
#pragma unroll
                    for (int i_ = 0; i_ < 3; ++i_) { rq[i_][0] = (u32x4){0u, 0u, 0u, 0u}; rq[i_][1] = (u32x4){0u, 0u, 0u, 0u}; }
#pragma unroll
                    for (int i_ = 0; i_ < 4; ++i_) rv[i_] = (u32x4){0u, 0u, 0u, 0u};
#define ATT_DECODE(it) const int rit_ = 6143 - (it); const int bj_ = rit_ / 96, q96_ = rit_ % 96, b = bj_ >> 2, j = bj_ & 3, cfg = q96_ >> 5, qq_ = q96_ & 31; \
                        const int sh = cfg * 2, r = (cfg == 0) ? 0 : (cfg == 1 ? (qq_ >> 3) : (qq_ >> 1)), n = (cfg == 0) ? qq_ : (cfg == 1 ? (qq_ & 7) : (qq_ & 1)); \
                        const int hd = cfg * 4 + j; const size_t rowb = (size_t)b * SEQ; (void)hd; (void)rowb; (void)n; (void)r; (void)sh;
#define ATT_LOAD(it) do { ATT_DECODE(it) \
                        _Pragma("unroll") for (int r3 = 0; r3 < 3; ++r3) { const int idx = tid + 512 * r3, rowi = idx >> 2, part = idx & 3; const bool isq = rowi < 128; \
                            const int sub = isq ? (n * 128 + rowi) : ((n - 1) * 128 + (rowi - 128)); const bool valid = sub >= 0; const int tok = valid ? ((sub << sh) + r) : 0; \
                            const bf16_t* src = pbuf + (rowb + tok) * 3328 + (isq ? 1024 : 1792) + hd * 64 + part * 16; \
                            rq[r3][0] = (u32x4){0u, 0u, 0u, 0u}; rq[r3][1] = rq[r3][0]; if (valid) { rq[r3][0] = *(const u32x4*)src; rq[r3][1] = *(const u32x4*)(src + 8); } } \
                        _Pragma("unroll") for (int r4 = 0; r4 < 4; ++r4) { const int idx = tid + 512 * r4, ks = idx >> 3, c8 = idx & 7; const int sub = (n - 1) * 128 + ks; \
                            rv[r4] = (u32x4){0u, 0u, 0u, 0u}; if (sub >= 0) rv[r4] = *(const u32x4*)(pbuf + (rowb + ((sub << sh) + r)) * 3328 + 2560 + hd * 64 + c8 * 8); } } while (0)
                    if (vcu < 6144) ATT_LOAD(vcu);
                    for (int item = vcu; item < 6144; item += G) {
                        ATT_DECODE(item)
#pragma unroll
                        for (int r3 = 0; r3 < 3; ++r3) {
                            const int idx = tid + 512 * r3, rowi = idx >> 2, part = idx & 3;
                            const bool isq = rowi < 128;
                            const int sub = isq ? (n * 128 + rowi) : ((n - 1) * 128 + (rowi - 128));
                            const int tok = (sub >= 0) ? ((sub << sh) + r) : 0;
                            float f[16]; unpack8(rq[r3][0], f); unpack8(rq[r3][1], f + 8);
                            float ss = 0.f;
#pragma unroll
                            for (int i = 0; i < 16; ++i) ss += f[i] * f[i];
                            ss += __shfl_xor(ss, 1); ss += __shfl_xor(ss, 2);
                            const float rs = rsqrtf(ss * (1.0f / 64.0f) + EPSF);
#pragma unroll
                            for (int i = 0; i < 16; ++i) f[i] = f[i] * rs * (r3 == 0 ? gq16[i] : gk16[i]);
                            if (part == 0) {
                                const float tf = (float)tok;
                                const float crev[8] = {0.15915494309189535f, 0.03086376340470123f, 0.005985185712713705f, 0.001160663641240061f, 0.00022507907903927653f, 4.364795279280289e-05f, 8.464330808241401e-06f, 1.6414262627950345e-06f};
#pragma unroll
                                for (int i = 0; i < 8; ++i) { const float rev = __builtin_amdgcn_fractf(tf * crev[i]); const float c = __builtin_amdgcn_cosf(rev), sn = __builtin_amdgcn_sinf(rev), x1 = f[i], x2 = f[8 + i]; f[i] = x1 * c - x2 * sn; f[8 + i] = x2 * c + x1 * sn; }
                            }
                            LAS bf16_t* dst = isq ? (QL + rowi * 72 + part * 16) : (KL + (rowi - 128) * 72 + part * 16);
                            *(LAS u32x4*)dst = pack8(f); *(LAS u32x4*)(dst + 8) = pack8(f + 8);
                        }
#pragma unroll
                        for (int r4 = 0; r4 < 4; ++r4) { const int idx = tid + 512 * r4, ks = idx >> 3, c8 = idx & 7; *(LAS u32x4*)(VL + ks * 72 + c8 * 8) = rv[r4]; }
                        if (item + G < 6144) ATT_LOAD(item + G);
                        asm volatile("s_waitcnt lgkmcnt(0)" ::: "memory"); __builtin_amdgcn_s_barrier(); asm volatile("" ::: "memory");
                        {
                            const int w = wave, qi = w * 16 + fr;
                            const bf16x8 Y0 = *(const LAS bf16x8*)(QL + qi * 72 + fq * 8), Y1 = *(const LAS bf16x8*)(QL + qi * 72 + 32 + fq * 8);
                            f32x4 sc[10];
                            {
                                bf16x8 KX0[9], KX1[9];
#pragma unroll
                                for (int jt = 0; jt < 9; ++jt) { const LAS bf16_t* kp = KL + ((w + jt) * 16 + fr) * 72 + fq * 8; KX0[jt] = *(const LAS bf16x8*)kp; KX1[jt] = *(const LAS bf16x8*)(kp + 32); }
                                __builtin_amdgcn_sched_barrier(0);
#pragma unroll
                                for (int jt = 0; jt < 9; ++jt) {
                                    f32x4 a = (f32x4){0.f, 0.f, 0.f, 0.f};
                                    a = __builtin_amdgcn_mfma_f32_16x16x32_bf16(KX0[jt], Y0, a, 0, 0, 0);
                                    a = __builtin_amdgcn_mfma_f32_16x16x32_bf16(KX1[jt], Y1, a, 0, 0, 0);
                                    sc[jt] = a;
                                }
                            }
                            float mx = -INFINITY;
#pragma unroll
                            for (int jt = 0; jt < 9; ++jt)
#pragma unroll
                                for (int i = 0; i < 4; ++i) {
                                    const int c = 4 * fq + i;
                                    bool ok = (n > 0) || (w + jt >= 8);
                                    if (jt == 0) ok = ok && (fr <= c);
                                    if (jt == 8) ok = ok && (fr >= c);
                                    const float v = ok ? sc[jt][i] : -INFINITY; sc[jt][i] = v; mx = fmaxf(mx, v);
                                }
                            mx = fmaxf(mx, __shfl_xor(mx, 16)); mx = fmaxf(mx, __shfl_xor(mx, 32));
                            float den = 0.f;
#pragma unroll
                            for (int jt = 0; jt < 9; ++jt)
#pragma unroll
                                for (int i = 0; i < 4; ++i) { const float e = __expf(sc[jt][i] - mx); sc[jt][i] = e; den += e; }
                            sc[9] = (f32x4){0.f, 0.f, 0.f, 0.f};
                            den += __shfl_xor(den, 16); den += __shfl_xor(den, 32);
                            f32x4 oa[4];
#pragma unroll
                            for (int et = 0; et < 4; ++et) oa[et] = (f32x4){0.f, 0.f, 0.f, 0.f};
                            v4i16_t VLO[5][4], VHI[5][4];
#pragma unroll
                            for (int jj = 0; jj < 5; ++jj) {
                                const int t0r = (w + 2 * jj) * 16, t1r = (jj < 4) ? (w + 2 * jj + 1) * 16 : t0r;
#pragma unroll
                                for (int et = 0; et < 4; ++et) {
                                    VLO[jj][et] = __builtin_amdgcn_ds_read_tr16_b64_v4i16((LAS v4i16_t*)(VL + (t0r + 4 * fq + tr_r) * 72 + et * 16 + 4 * tr_c));
                                    VHI[jj][et] = __builtin_amdgcn_ds_read_tr16_b64_v4i16((LAS v4i16_t*)(VL + (t1r + 4 * fq + tr_r) * 72 + et * 16 + 4 * tr_c));
                                }
                            }
                            __builtin_amdgcn_sched_barrier(0);
#pragma unroll
                            for (int jj = 0; jj < 5; ++jj) {
                                u32x4 pp; pp.x = pk_bf16(sc[2 * jj][0], sc[2 * jj][1]); pp.y = pk_bf16(sc[2 * jj][2], sc[2 * jj][3]); pp.z = pk_bf16(sc[2 * jj + 1][0], sc[2 * jj + 1][1]); pp.w = pk_bf16(sc[2 * jj + 1][2], sc[2 * jj + 1][3]);
                                const bf16x8 Pf = __builtin_bit_cast(bf16x8, pp);
#pragma unroll
                                for (int et = 0; et < 4; ++et) {
                                    const v4i16_t lo = VLO[jj][et], hi = VHI[jj][et];
                                    const bf16x8 xv = (bf16x8){lo[0], lo[1], lo[2], lo[3], hi[0], hi[1], hi[2], hi[3]};
                                    oa[et] = __builtin_amdgcn_mfma_f32_16x16x32_bf16(xv, Pf, oa[et], 0, 0, 0);
                                }
                            }
                            const float inv = 1.0f / den;
                            const int tokq = ((n * 128 + qi) << sh) + r;
                            bf16_t* op = mix + (rowb + tokq) * 1280 + 512 + hd * 64 + 4 * fq;
#pragma unroll
                            for (int et = 0; et < 4; ++et) { u32x2 wv; wv.x = pk_bf16(oa[et][0] * inv, oa[et][1] * inv); wv.y = pk_bf16(oa[et][2] * inv, oa[et][3] * inv); *(u32x2*)(op + et * 16) = wv; }
                            if (fq == 0) lse[(rowb + tokq) * 12 + hd] = mx + __logf(den);
                        }
                        asm volatile("s_waitcnt lgkmcnt(0)" ::: "memory"); __builtin_amdgcn_s_barrier(); asm volatile("" ::: "memory");
                    }
#undef ATT_LOAD
#undef ATT_DECODE
                }
#endif
            } else if (s == 2 && odd) {
                const int gw = vcu * 8 + wave, NGW = G * 8;
                for (int m0 = gw * 2; m0 < NTOK; m0 += NGW * 2) {
                    u32x4 v[2][2]; float al[2][2];
#pragma unroll
                    for (int q = 0; q < 2; ++q)
#pragma unroll
                        for (int c2 = 0; c2 < 2; ++c2) {
                            const int ch = lane + 64 * c2; v[q][c2] = (u32x4){0u, 0u, 0u, 0u}; al[q][c2] = 0.f;
                            if (ch < 96) {
                                const size_t m = (size_t)(m0 + q);
                                const int hd = ch >> 3, cfg = hd >> 2, j = hd & 3;
                                const float l0 = lse[m * 12 + j], l1 = lse[m * 12 + 4 + j], l2 = lse[m * 12 + 8 + j];
                                v[q][c2] = *(const u32x4*)(mix + m * 1280 + 512 + ch * 8);
                                const float mxl = fmaxf(l0, fmaxf(l1, l2));
                                const float e0 = __expf(l0 - mxl), e1 = __expf(l1 - mxl), e2 = __expf(l2 - mxl);
                                al[q][c2] = ((cfg == 0) ? e0 : (cfg == 1 ? e1 : e2)) / (e0 + e1 + e2);
                            }
                        }
#pragma unroll
                    for (int q = 0; q < 2; ++q)
#pragma unroll
                        for (int c2 = 0; c2 < 2; ++c2) {
                            const int ch = lane + 64 * c2;
                            if (ch < 96) { float f[8]; unpack8(v[q][c2], f);
#pragma unroll
                                for (int i = 0; i < 8; ++i) f[i] *= al[q][c2];
                                *(u32x4*)(mix + (size_t)(m0 + q) * 1280 + 512 + ch * 8) = pack8(f); }
                        }
                }
            } else if (s == 3) {
                const bf16_t* wt = odd ? (const bf16_t*)(ws + WS_ODWOUT) + (size_t)eo * 1024 * 1280 : (const bf16_t*)(ws + WS_EVWOUT) + (size_t)eo * 1024 * 1024;
                pg8::Gemm g{mix, wt, MW, MW, MW, 256, 4, 1, 1, 0, 0, 0, 0, 0};
                pg8::EpiR E{nullptr, xb, sx_xat, 0};
                pg8::gemm_phase<pg8::EpiR>(lds, tid, g, G, bx, E);
            } else if (s == 4) {
                pg8::Gemm g{xb, (const bf16_t*)(ws + WS_WQ) + (size_t)l * 1024 * 1024, 1024, 1024, 1024, 256, 4, 1, 1, 0, 0, 0, 0, 0};
                pg8::EpiP E{(bf16_t*)(ws + WS_QX), 1024, NTOK, sx_xat, 1.0f / (1024.0f * SC_SS), 0, qst, 4, 1, 0};
                pg8::gemm_phase<pg8::EpiP>(lds, tid, g, G, bx, E);
            } else if (s == 5) {
                pg8::Gemm g{(const bf16_t*)(ws + WS_QX), (const bf16_t*)(ws + WS_KT) + (size_t)l * 4096 * 1024, 1024, 1024, 256, 16, 1, 64, 4, SEQ * 1024, 256, 256 * 1024, 256, 0};
                pg8::EpiS E{(bf16_t*)(ws + WS_PB), qst, (LAS float*)(lds + 131072)};
                pg8::gemm_phase<pg8::EpiS>(lds, tid, g, G, bx, E);
            } else if (s == 7) {
                pg8::Gemm g{(const bf16_t*)(ws + WS_PB), (const bf16_t*)(ws + WS_VP), 1024, 1024, 1024, 16, 4, 16, 1, SEQ * 1024, 0, 1024 * 1024, 0, 0};
                pg8::EpiR E{nullptr, xb, sx_mlp, SEQ};
                pg8::gemm_phase<pg8::EpiR>(lds, tid, g, G, bx, E);
            } else if (s == 8) {
                pg8::Gemm g{xb, (const bf16_t*)(ws + WS_W1) + (size_t)l * 4096 * 1024, 1024, 1024, 1024, 256, 16, 1, 1, 0, 0, 0, 0, 0};
                pg8::EpiP E{(bf16_t*)(ws + WS_HMID), 4096, NTOK, sx_mlp, 1.0f / (1024.0f * SC_SS), 2, nullptr, 0, 1, 0};
                pg8::gemm_phase<pg8::EpiP>(lds, tid, g, G, bx, E);
            } else {
                pg8::Gemm g{(const bf16_t*)(ws + WS_HMID), (const bf16_t*)(ws + WS_W2) + (size_t)l * 1024 * 4096, 4096, 4096, 4096, 256, 4, 1, 1, 0, 0, 0, 0, 1};
                pg8::EpiR E{(l == 3) ? ap->out : nullptr, xb, (l == 3) ? (u64*)(ws + ST_QST) : sx_next, 0};
                pg8::gemm_phase<pg8::EpiR>(lds, tid, g, G, bx, E);
            }
        }
        }
        if (ph + 1 < args.hi) { if (ph == 0) cg::this_grid().sync(); else xcd_barrier((unsigned*)(ws + ST_BAR), xcc, xst); }
    }
}

constexpr int N_PHASES = 43;
extern "C" void kernel_launch(void* const* d_in, const int* in_sizes, int n_in, void* d_out, int out_size, void* d_ws, size_t ws_size, hipStream_t stream) {
    static int grid = 0;
    if (grid == 0) {
        if (n_in != 29 || ws_size < WS_END) { fprintf(stderr, "kernel_launch: need 29 inputs and %zu bytes of workspace; got %d, %zu\n", (size_t)WS_END, n_in, ws_size); grid = -1; return; }
        int dev = 0, cus = 0, per_cu = 0;
        hipGetDevice(&dev); hipDeviceGetAttribute(&cus, hipDeviceAttributeMultiprocessorCount, dev);
        if (hipFuncSetAttribute((const void*)mk_fwd, hipFuncAttributeMaxDynamicSharedMemorySize, LDS_BYTES) != hipSuccess) { fprintf(stderr, "kernel_launch: hipFuncSetAttribute failed\n"); grid = -1; return; }
        if (hipOccupancyMaxActiveBlocksPerMultiprocessor(&per_cu, (const void*)mk_fwd, 512, LDS_BYTES) != hipSuccess || per_cu < 1) per_cu = 1;
        (void)hipGetLastError();
        grid = cus * per_cu;
        fprintf(stderr, "kernel_launch: grid %d (cus %d x %d)\n", grid, cus, per_cu);
    }
    if (grid < 0) return;
    Args a{};
    for (int i = 0; i < 29; ++i) a.in[i] = (const float*)d_in[i];
    a.out = (float*)d_out; a.ws = (unsigned char*)d_ws;
#if MK_MULTI
    for (int ph = 0; ph < N_PHASES; ++ph) { a.lo = ph; a.hi = ph + 1; hipLaunchKernelGGL(mk_fwd, dim3(grid), dim3(512), LDS_BYTES, stream, a); }
#else
    a.lo = 0; a.hi = N_PHASES;
    if (hipMemsetAsync((char*)d_ws + ST_BAR, 0, 16384, stream) != hipSuccess) { fprintf(stderr, "kernel_launch: memset failed\n"); return; }
    void* kargs[] = {&a};
    hipError_t e = hipLaunchCooperativeKernel((const void*)mk_fwd, dim3(grid), dim3(512), kargs, LDS_BYTES, stream);
    if (e != hipSuccess) fprintf(stderr, "cooperative launch failed: %s (grid %d)\n", hipGetErrorString(e), grid);
#endif
}
```

```cpp
#include <hip/hip_runtime.h>
#include <hip/hip_cooperative_groups.h>
#include <cstdio>
#include <cstdint>
namespace cg = cooperative_groups;

#ifndef MK_MULTI
#define MK_MULTI 0
#endif

#define LAS __attribute__((address_space(3)))
typedef unsigned short bf16_t;
typedef short bf16x8 __attribute__((ext_vector_type(8)));
typedef float f32x4 __attribute__((ext_vector_type(4)));
typedef float f32x2 __attribute__((ext_vector_type(2)));
typedef unsigned u32x4 __attribute__((ext_vector_type(4)));
typedef unsigned u32x2 __attribute__((ext_vector_type(2)));
typedef __bf16 bf16x2_t __attribute__((ext_vector_type(2)));
typedef short v4i16_t __attribute__((ext_vector_type(4)));

constexpr int NTOK = 65536, DM = 1024, SEQ = 4096, NBATCH = 16;
constexpr float EPSF = 1e-6f;
constexpr size_t MiB = 1u << 20;
typedef unsigned long long u64;
constexpr float SC_SS = 1048576.0f, SC_L = 16777216.0f;
constexpr size_t ST_SXZ = 0;
constexpr size_t ST_QST = 11 * 512 * 1024;
constexpr size_t ST_LSUM = ST_QST + 8 * MiB;
constexpr size_t ST_KST = ST_LSUM + 8 * MiB;
constexpr size_t ST_ZERO_BYTES = ST_KST + 1 * MiB;
constexpr size_t ST_SX0 = ST_ZERO_BYTES;
constexpr size_t ST_SMEM = ST_SX0 + 512 * 1024;
constexpr size_t ST_BAR = ST_SX0 + 768 * 1024;
constexpr size_t ST_LSE = 24 * MiB;
constexpr size_t ST_ROPE = 27 * MiB;
constexpr size_t WB = 16 * MiB;
constexpr size_t WS_EVWIN = WB + 16 * MiB, WS_ODWIN = WB + 28 * MiB, WS_EVWOUT = WB + 41 * MiB, WS_ODWOUT = WB + 45 * MiB, WS_WQ = WB + 50 * MiB, WS_WKV = WB + 58 * MiB,
                 WS_WO = WB + 74 * MiB, WS_W1 = WB + 82 * MiB, WS_W2 = WB + 114 * MiB, WS_MEMB = WB + 146 * MiB, WS_KT = WB + 154 * MiB, WS_VT = WB + 186 * MiB, WS_XB = WB + 218 * MiB,
                 WS_A = WB + 346 * MiB;
constexpr size_t WS_P = WS_A, WS_MIX = WS_A + 416 * MiB, WS_KVRAW = WS_A, WS_QX = WS_A, WS_PB = WS_A + 128 * MiB, WS_AO = WS_A + 256 * MiB, WS_HMID = WS_A;
constexpr size_t WS_VP = WS_A + 576 * MiB;
constexpr size_t WS_END = WS_VP + 32 * MiB;
constexpr int LDS_BYTES = 147456;

__device__ __forceinline__ unsigned pk_bf16(float lo, float hi) { f32x2 v = {lo, hi}; bf16x2_t b = __builtin_convertvector(v, bf16x2_t); return __builtin_bit_cast(unsigned, b); }
__device__ __forceinline__ float bf_lo(unsigned u) { return __uint_as_float(u << 16); }
__device__ __forceinline__ float bf_hi(unsigned u) { return __uint_as_float(u & 0xffff0000u); }
__device__ __forceinline__ void unpack8(const u32x4 v, float* f) { f[0] = bf_lo(v.x); f[1] = bf_hi(v.x); f[2] = bf_lo(v.y); f[3] = bf_hi(v.y); f[4] = bf_lo(v.z); f[5] = bf_hi(v.z); f[6] = bf_lo(v.w); f[7] = bf_hi(v.w); }
__device__ __forceinline__ u32x4 pack8(const float* f) { u32x4 w; w.x = pk_bf16(f[0], f[1]); w.y = pk_bf16(f[2], f[3]); w.z = pk_bf16(f[4], f[5]); w.w = pk_bf16(f[6], f[7]); return w; }
__device__ __forceinline__ float sigmoidf_(float x) { return __builtin_amdgcn_rcpf(1.0f + __expf(-x)); }
__device__ __forceinline__ float wave_sum(float v) {
#pragma unroll
    for (int o = 1; o < 64; o <<= 1) v += __shfl_xor(v, o);
    return v;
}
template <int CTRL> __device__ __forceinline__ float dppf(float v) { return __int_as_float(__builtin_amdgcn_update_dpp(0, __float_as_int(v), CTRL, 0xf, 0xf, true)); }
__device__ __forceinline__ float row16_sum(float v) { v += dppf<0x128>(v); v += dppf<0x124>(v); v += dppf<0x122>(v); v += dppf<0x121>(v); return v; }
__device__ __forceinline__ f32x2 gelu_pk(f32x2 v) {
    const f32x2 av = __builtin_elementwise_abs(v), d = av * 0.2316418882f + 1.0f;
    f32x2 t; t.x = __builtin_amdgcn_rcpf(d.x); t.y = __builtin_amdgcn_rcpf(d.y);
    f32x2 q = t * 0.5307027145f + (-0.7265760135f); q = q * t + 0.7107068705f; q = q * t + (-0.142248368f); q = q * t + 0.127414796f; q = q * t;
    const f32x2 s = (v * v) * (-0.72134752044f);
    f32x2 e; e.x = __builtin_amdgcn_exp2f(s.x); e.y = __builtin_amdgcn_exp2f(s.y);
    const f32x2 m = v * (q * e), r = v - m;
    f32x2 o; o.x = v.x < 0.f ? m.x : r.x; o.y = v.y < 0.f ? m.y : r.y; return o;
}

namespace pg8 {
constexpr int BM = 256, BK = 64, HALF = 128, HTB = HALF * BK * 2, STAGE_BYTES = 8 * HTB, WGM = 8;
__host__ __device__ __forceinline__ int lds_byte(int r, int c) { const int st = (r >> 4) * 2 + (c >> 5), rr = r & 15, cc = c & 31, ob = rr * 64 + cc * 2; return st * 1024 + (ob ^ (((ob >> 9) & 1) << 5)); }
__host__ __device__ __forceinline__ void stage_rc(int b, int& R, int& C) { const int st = b / 1024, sb = b % 1024, swz = sb ^ (((sb >> 9) & 1) << 5); R = (st >> 1) * 16 + swz / 64; C = (st & 1) * 32 + (swz % 64) / 2; }
__host__ __device__ __forceinline__ int perm32(int rho) { const int n = rho >> 4, i = rho & 15; return 8 * (i >> 2) + 4 * n + (i & 3); }

struct Unit { int pm, pn, z; };
struct Gemm { const bf16_t* A; const bf16_t* Bt; int lda, ldb, K, nM, nN, nZ, ZL; int sAh, sAl, sBh, sBl; int rev; };
struct Order {
    int nM, nN, per, nwg, G, c, rev;
    __device__ __forceinline__ void init(const Gemm& g, int G_, int c_) { nM = g.nM; nN = g.nN; per = nM * nN; nwg = per * g.nZ; G = G_; c = c_; rev = g.rev; }
    __device__ __forceinline__ bool next(int i, Unit& u) const {
        const long L = (long)i * G + c; if (L >= nwg) return false;
        int w = (int)L;
        if ((nwg & 7) == 0) { const int ch = nwg >> 3, off = w >> 3; w = (w & 7) * ch + (rev ? ch - 1 - off : off); }
        u.z = w / per; const int t = w % per;
        const int nig = WGM * nN, gid = t / nig, fm = gid * WGM, gsz = (nM - fm) < WGM ? (nM - fm) : WGM;
        u.pm = fm + ((t % nig) % gsz); u.pn = (t % nig) / gsz; return true;
    }
};
__device__ __forceinline__ const char* a_ptr(const Gemm& g, const Unit& u) { return (const char*)(g.A + ((u.z / g.ZL) * g.sAh + (u.z % g.ZL) * g.sAl + u.pm * BM * g.lda)); }
__device__ __forceinline__ const char* b_ptr(const Gemm& g, const Unit& u) { return (const char*)(g.Bt + ((u.z / g.ZL) * g.sBh + (u.z % g.ZL) * g.sBl + u.pn * BM * g.ldb)); }

struct EpiP {
    static constexpr bool PERM = true;
    bf16_t* O; int ldc; int Mz; const u64* rstat; float rinv; int act; u64* hstat; int hs_ld; int ZLo; int zcol;
    __device__ __forceinline__ void operator()(f32x4 (&acc)[2][2][4][2], const Unit& u, int wr, int wc, int fr, int fq) const {
        const int row0 = u.pm * BM + wr * 64 + fr, col0 = u.pn * BM + wc * 32 + 8 * fq;
        const bool do_gelu = (act == 1) && (u.pn < 4);
        float rsv[8];
#pragma unroll
        for (int q = 0; q < 8; ++q) rsv[q] = 1.f;
        if (rstat) {
            u64 sv[8];
#pragma unroll
            for (int q = 0; q < 8; ++q) sv[q] = rstat[row0 + (q >> 2) * HALF + (q & 3) * 16];
#pragma unroll
            for (int q = 0; q < 8; ++q) rsv[q] = rsqrtf((float)sv[q] * rinv + EPSF);
        }
        asm volatile("" ::: "memory");
#pragma unroll
        for (int ai = 0; ai < 2; ++ai)
#pragma unroll
            for (int m = 0; m < 4; ++m) {
                const int row = row0 + ai * HALF + m * 16;
                const float rs = rsv[ai * 4 + m];
                float hs = 0.f;
                bf16_t* rowp = O + ((long)(u.z / ZLo) * Mz + row) * ldc + (u.z % ZLo) * zcol + col0;
#pragma unroll
                for (int bj = 0; bj < 2; ++bj) {
                    f32x4 v0 = acc[ai][bj][m][0] * rs, v1 = acc[ai][bj][m][1] * rs;
                    if (do_gelu) { f32x2 a = gelu_pk((f32x2){v0[0], v0[1]}), b = gelu_pk((f32x2){v0[2], v0[3]}), c = gelu_pk((f32x2){v1[0], v1[1]}), d = gelu_pk((f32x2){v1[2], v1[3]});
                        v0 = (f32x4){a.x, a.y, b.x, b.y}; v1 = (f32x4){c.x, c.y, d.x, d.y}; }
                    else if (act == 2) {
#pragma unroll
                        for (int i = 0; i < 4; ++i) { const float a = fmaxf(v0[i], 0.f), b = fmaxf(v1[i], 0.f); v0[i] = a * a; v1[i] = b * b; } }
                    hs += (v0[0] * v0[0] + v0[1] * v0[1]) + (v0[2] * v0[2] + v0[3] * v0[3]) + (v1[0] * v1[0] + v1[1] * v1[1]) + (v1[2] * v1[2] + v1[3] * v1[3]);
                    u32x4 w; w.x = pk_bf16(v0[0], v0[1]); w.y = pk_bf16(v0[2], v0[3]); w.z = pk_bf16(v1[0], v1[1]); w.w = pk_bf16(v1[2], v1[3]);
                    *(u32x4*)(rowp + bj * HALF) = w;
                }
                if (hstat) { hs += __shfl_xor(hs, 16); hs += __shfl_xor(hs, 32); if (fq == 0) atomicAdd(hstat + ((long)u.z * Mz + row) * hs_ld + u.pn, (u64)(hs * SC_SS + 0.5f)); }
            }
    }
};
struct EpiS {
    static constexpr bool PERM = true;
    bf16_t* P; const u64* qstat; LAS float* xch;
    __device__ __forceinline__ void operator()(f32x4 (&acc)[2][2][4][2], const Unit& u, int wr, int wc, int fr, int fq) const {
        const int b = u.z >> 2, h = u.z & 3;
        const int row0 = b * SEQ + u.pm * BM + wr * 64 + fr, col0 = h * 256 + wc * 32 + 8 * fq;
        float rsv[8];
        { u64 sv[8];
#pragma unroll
          for (int q = 0; q < 8; ++q) sv[q] = qstat[(long)(row0 + (q >> 2) * HALF + (q & 3) * 16) * 4 + h];
#pragma unroll
          for (int q = 0; q < 8; ++q) rsv[q] = rsqrtf((float)sv[q] * (1.0f / (256.0f * SC_SS)) + EPSF) * 1.4426950408889634f; }
#pragma unroll
        for (int ai = 0; ai < 2; ++ai)
#pragma unroll
            for (int m = 0; m < 4; ++m) {
                const int rl = ai * HALF + wr * 64 + m * 16 + fr;
                const float rs = rsv[ai * 4 + m];
                float sum = 0.f;
#pragma unroll
                for (int bj = 0; bj < 2; ++bj)
#pragma unroll
                    for (int n = 0; n < 2; ++n)
#pragma unroll
                        for (int i = 0; i < 4; ++i) { const float e = __builtin_amdgcn_exp2f(acc[ai][bj][m][n][i] * rs); acc[ai][bj][m][n][i] = e; sum += e; }
                sum += __shfl_xor(sum, 16); sum += __shfl_xor(sum, 32);
                if (fq == 0) xch[rl * 4 + wc] = sum;
            }
        asm volatile("s_waitcnt lgkmcnt(0)" ::: "memory"); __builtin_amdgcn_s_barrier(); asm volatile("" ::: "memory");
#pragma unroll
        for (int ai = 0; ai < 2; ++ai)
#pragma unroll
            for (int m = 0; m < 4; ++m) {
                const int row = row0 + ai * HALF + m * 16, rl = ai * HALF + wr * 64 + m * 16 + fr;
                const f32x4 t = *(const LAS f32x4*)(xch + rl * 4);
                const float inv = 1.0f / ((t[0] + t[1]) + (t[2] + t[3]));
                bf16_t* rowp = P + (long)row * 1024 + col0;
#pragma unroll
                for (int bj = 0; bj < 2; ++bj) {
                    const f32x4 v0 = acc[ai][bj][m][0] * inv, v1 = acc[ai][bj][m][1] * inv;
                    u32x4 w; w.x = pk_bf16(v0[0], v0[1]); w.y = pk_bf16(v0[2], v0[3]); w.z = pk_bf16(v1[0], v1[1]); w.w = pk_bf16(v1[2], v1[3]);
                    *(u32x4*)(rowp + bj * HALF) = w;
                }
            }
    }
};
struct EpiO {
    static constexpr bool PERM = true;
    bf16_t* O; const u64* lsum;
    __device__ __forceinline__ void operator()(f32x4 (&acc)[2][2][4][2], const Unit& u, int wr, int wc, int fr, int fq) const {
        const int b = u.z >> 2, h = u.z & 3;
        const int row0 = b * SEQ + u.pm * BM + wr * 64 + fr, col0 = h * 256 + wc * 32 + 8 * fq;
#pragma unroll
        for (int ai = 0; ai < 2; ++ai)
#pragma unroll
            for (int m = 0; m < 4; ++m) {
                const int row = row0 + ai * HALF + m * 16;
                const float inv = SC_L / (float)lsum[(long)row * 4 + h];
                bf16_t* rowp = O + (long)row * 1024 + col0;
#pragma unroll
                for (int bj = 0; bj < 2; ++bj) {
                    const f32x4 v0 = acc[ai][bj][m][0] * inv, v1 = acc[ai][bj][m][1] * inv;
                    u32x4 w; w.x = pk_bf16(v0[0], v0[1]); w.y = pk_bf16(v0[2], v0[3]); w.z = pk_bf16(v1[0], v1[1]); w.w = pk_bf16(v1[2], v1[3]);
                    *(u32x4*)(rowp + bj * HALF) = w;
                }
            }
    }
};
struct EpiR {
    static constexpr bool PERM = true;
    float* out; bf16_t* xb; u64* stat; int Mz;
    __device__ __forceinline__ bool can_repeat() const { return false; }
    __device__ __forceinline__ void operator()(f32x4 (&acc)[2][2][4][2], const Unit& u, int wr, int wc, int fr, int fq) const {
        const int row0 = u.z * Mz + u.pm * BM + wr * 64 + fr, col0 = u.pn * BM + wc * 32 + 8 * fq;
        u32x4 xv[2][2][2];
#define EPIR_LOAD(q_, buf_) do { _Pragma("unroll") for (int mm = 0; mm < 2; ++mm) _Pragma("unroll") for (int bj = 0; bj < 2; ++bj) \
            xv[buf_][mm][bj] = *(const u32x4*)(xb + (size_t)(row0 + ((q_) >> 1) * HALF + (((q_) & 1) * 2 + mm) * 16) * DM + col0 + bj * HALF); } while (0)
        EPIR_LOAD(0, 0);
#pragma unroll
        for (int q = 0; q < 4; ++q) {
            if (q < 3) EPIR_LOAD(q + 1, (q + 1) & 1);
            asm volatile("" ::: "memory");
            const int ai = q >> 1;
#pragma unroll
            for (int mm = 0; mm < 2; ++mm) {
                const int m = (q & 1) * 2 + mm;
                const int row = row0 + ai * HALF + m * 16; const size_t off = (size_t)row * DM + col0;
                float ss = 0.f;
#pragma unroll
                for (int bj = 0; bj < 2; ++bj) {
                    float f[8]; unpack8(xv[q & 1][mm][bj], f);
#pragma unroll
                    for (int i = 0; i < 4; ++i) { f[i] += acc[ai][bj][m][0][i]; f[4 + i] += acc[ai][bj][m][1][i]; }
#pragma unroll
                    for (int i = 0; i < 8; ++i) ss += f[i] * f[i];
                    *(u32x4*)(xb + off + bj * HALF) = pack8(f);
                    if (out) { *(f32x4*)(out + off + bj * HALF) = (f32x4){f[0], f[1], f[2], f[3]}; *(f32x4*)(out + off + bj * HALF + 4) = (f32x4){f[4], f[5], f[6], f[7]}; }
                }
                ss += __shfl_xor(ss, 16); ss += __shfl_xor(ss, 32);
                if (fq == 0) atomicAdd(stat + row, (u64)(ss * SC_SS + 0.5f));
            }
            asm volatile("" ::: "memory");
        }
#undef EPIR_LOAD
    }
};

template <class Epi>
__device__ __forceinline__ void gemm_phase(LAS unsigned char* lds, const int tid, const Gemm g, const int G, const int cidx, const Epi& E) {
    const int wid = __builtin_amdgcn_readfirstlane(tid >> 6), lane = tid & 63, wr = wid >> 2, wc = wid & 3, fr = lane & 15, fq = lane >> 4;
    Order S; S.init(g, G, cidx);
    const int K = g.K, nt = K / BK;
    unsigned voffA[2], voffB[2];
#pragma unroll
    for (int i = 0; i < 2; ++i) { int R, C; stage_rc(tid * 16 + i * 8192, R, C); const int Rb = Epi::PERM ? ((R & ~31) + perm32(R & 31)) : R;
        voffA[i] = (unsigned)(R * g.lda + C) * 2u; voffB[i] = (unsigned)(Rb * g.ldb + C) * 2u; }
    const size_t kstep = (size_t)(BK * 2);
    const size_t hstepA = (size_t)HALF * g.lda * 2, hstepB = (size_t)HALF * g.ldb * 2;
    const unsigned ldsw = (unsigned)wid * 1024u;
    const int aoff = lds_byte(wr * 64 + fr, fq * 8), boff = lds_byte(wc * 32 + fr, fq * 8);
#define PG8_SA(b, h) (((b) * 2 + (h)) * HTB)
#define PG8_SB(b, h) ((4 + (b) * 2 + (h)) * HTB)
#define PG8_STAGE(bufoff, gbase, voff) do { _Pragma("unroll") for (int _i = 0; _i < 2; ++_i) \
        __builtin_amdgcn_global_load_lds((const unsigned*)((const char*)(gbase) + (voff)[_i]), (LAS unsigned*)(lds + (bufoff) + ldsw + _i * 8192), 16, 0, 0); } while (0)
#define PG8_LDA(dst, b, h) do { _Pragma("unroll") for (int m = 0; m < 4; ++m) _Pragma("unroll") for (int k = 0; k < 2; ++k) dst[m][k] = *(const LAS bf16x8*)(lds + PG8_SA(b, h) + aoff + m * 2048 + k * 1024); } while (0)
#define PG8_LDB(dst, b, h) do { _Pragma("unroll") for (int n = 0; n < 2; ++n) _Pragma("unroll") for (int k = 0; k < 2; ++k) dst[n][k] = *(const LAS bf16x8*)(lds + PG8_SB(b, h) + boff + n * 2048 + k * 1024); } while (0)
#define PG8_MMA(ai, bj, At, Bt) do { __builtin_amdgcn_s_setprio(1); _Pragma("unroll") for (int m = 0; m < 4; ++m) _Pragma("unroll") for (int n = 0; n < 2; ++n) _Pragma("unroll") for (int k = 0; k < 2; ++k) \
        acc[ai][bj][m][n] = __builtin_amdgcn_mfma_f32_16x16x32_bf16(Bt[n][k], At[m][k], acc[ai][bj][m][n], 0, 0, 0); __builtin_amdgcn_s_setprio(0); } while (0)
#define PG8_WAIT_V(n) asm volatile("s_waitcnt vmcnt(" #n ")" ::: "memory")
#define PG8_WAIT_L(n) asm volatile("s_waitcnt lgkmcnt(" #n ")" ::: "memory")
#define PG8_BAR __builtin_amdgcn_s_barrier()
#define PG8_SCHED __builtin_amdgcn_sched_barrier(0)
    Unit cur, nxt; int ui = 0;
    if (!S.next(0, cur)) return;
    f32x4 acc[2][2][4][2];
#pragma unroll
    for (int a = 0; a < 2; ++a)
#pragma unroll
        for (int b = 0; b < 2; ++b)
#pragma unroll
            for (int m = 0; m < 4; ++m)
#pragma unroll
                for (int n = 0; n < 2; ++n) acc[a][b][m][n] = (f32x4){0.f, 0.f, 0.f, 0.f};
    bf16x8 At[4][2], B0[2][2], B1[2][2];
    const char* cA = a_ptr(g, cur); const char* cB = b_ptr(g, cur);
    PG8_STAGE(PG8_SB(0, 0), cB, voffB); PG8_STAGE(PG8_SB(0, 1), cB + hstepB, voffB); PG8_STAGE(PG8_SA(0, 0), cA, voffA); PG8_STAGE(PG8_SA(0, 1), cA + hstepA, voffA);
    if (wr == 1) PG8_BAR;
    PG8_WAIT_V(2); PG8_BAR;
    PG8_STAGE(PG8_SB(1, 0), cB + kstep, voffB); PG8_STAGE(PG8_SA(1, 0), cA + kstep, voffA); PG8_STAGE(PG8_SB(1, 1), cB + hstepB + kstep, voffB);
    PG8_WAIT_V(6); PG8_BAR;
    for (;;) {
        const bool has_next = S.next(ui + 1, nxt);
        const char* nA = has_next ? a_ptr(g, nxt) : cA; const char* nB = has_next ? b_ptr(g, nxt) : cB;
        for (int t = 0; t < nt; t += 2) {
            const bool last = (t == nt - 2);
            const char* a1 = cA + (size_t)(t + 1) * kstep;
            const char* a2 = last ? nA : cA + (size_t)(t + 2) * kstep; const char* b2 = last ? nB : cB + (size_t)(t + 2) * kstep;
            const char* a3 = a2 + kstep; const char* b3 = b2 + kstep;
            PG8_LDB(B0, 0, 0); PG8_LDB(B1, 0, 1); PG8_SCHED; PG8_LDA(At, 0, 0); PG8_STAGE(PG8_SA(1, 1), a1 + hstepA, voffA);
            PG8_WAIT_V(8); PG8_WAIT_L(0); PG8_BAR; PG8_MMA(0, 0, At, B0); PG8_MMA(0, 1, At, B1); PG8_BAR; PG8_SCHED;
            PG8_LDA(At, 0, 1); PG8_STAGE(PG8_SB(0, 0), b2, voffB); PG8_STAGE(PG8_SB(0, 1), b2 + hstepB, voffB); PG8_STAGE(PG8_SA(0, 0), a2, voffA);
            PG8_WAIT_V(8); PG8_WAIT_L(0); PG8_BAR; PG8_MMA(1, 0, At, B0); PG8_MMA(1, 1, At, B1); PG8_BAR; PG8_SCHED;
            PG8_LDB(B0, 1, 0); PG8_LDB(B1, 1, 1); PG8_SCHED; PG8_LDA(At, 1, 0); PG8_STAGE(PG8_SA(0, 1), a2 + hstepA, voffA);
            PG8_WAIT_V(8); PG8_WAIT_L(0); PG8_BAR; PG8_MMA(0, 0, At, B0); PG8_MMA(0, 1, At, B1); PG8_BAR; PG8_SCHED;
            PG8_LDA(At, 1, 1); PG8_STAGE(PG8_SB(1, 0), b3, voffB); PG8_STAGE(PG8_SB(1, 1), b3 + hstepB, voffB); PG8_STAGE(PG8_SA(1, 0), a3, voffA);
            PG8_WAIT_V(8); PG8_WAIT_L(0); PG8_BAR; PG8_MMA(1, 0, At, B0); PG8_MMA(1, 1, At, B1); PG8_BAR; PG8_SCHED;
        }
        if (wr == 0) PG8_BAR;
        E(acc, cur, wr, wc, fr, fq);
        if (!has_next) break;
#pragma unroll
        for (int a = 0; a < 2; ++a)
#pragma unroll
            for (int b = 0; b < 2; ++b)
#pragma unroll
                for (int m = 0; m < 4; ++m)
#pragma unroll
                    for (int n = 0; n < 2; ++n) acc[a][b][m][n] = (f32x4){0.f, 0.f, 0.f, 0.f};
        cur = nxt; cA = nA; cB = nB; ++ui;
        if (wr == 1) PG8_BAR;
    }
    PG8_WAIT_V(0);
    PG8_BAR;
#undef PG8_SA
#undef PG8_SB
#undef PG8_STAGE
#undef PG8_LDA
#undef PG8_LDB
#undef PG8_MMA
#undef PG8_WAIT_V
#undef PG8_WAIT_L
#undef PG8_BAR
#undef PG8_SCHED
}
}

struct Args { const float* in[29]; float* out; unsigned char* ws; int lo, hi; };

__device__ __forceinline__ void transpose_item(const float* W, int K, int N, const float* gain, bf16_t* WT, LAS float* scr, int item, int lane) {
    const int nblk = N / 32, kb = item / nblk, nb = item % nblk, k0 = 64 * kb, n0 = 32 * nb;
    {
        float wv[32]; const float* wp = W + (size_t)(k0 + (lane >> 5)) * N + n0 + (lane & 31);
#pragma unroll
        for (int i = 0; i < 32; ++i) wv[i] = wp[(size_t)(2 * i) * N];
        if (gain) { const float* gp = gain + k0 + (lane >> 5);
#pragma unroll
            for (int i = 0; i < 32; ++i) wv[i] *= gp[2 * i]; }
#pragma unroll
        for (int i = 0; i < 32; ++i) scr[(2 * i + (lane >> 5)) * 33 + (lane & 31)] = wv[i];
    }
    asm volatile("s_waitcnt lgkmcnt(0)" ::: "memory");
    const int c = lane & 7;
#pragma unroll
    for (int j = 0; j < 4; ++j) { const int n = (lane >> 3) + 8 * j; const LAS float* s = scr + (8 * c) * 33 + n;
        u32x4 o; o.x = pk_bf16(s[0 * 33], s[1 * 33]); o.y = pk_bf16(s[2 * 33], s[3 * 33]); o.z = pk_bf16(s[4 * 33], s[5 * 33]); o.w = pk_bf16(s[6 * 33], s[7 * 33]);
        *(u32x4*)(WT + (size_t)(n0 + n) * K + k0 + 8 * c) = o; }
    asm volatile("s_waitcnt lgkmcnt(0)" ::: "memory");
}
__device__ __forceinline__ void transpose_all(const float* W, int K, int N, const float* gain, bf16_t* WT, LAS float* scr, int gw, int NGW, int lane) {
    const int nitems = (K / 64) * (N / 32);
    for (int it = gw; it < nitems; it += NGW) transpose_item(W, K, N, gain, WT, scr, it, lane);
}
__device__ __forceinline__ void row_to_bf16(const float* xrow, bf16_t* orow, u64* ss, int lane) {
    const f32x4* xr = (const f32x4*)xrow + lane; float s = 0.f; f32x4 v[4];
#pragma unroll
    for (int j = 0; j < 4; ++j) { v[j] = xr[64 * j]; s += (v[j].x * v[j].x + v[j].y * v[j].y) + (v[j].z * v[j].z + v[j].w * v[j].w); }
    s = wave_sum(s);
    u32x2* o8 = (u32x2*)orow + lane;
#pragma unroll
    for (int j = 0; j < 4; ++j) { u32x2 w; w.x = pk_bf16(v[j].x, v[j].y); w.y = pk_bf16(v[j].z, v[j].w); o8[64 * j] = w; }
    if (lane == 0) *ss = (u64)(s * SC_SS + 0.5f);
}

__device__ __forceinline__ void transpose_layer(const __attribute__((address_space(4))) Args* ap, unsigned char* ws, int l, LAS float* scr, int gw, int NGW, int lane) {
    const int e = l >> 1;
    if (l & 1) {
        transpose_all(ap->in[11] + (size_t)e * 1024 * 3328, 1024, 3328, ap->in[2] + l * 1024, (bf16_t*)(ws + WS_ODWIN) + (size_t)e * 3328 * 1024, scr, gw, NGW, lane);
        transpose_all(ap->in[18] + (size_t)e * 1280 * 1024, 1280, 1024, nullptr, (bf16_t*)(ws + WS_ODWOUT) + (size_t)e * 1024 * 1280, scr, gw, NGW, lane);
    } else {
        transpose_all(ap->in[3] + (size_t)e * 1024 * 3072, 1024, 3072, ap->in[2] + l * 1024, (bf16_t*)(ws + WS_EVWIN) + (size_t)e * 3072 * 1024, scr, gw, NGW, lane);
        transpose_all(ap->in[10] + (size_t)e * 1024 * 1024, 1024, 1024, nullptr, (bf16_t*)(ws + WS_EVWOUT) + (size_t)e * 1024 * 1024, scr, gw, NGW, lane);
    }
    transpose_all(ap->in[21] + (size_t)l * 1024 * 1024, 1024, 1024, ap->in[19] + l * 1024, (bf16_t*)(ws + WS_WQ) + (size_t)l * 1024 * 1024, scr, gw, NGW, lane);
    transpose_all(ap->in[25] + (size_t)l * 1024 * 1024, 1024, 1024, nullptr, (bf16_t*)(ws + WS_WO) + (size_t)l * 1024 * 1024, scr, gw, NGW, lane);
    transpose_all(ap->in[27] + (size_t)l * 1024 * 4096, 1024, 4096, ap->in[26] + l * 1024, (bf16_t*)(ws + WS_W1) + (size_t)l * 4096 * 1024, scr, gw, NGW, lane);
    transpose_all(ap->in[28] + (size_t)l * 4096 * 1024, 4096, 1024, nullptr, (bf16_t*)(ws + WS_W2) + (size_t)l * 1024 * 4096, scr, gw, NGW, lane);
}

#define XB_TMO      128
#define XB_XCNT(j)  (256  + 64 * (j))
#define XB_XSUB(j)  (1280 + 64 * (j))
#define XB_XGEN(j)  (2304 + 64 * (j))
#define XB_TOP      3328
#define XB_TOPGEN   3392
#define XCD_BAR_WORDS 3456
#define XB_SPIN_CAP (1u << 22)
__device__ __forceinline__ unsigned xb_ld(unsigned* p)              { return __hip_atomic_load(p, __ATOMIC_RELAXED, __HIP_MEMORY_SCOPE_AGENT); }
__device__ __forceinline__ unsigned xb_add(unsigned* p, unsigned v) { return __hip_atomic_fetch_add(p, v, __ATOMIC_RELAXED, __HIP_MEMORY_SCOPE_AGENT); }
__device__ __forceinline__ unsigned xb_xcc_id() { return (unsigned)__builtin_amdgcn_s_getreg((3 << 11) | 20) & 0xFu; }
#define XB_SPIN(cond, bar) do { unsigned _sp = 0; while (cond) { __builtin_amdgcn_s_sleep(1); \
    if ((++_sp & 255u) == 0u) { if (xb_ld(&(bar)[XB_TMO])) break; if (_sp > XB_SPIN_CAP) { atomicAdd(&(bar)[XB_TMO], 1u); break; } } } } while (0)
__device__ __forceinline__ void xcd_barrier_complete(unsigned* bar, unsigned x, unsigned& nloc, unsigned& nx) {
    const unsigned G = gridDim.x * gridDim.y * gridDim.z;
    unsigned sum, cnt, mine, sp = 0u;
    for (;;) {
        sum = 0u; cnt = 0u; mine = 0u;
#pragma unroll
        for (unsigned j = 0; j < 16; ++j) { const unsigned c = xb_ld(&bar[XB_XCNT(j)]); sum += c; cnt += (c > 0u) ? 1u : 0u; mine = (j == x) ? c : mine; }
        if (sum == G) break;
        __builtin_amdgcn_s_sleep(1);
        if ((++sp & 255u) == 0u) { if (xb_ld(&bar[XB_TMO])) break; if (sp > XB_SPIN_CAP) { atomicAdd(&bar[XB_TMO], 1u); break; } }
    }
    nloc = mine > 0u ? mine : 1u; nx = cnt > 0u ? cnt : 1u;
}
__device__ __forceinline__ void xcd_barrier(unsigned* bar, unsigned x, volatile LAS unsigned* st) {
    asm volatile("s_waitcnt vmcnt(0)" ::: "memory");
    __syncthreads();
    if (threadIdx.x == 0) {
        __builtin_amdgcn_s_waitcnt(0);
        unsigned nloc = st[0], nx = st[1];
        if (nloc == 0u) { xcd_barrier_complete(bar, x, nloc, nx); st[0] = nloc; st[1] = nx; }
        const unsigned old = xb_add(&bar[XB_XSUB(x)], 1u);
        const unsigned gen = old / nloc;
        if (old + 1u == (gen + 1u) * nloc) {
            __builtin_amdgcn_fence(__ATOMIC_RELEASE, "agent");
            asm volatile("s_waitcnt vmcnt(0)" ::: "memory");
            const unsigned og = xb_add(&bar[XB_TOP], 1u);
            const unsigned tg = og / nx;
            if (og + 1u == (tg + 1u) * nx) xb_add(&bar[XB_TOPGEN], 1u);
            else XB_SPIN(xb_ld(&bar[XB_TOPGEN]) == tg, bar);
            __builtin_amdgcn_fence(__ATOMIC_ACQUIRE, "agent");
            xb_add(&bar[XB_XGEN(x)], 1u);
            asm volatile("s_waitcnt vmcnt(0)" ::: "memory");
        } else {
            XB_SPIN(xb_ld(&bar[XB_XGEN(x)]) == gen, bar);
            __builtin_amdgcn_fence(__ATOMIC_ACQUIRE, "agent");
            asm volatile("s_waitcnt vmcnt(0)" ::: "memory");
        }
    }
    __syncthreads();
}

__global__ void __launch_bounds__(512, 2) mk_fwd(Args args) {
    extern __shared__ __attribute__((aligned(16))) unsigned char lds_raw[];
    LAS unsigned char* lds = (LAS unsigned char*)lds_raw;
    volatile LAS unsigned* const xst = (volatile LAS unsigned*)((LAS unsigned char*)lds_raw + LDS_BYTES - 64);
    if (threadIdx.x < 2) xst[threadIdx.x] = 0u;
    const unsigned xcc = xb_xcc_id();
    if (args.hi - args.lo > 1 && threadIdx.x == 0) (void)xb_add((unsigned*)(args.ws + ST_BAR) + XB_XCNT(xcc), 1u);
    __syncthreads();
    const __attribute__((address_space(4))) Args* const ap0 = (const __attribute__((address_space(4))) Args*)__builtin_amdgcn_kernarg_segment_ptr();
#ifdef REP_MASK
    for (int ph2 = args.lo * 2; ph2 < args.hi * 2; ++ph2) { const int ph = ph2 >> 1;
    if ((ph2 & 1) && !(ph >= 3 && ((REP_MASK >> ((ph - 3) % 10)) & 1) && ((REP_ODD >> (((ph - 3) / 10) & 1)) & 1))) continue;
#else
    for (int ph = args.lo; ph < args.hi; ++ph) {
#endif
    const __attribute__((address_space(4))) Args* ap = ap0; asm volatile("" : "+s"(ap));
    int tid = threadIdx.x; asm volatile("" : "+v"(tid));
    const int lane = tid & 63, wave = __builtin_amdgcn_readfirstlane(tid >> 6);
    int G = gridDim.x, bx = blockIdx.x; asm volatile("" : "+s"(G), "+s"(bx));
    const int vcu = (G % 8 == 0) ? (bx % 8) * (G / 8) + bx / 8 : bx;
    unsigned char* ws = ap->ws;
    u64* const st_sxz = (u64*)(ws + ST_SXZ); u64* const st_sx0 = (u64*)(ws + ST_SX0);
    bf16_t* const xb = (bf16_t*)(ws + WS_XB);
    bf16_t* const pbuf = (bf16_t*)(ws + WS_P); bf16_t* const mix = (bf16_t*)(ws + WS_MIX);
    float* const rope = (float*)(ws + ST_ROPE); float* const lse = (float*)(ws + ST_LSE);
    {
#ifdef ONLY_S
        if (ph < 0) {
#else
        if (ph == 0) {
#endif
            const int gw = vcu * 8 + wave, NGW = G * 8;
            { u32x4* z = (u32x4*)ws; const size_t n16 = ST_ZERO_BYTES / 16; for (size_t i = (size_t)bx * 512 + tid; i < n16; i += (size_t)G * 512) z[i] = (u32x4){0u, 0u, 0u, 0u}; }
            for (int m = gw * 2; m < NTOK; m += NGW * 2) {
                const f32x4* x0 = (const f32x4*)(ap->in[0] + (size_t)m * DM) + lane; const f32x4* x1 = x0 + DM / 4;
                f32x4 v[8];
#pragma unroll
                for (int j = 0; j < 4; ++j) { v[j] = x0[64 * j]; v[4 + j] = x1[64 * j]; }
                float s0 = 0.f, s1 = 0.f;
#pragma unroll
                for (int j = 0; j < 4; ++j) { s0 += (v[j].x * v[j].x + v[j].y * v[j].y) + (v[j].z * v[j].z + v[j].w * v[j].w); s1 += (v[4 + j].x * v[4 + j].x + v[4 + j].y * v[4 + j].y) + (v[4 + j].z * v[4 + j].z + v[4 + j].w * v[4 + j].w); }
                s0 = wave_sum(s0); s1 = wave_sum(s1);
                u32x2* o0 = (u32x2*)(xb + (size_t)m * DM) + lane; u32x2* o1 = o0 + DM / 4;
#pragma unroll
                for (int j = 0; j < 4; ++j) { u32x2 w; w.x = pk_bf16(v[j].x, v[j].y); w.y = pk_bf16(v[j].z, v[j].w); o0[64 * j] = w; u32x2 w1; w1.x = pk_bf16(v[4 + j].x, v[4 + j].y); w1.y = pk_bf16(v[4 + j].z, v[4 + j].w); o1[64 * j] = w1; }
                if (lane == 0) { st_sx0[m] = (u64)(s0 * SC_SS + 0.5f); st_sx0[m + 1] = (u64)(s1 * SC_SS + 0.5f); }
            }
            { bf16_t* memb = (bf16_t*)(ws + WS_MEMB); u64* smem = (u64*)(ws + ST_SMEM);
              for (int m = gw; m < 4096; m += NGW) row_to_bf16(ap->in[1] + (size_t)m * DM, memb + (size_t)m * DM, smem + m, lane); }
            LAS float* scr = (LAS float*)(lds + wave * 16384);
            for (int l = 0; l < 4; ++l)
                transpose_all(ap->in[22] + (size_t)l * 1024 * 2048, 1024, 2048, ap->in[20] + l * 1024, (bf16_t*)(ws + WS_WKV) + (size_t)l * 2048 * 1024, scr, gw, NGW, lane);
            for (int l = 0; l < ((G >= 128) ? 1 : 4); ++l) transpose_layer(ap, ws, l, scr, gw, NGW, lane);
            for (int i = bx * 512 + tid; i < 4096 * 8; i += G * 512) {
                const int t = i >> 3, j = i & 7;
                const float invf[8] = {1.0f, 0.19392274474868576f, 0.03760603093086393f, 0.007292664737217109f, 0.001414213562373095f, 0.0002742481756762073f, 5.318295896944988e-05f, 1.031338537721246e-05f};
                float fj = invf[0];
#pragma unroll
                for (int q = 1; q < 8; ++q) fj = (j == q) ? invf[q] : fj;
                const float ang = (float)t * fj;
                const double a = (double)ang; const double k = __builtin_rint(a * 0.15915494309189535); const float r = (float)(a - k * 6.283185307179586);
                rope[t * 16 + j] = __cosf(r); rope[t * 16 + 8 + j] = __sinf(r);
            }
#ifdef ONLY_S
        } else if (ph < 0) {
#else
        } else if (ph == 1) {
#endif
            pg8::Gemm g{(const bf16_t*)(ws + WS_MEMB), (const bf16_t*)(ws + WS_WKV), 1024, 1024, 1024, 16, 8, 4, 1, 0, 0, 2048 * 1024, 0, 0};
            pg8::EpiP E{(bf16_t*)(ws + WS_KVRAW), 2048, 4096, (const u64*)(ws + ST_SMEM), 1.0f / (1024.0f * SC_SS), 0, (u64*)(ws + ST_KST), 8, 1, 0};
            pg8::gemm_phase<pg8::EpiP>(lds, tid, g, G, bx, E);
#ifdef ONLY_S
        } else if (ph < 0) {
#else
        } else if (ph == 2) {
#endif
            const int gw = vcu * 8 + wave, NGW = G * 8;
            const bf16_t* kvraw = (const bf16_t*)(ws + WS_KVRAW); bf16_t* kt = (bf16_t*)(ws + WS_KT); bf16_t* vt = (bf16_t*)(ws + WS_VT); const u64* kst = (const u64*)(ws + ST_KST);
            for (int r = gw; r < 4 * 4096; r += NGW) {
                const int l = r >> 12;
                const float* gk = ap->in[24] + l * 256; const float* gq = ap->in[23] + l * 256;
#pragma unroll
                for (int c2 = 0; c2 < 2; ++c2) {
                    const int ch = lane + 64 * c2, h = ch >> 5, e0 = (ch & 31) * 8;
                    const float rs = rsqrtf((float)kst[(size_t)r * 8 + h] * (1.0f / (256.0f * SC_SS)) + EPSF) * 0.0625f;
                    const u32x4 raw = *(const u32x4*)(kvraw + (size_t)r * 2048 + ch * 8); float f[8]; unpack8(raw, f);
#pragma unroll
                    for (int i = 0; i < 8; ++i) f[i] = f[i] * rs * gk[e0 + i] * gq[e0 + i];
                    *(u32x4*)(kt + (size_t)r * 1024 + ch * 8) = pack8(f);
                }
            }
            for (int idx0 = bx * 512 + tid; idx0 < 4 * 4096 * 128; idx0 += G * 512 * 4) {
                u32x4 cv[4];
#pragma unroll
                for (int q = 0; q < 4; ++q) { const int idx = idx0 + q * G * 512; cv[q] = (u32x4){0u, 0u, 0u, 0u}; if (idx < 4 * 4096 * 128) cv[q] = *(const u32x4*)(kvraw + (size_t)(idx >> 7) * 2048 + 1024 + (idx & 127) * 8); }
#pragma unroll
                for (int q = 0; q < 4; ++q) { const int idx = idx0 + q * G * 512; if (idx < 4 * 4096 * 128) *(u32x4*)(vt + (size_t)(idx >> 7) * 1024 + (idx & 127) * 8) = cv[q]; }
            }
        } else {
            #ifdef ONLY_S
            const int l = (ph - 3) / 10, s = ONLY_S, odd = ONLY_ODD, eo = l >> 1;
#else
            const int l = (ph - 3) / 10, s = (ph - 3) % 10, odd = l & 1, eo = l >> 1;
#endif
            u64* const sx_mix = (l == 0) ? st_sx0 : st_sxz + (size_t)(3 * l - 1) * NTOK;
            u64* const sx_xat = st_sxz + (size_t)(3 * l) * NTOK;
            u64* const sx_mlp = st_sxz + (size_t)(3 * l + 1) * NTOK;
            u64* const sx_next = st_sxz + (size_t)(3 * l + 2) * NTOK;
            u64* const qst = (u64*)(ws + ST_QST) + (size_t)l * NTOK * 4;
            u64* const lsum = (u64*)(ws + ST_LSUM) + (size_t)l * NTOK * 4;
            const int PW = odd ? 3328 : 3072, MW = odd ? 1280 : 1024;
            if (s == 6) continue;
            if (s == 0) {
                const bf16_t* wt = odd ? (const bf16_t*)(ws + WS_ODWIN) + (size_t)eo * 3328 * 1024 : (const bf16_t*)(ws + WS_EVWIN) + (size_t)eo * 3072 * 1024;
                pg8::Gemm g{xb, wt, 1024, 1024, 1024, 256, PW / 256, 1, 1, 0, 0, 0, 0, 0};
                pg8::EpiP E{pbuf, PW, NTOK, sx_mix, 1.0f / (1024.0f * SC_SS), odd ? 1 : 0, nullptr, 0, 1, 0};
                pg8::Gemm gv{(const bf16_t*)(ws + WS_WO) + (size_t)l * 1024 * 1024, (const bf16_t*)(ws + WS_VT) + (size_t)l * 4096 * 1024, 1024, 1024, 256, 4, 1, 64, 4, 0, 256, 256 * 1024, 256, 0};
                pg8::EpiP Ev{(bf16_t*)(ws + WS_VP), 1024, 1024, nullptr, 0.f, 0, nullptr, 0, 4, 256};
#pragma unroll 1
                for (int pass = 0; pass < 2; ++pass)
                    pg8::gemm_phase<pg8::EpiP>(lds, tid, pass ? gv : g, G, bx, pass ? Ev : E);
            } else if (s == 1 && !odd) {
#if !defined(NO_HGRN)
                {
                    const int fr = lane & 15, fq = lane >> 4, tr_r = (lane & 15) >> 2, tr_c = lane & 3;
                    const int kch = tid >> 2, tq = tid & 3;
                    constexpr int HB = 17920;
                    for (int item = vcu; item < 64; item += G) {
                        const int b = item >> 2, h = item & 3;
                        float lbv = 0.f; if (eo == 1) { const int c = h * 128 + kch; lbv = sigmoidf_(ap->in[8][512 + c] - ap->in[8][c]); }
                        f32x4 Sacc[8];
#pragma unroll
                        for (int kt = 0; kt < 8; ++kt) Sacc[kt] = (f32x4){0.f, 0.f, 0.f, 0.f};
                        const bf16_t* pq = pbuf + ((size_t)b * SEQ + 4 * tq) * 3072 + 1024 + h * 128 + kch;
                        const bf16_t* pi = pbuf + ((size_t)b * SEQ + (tid >> 5)) * 3072 + 2048 + h * 128 + (tid & 31) * 4;
                        unsigned rqr[4], rfr[4]; u32x2 rir;
#define HG_LOAD(blk_) do { const bf16_t* p_ = pq + (size_t)(blk_) * 16 * 3072; \
                            _Pragma("unroll") for (int j = 0; j < 4; ++j) { rqr[j] = p_[(size_t)j * 3072]; rfr[j] = p_[(size_t)j * 3072 + 512]; } \
                            rir = *(const u32x2*)(pi + (size_t)(blk_) * 16 * 3072); } while (0)
#define HG_ELEM(buf_) do { LAS bf16_t* QT_ = (LAS bf16_t*)(lds + (buf_) * HB); LAS bf16_t* KT_ = QT_ + 2176; LAS bf16_t* KB_ = QT_ + 4352; LAS bf16_t* IV_ = QT_ + 6528; LAS float* EL_ = (LAS float*)(lds + (buf_) * HB + 17408); \
                            float cj[4], fk[4], qv[4]; float c_ = 0.f; \
                            _Pragma("unroll") for (int j = 0; j < 4; ++j) { const float fp = __uint_as_float(rfr[j] << 16); const float f = lbv + (1.0f - lbv) * sigmoidf_(fp); c_ += __logf(f); cj[j] = c_; fk[j] = 1.0f - f; qv[j] = __uint_as_float(rqr[j] << 16); } \
                            const float T0 = dppf<0x00>(c_), T1 = dppf<0x55>(c_), T2 = dppf<0xAA>(c_), T3 = dppf<0xFF>(c_); \
                            const float P_ = (tq > 0 ? T0 : 0.f) + (tq > 1 ? T1 : 0.f) + (tq > 2 ? T2 : 0.f); \
                            const float ELv = __expf(fmaxf((T0 + T1) + (T2 + T3), -80.f)); \
                            _Pragma("unroll") for (int j = 0; j < 4; ++j) { const float Bv = fmaxf(P_ + cj[j], -80.f); const float E = __expf(Bv), Ei = __expf(-Bv); const float kt_ = fk[j] * Ei; const int t_ = 4 * tq + j; \
                                QT_[t_ * 136 + kch] = (bf16_t)(pk_bf16(qv[j] * E, 0.f) & 0xffffu); KT_[t_ * 136 + kch] = (bf16_t)(pk_bf16(kt_, 0.f) & 0xffffu); KB_[t_ * 136 + kch] = (bf16_t)(pk_bf16(kt_ * ELv, 0.f) & 0xffffu); } \
                            if (tq == 0) EL_[kch] = ELv; \
                            *(LAS u32x2*)(IV_ + (tid >> 5) * 136 + (tid & 31) * 4) = rir; } while (0)
                        HG_LOAD(0);
                        {
                            LAS float* fL = (LAS float*)(lds + 40960); LAS float* qL = fL + 2048; LAS float* iL = fL + 4096; LAS float* SD = (LAS float*)(lds + 65536);
#pragma unroll
                            for (int j = 0; j < 4; ++j) { const float fp = __uint_as_float(rfr[j] << 16); fL[(4 * tq + j) * 128 + kch] = lbv + (1.0f - lbv) * sigmoidf_(fp); qL[(4 * tq + j) * 128 + kch] = __uint_as_float(rqr[j] << 16); }
                            *(LAS f32x4*)(iL + (tid >> 5) * 128 + (tid & 31) * 4) = (f32x4){bf_lo(rir.x), bf_hi(rir.x), bf_lo(rir.y), bf_hi(rir.y)};
                            asm volatile("s_waitcnt lgkmcnt(0)" ::: "memory"); __builtin_amdgcn_s_barrier(); asm volatile("" ::: "memory");
                            const int kg = lane & 15, vq = wave * 4 + (lane >> 4);
                            float S0[8][4];
#pragma unroll
                            for (int j = 0; j < 8; ++j)
#pragma unroll
                                for (int c = 0; c < 4; ++c) S0[j][c] = 0.f;
#pragma unroll 2
                            for (int t = 0; t < 16; ++t) {
                                const f32x4 fa = *(const LAS f32x4*)(fL + t * 128 + kg * 8), fb = *(const LAS f32x4*)(fL + t * 128 + kg * 8 + 4);
                                const f32x4 qa = *(const LAS f32x4*)(qL + t * 128 + kg * 8), qb = *(const LAS f32x4*)(qL + t * 128 + kg * 8 + 4);
                                const f32x4 iv = *(const LAS f32x4*)(iL + t * 128 + vq * 4);
                                float a[4] = {0.f, 0.f, 0.f, 0.f};
#pragma unroll
                                for (int j = 0; j < 8; ++j) { const float fj = j < 4 ? fa[j] : fb[j - 4], qj = j < 4 ? qa[j] : qb[j - 4];
#pragma unroll
                                    for (int c = 0; c < 4; ++c) { const float d0 = S0[j][c] - iv[c]; S0[j][c] = __builtin_fmaf(fj, d0, iv[c]); a[c] = __builtin_fmaf(qj, S0[j][c], a[c]); } }
#pragma unroll
                                for (int c = 0; c < 4; ++c) a[c] = row16_sum(a[c]);
                                if (kg == 0) { u32x2 wv; wv.x = pk_bf16(a[0], a[1]); wv.y = pk_bf16(a[2], a[3]); *(u32x2*)(mix + ((size_t)b * SEQ + t) * 1024 + 512 + h * 128 + vq * 4) = wv; }
                            }
#pragma unroll
                            for (int j = 0; j < 8; ++j) *(LAS f32x4*)(SD + (kg * 8 + j) * 128 + vq * 4) = (f32x4){S0[j][0], S0[j][1], S0[j][2], S0[j][3]};
                            asm volatile("s_waitcnt lgkmcnt(0)" ::: "memory"); __builtin_amdgcn_s_barrier(); asm volatile("" ::: "memory");
#pragma unroll
                            for (int kt = 0; kt < 8; ++kt)
#pragma unroll
                                for (int i = 0; i < 4; ++i) Sacc[kt][i] = SD[(16 * kt + 4 * fq + i) * 128 + 16 * wave + fr];
                        }
                        HG_LOAD(1); HG_ELEM(1); HG_LOAD(2);
                        asm volatile("s_waitcnt lgkmcnt(0)" ::: "memory"); __builtin_amdgcn_s_barrier(); asm volatile("" ::: "memory");
                        for (int blk = 1; blk < 256; ++blk) {
                            const int cur = blk & 1;
                            if (wave < 4 && blk + 1 < 256) { HG_ELEM(cur ^ 1); if (blk + 2 < 256) HG_LOAD(blk + 2); }
                            const LAS bf16_t* QT = (const LAS bf16_t*)(lds + cur * HB); const LAS bf16_t* KT = QT + 2176; const LAS bf16_t* KB = QT + 4352; const LAS bf16_t* IV = QT + 6528; const LAS float* EL = (const LAS float*)(lds + cur * HB + 17408);
                            const v4i16_t itv = __builtin_amdgcn_ds_read_tr16_b64_v4i16((LAS v4i16_t*)(IV + (4 * fq + tr_r) * 136 + 16 * wave + 4 * tr_c));
                            bf16x8 AX[4], AY[4]; u32x2 QY0[4], QY1[4]; f32x4 ELv4[8]; v4i16_t KX[8];
#pragma unroll
                            for (int ks = 0; ks < 4; ++ks) { AX[ks] = *(const LAS bf16x8*)(KT + fr * 136 + ks * 32 + fq * 8); AY[ks] = *(const LAS bf16x8*)(QT + fr * 136 + ks * 32 + fq * 8); }
#pragma unroll
                            for (int p = 0; p < 4; ++p) { QY0[p] = *(const LAS u32x2*)(QT + fr * 136 + 32 * p + 4 * fq); QY1[p] = *(const LAS u32x2*)(QT + fr * 136 + 32 * p + 16 + 4 * fq); }
#pragma unroll
                            for (int kt = 0; kt < 8; ++kt) { ELv4[kt] = *(const LAS f32x4*)(EL + 16 * kt + 4 * fq); KX[kt] = __builtin_amdgcn_ds_read_tr16_b64_v4i16((LAS v4i16_t*)(KB + (4 * fq + tr_r) * 136 + kt * 16 + 4 * tr_c)); }
                            __builtin_amdgcn_sched_barrier(0);
                            const bf16x8 IT = (bf16x8){itv[0], itv[1], itv[2], itv[3], 0, 0, 0, 0};
                            f32x4 A = (f32x4){0.f, 0.f, 0.f, 0.f};
#pragma unroll
                            for (int ks = 0; ks < 4; ++ks) A = __builtin_amdgcn_mfma_f32_16x16x32_bf16(AX[ks], AY[ks], A, 0, 0, 0);
#pragma unroll
                            for (int i = 0; i < 4; ++i) A[i] = (4 * fq + i > fr) ? 0.f : A[i];
                            const u32x4 apk = (u32x4){pk_bf16(A[0], A[1]), pk_bf16(A[2], A[3]), 0u, 0u};
                            f32x4 o = __builtin_amdgcn_mfma_f32_16x16x32_bf16(IT, __builtin_bit_cast(bf16x8, apk), (f32x4){0.f, 0.f, 0.f, 0.f}, 0, 0, 0);
#pragma unroll
                            for (int p = 0; p < 4; ++p) {
                                const u32x4 sx = (u32x4){pk_bf16(Sacc[2 * p][0], Sacc[2 * p][1]), pk_bf16(Sacc[2 * p][2], Sacc[2 * p][3]), pk_bf16(Sacc[2 * p + 1][0], Sacc[2 * p + 1][1]), pk_bf16(Sacc[2 * p + 1][2], Sacc[2 * p + 1][3])};
                                const u32x4 yy = (u32x4){QY0[p].x, QY0[p].y, QY1[p].x, QY1[p].y};
                                o = __builtin_amdgcn_mfma_f32_16x16x32_bf16(__builtin_bit_cast(bf16x8, sx), __builtin_bit_cast(bf16x8, yy), o, 0, 0, 0);
                            }
                            { u32x2 wv; wv.x = pk_bf16(o[0], o[1]); wv.y = pk_bf16(o[2], o[3]);
                              *(u32x2*)(mix + ((size_t)b * SEQ + blk * 16 + fr) * 1024 + 512 + h * 128 + 16 * wave + 4 * fq) = wv; }
#pragma unroll
                            for (int kt = 0; kt < 8; ++kt) {
                                const bf16x8 X = (bf16x8){KX[kt][0], KX[kt][1], KX[kt][2], KX[kt][3], 0, 0, 0, 0};
                                Sacc[kt] = __builtin_amdgcn_mfma_f32_16x16x32_bf16(X, IT, Sacc[kt] * ELv4[kt], 0, 0, 0);
                            }
                            if (wave >= 4 && blk + 1 < 256) { HG_ELEM(cur ^ 1); if (blk + 2 < 256) HG_LOAD(blk + 2); }
                            asm volatile("s_waitcnt lgkmcnt(0)" ::: "memory"); __builtin_amdgcn_s_barrier(); asm volatile("" ::: "memory");
                        }
#undef HG_LOAD
#undef HG_ELEM
                    }
                }
#endif
#if !defined(NO_CONV)
                {
                    LAS unsigned* hL32 = (LAS unsigned*)lds; LAS float* yL = (LAS float*)(lds + 65536);
                    const float* cw = ap->in[4] + (size_t)eo * 31 * 512; const float* cb = ap->in[5] + eo * 512;
                    const float* lng = ap->in[6] + eo * 512; const float* lnb = ap->in[7] + eo * 512;
                    const int cp = tid & 255, th = tid >> 8;
                    const bool split_ = (G >= 128);
                    for (int item = split_ ? vcu - 64 : vcu; item < 2048; item += split_ ? G - 64 : G) {
                        if (item < 0) break;
                        const int ritem = 2047 - item;
                        const int b = ritem >> 7, t0 = (ritem & 127) * 32;
                        {
                            u32x4 av[8], gv[8];
#pragma unroll
                            for (int q = 0; q < 8; ++q) {
                                const int idx = tid + 512 * q, r = idx >> 6, c8 = idx & 63, t = t0 - 30 + r;
                                av[q] = (u32x4){0u, 0u, 0u, 0u}; gv[q] = av[q];
                                if (idx < 62 * 64 && t >= 0) { const bf16_t* pr = pbuf + ((size_t)b * SEQ + t) * 3072 + c8 * 8; av[q] = *(const u32x4*)pr; gv[q] = *(const u32x4*)(pr + 512); }
                            }
#pragma unroll
                            for (int q = 0; q < 8; ++q) {
                                const int idx = tid + 512 * q, r = idx >> 6, c8 = idx & 63;
                                float a[8], g8[8]; unpack8(av[q], a); unpack8(gv[q], g8);
#pragma unroll
                                for (int i = 0; i < 8; ++i) a[i] *= sigmoidf_(g8[i]);
                                if (idx < 62 * 64) *(LAS u32x4*)(hL32 + r * 256 + c8 * 4) = pack8(a);
                            }
                        }
                        __syncthreads();
#pragma unroll 1
                        for (int sb = 0; sb < 2; ++sb) {
                            float y0[8], y1[8];
                            const float b0 = cb[2 * cp], b1 = cb[2 * cp + 1];
#pragma unroll
                            for (int t = 0; t < 8; ++t) { y0[t] = b0; y1[t] = b1; }
                            unsigned in[38];
#pragma unroll
                            for (int r = 0; r < 38; ++r) in[r] = hL32[(th * 16 + sb * 8 + r) * 256 + cp];
#pragma unroll
                            for (int j = 0; j < 31; ++j) {
                                const f32x2 wj = *(const f32x2*)(cw + j * 512 + 2 * cp);
#pragma unroll
                                for (int t = 0; t < 8; ++t) { y0[t] = __builtin_fmaf(wj.x, bf_lo(in[t + j]), y0[t]); y1[t] = __builtin_fmaf(wj.y, bf_hi(in[t + j]), y1[t]); }
                            }
#pragma unroll
                            for (int t = 0; t < 8; ++t) *(LAS f32x2*)(yL + (th * 16 + sb * 8 + t) * 512 + 2 * cp) = (f32x2){y0[t], y1[t]};
                        }
                        __syncthreads();
                        u32x4 lnres[4];
#pragma unroll
                        for (int q = 0; q < 4; ++q) {
                            const int tok = wave * 4 + q;
                            const f32x4 v0 = *(const LAS f32x4*)(yL + tok * 512 + lane * 8), v1 = *(const LAS f32x4*)(yL + tok * 512 + lane * 8 + 4);
                            float sm = (v0[0] + v0[1]) + (v0[2] + v0[3]) + (v1[0] + v1[1]) + (v1[2] + v1[3]);
                            sm = wave_sum(sm); const float mu = sm * (1.0f / 512.0f);
                            float f[8] = {v0[0] - mu, v0[1] - mu, v0[2] - mu, v0[3] - mu, v1[0] - mu, v1[1] - mu, v1[2] - mu, v1[3] - mu};
                            float sq = 0.f;
#pragma unroll
                            for (int i = 0; i < 8; ++i) sq += f[i] * f[i];
                            sq = wave_sum(sq); const float rstd = rsqrtf(sq * (1.0f / 512.0f) + EPSF);
#pragma unroll
                            for (int i = 0; i < 8; ++i) { const float yv = f[i] * rstd * lng[lane * 8 + i] + lnb[lane * 8 + i]; f[i] = yv * sigmoidf_(yv); }
                            lnres[q] = pack8(f);
                        }
#pragma unroll
                        for (int q = 0; q < 4; ++q) *(u32x4*)(mix + ((size_t)b * SEQ + t0 + wave * 4 + q) * 1024 + lane * 8) = lnres[q];
                        __syncthreads();
                    }
                    if (split_ && vcu >= 64) {
                        LAS float* scr = (LAS float*)(lds + wave * 16384);
                        const int gw2 = (vcu - 64) * 8 + wave, NGW2 = (G - 64) * 8;
                        if (l == 0) { transpose_layer(ap, ws, 1, scr, gw2, NGW2, lane); transpose_layer(ap, ws, 2, scr, gw2, NGW2, lane); }
                        else transpose_layer(ap, ws, 3, scr, gw2, NGW2, lane);
                    }
                }
#endif
            } else if (s == 2 && !odd) {
                const int gw = vcu * 8 + wave, NGW = G * 8;
                const float* og = ap->in[9] + eo * 128;
                float ogr[8];
#pragma unroll
                for (int i = 0; i < 8; ++i) ogr[i] = og[(lane & 15) * 8 + i];
                for (int m0 = gw * 4; m0 < NTOK; m0 += NGW * 4) {
                    u32x4 ov[4], gv[4];
#pragma unroll
                    for (int q = 0; q < 4; ++q) { ov[q] = *(const u32x4*)(mix + (size_t)(m0 + q) * 1024 + 512 + lane * 8); gv[q] = *(const u32x4*)(pbuf + (size_t)(m0 + q) * 3072 + 2560 + lane * 8); }
#pragma unroll
                    for (int q = 0; q < 4; ++q) {
                        float o[8], g8[8]; unpack8(ov[q], o); unpack8(gv[q], g8);
                        float ss = 0.f;
#pragma unroll
                        for (int i = 0; i < 8; ++i) ss += o[i] * o[i];
                        ss = row16_sum(ss);
                        const float rs = rsqrtf(ss * (1.0f / 128.0f) + EPSF);
                        const int c0 = (lane & 15) * 8;
#pragma unroll
                        for (int i = 0; i < 8; ++i) o[i] = o[i] * rs * ogr[i] * (g8[i] * sigmoidf_(g8[i]));
                        *(u32x4*)(mix + (size_t)(m0 + q) * 1024 + 512 + lane * 8) = pack8(o);
                    }
                }
            } else if (s == 1 && odd) {
#if !defined(NO_SGU)
                {
                    LAS bf16_t* VN = (LAS bf16_t*)lds;
                    const float* lng = ap->in[12] + eo * 512; const float* lnb = ap->in[13] + eo * 512;
                    const int wr = wave >> 2, wc = wave & 3, fr = lane & 15, fq = lane >> 4, tr_r = (lane & 15) >> 2, tr_c = lane & 3;
                    LAS float* LNP = (LAS float*)(lds + 133120);
                    if (tid < 128) *(LAS f32x4*)(LNP + tid * 4) = *(const f32x4*)(lng + tid * 4); else if (tid < 256) *(LAS f32x4*)(LNP + 512 + (tid - 128) * 4) = *(const f32x4*)(lnb + (tid - 128) * 4);
                    __syncthreads();
                    for (int item = vcu; item < 512; item += G) {
                        const int ritem = 511 - item;
                        const int b = ritem >> 5, n = ritem & 31;
                        const size_t row0 = (size_t)b * SEQ + n * 128;
                        const int sT = tid >> 2, qd = tid & 3;
                        {
                            const bf16_t* pr = pbuf + (row0 + sT) * 3328 + 512 + qd * 128;
                            float sm = 0.f, sq = 0.f;
#pragma unroll 4
                            for (int i = 0; i < 16; ++i) { const u32x4 rawv = *(const u32x4*)(pr + i * 8); float f[8]; unpack8(rawv, f);
#pragma unroll
                                for (int j = 0; j < 8; ++j) { sm += f[j]; sq += f[j] * f[j]; } }
                            sm += __shfl_xor(sm, 1); sm += __shfl_xor(sm, 2); sq += __shfl_xor(sq, 1); sq += __shfl_xor(sq, 2);
                            const float mu = sm * (1.0f / 512.0f); const float var = fmaxf(sq * (1.0f / 512.0f) - mu * mu, 0.f); const float rstd = rsqrtf(var + EPSF);
#pragma unroll 1
                            for (int i0 = 0; i0 < 16; i0 += 8) {
                                u32x4 rawb[8];
#pragma unroll
                                for (int i = 0; i < 8; ++i) rawb[i] = *(const u32x4*)(pr + (i0 + i) * 8);
#pragma unroll
                                for (int i = 0; i < 8; ++i) { float f[8]; unpack8(rawb[i], f);
                                    const LAS float* gp = LNP + qd * 128 + (i0 + i) * 8;
                                    const f32x4 g0 = *(const LAS f32x4*)gp, g1 = *(const LAS f32x4*)(gp + 4), b0 = *(const LAS f32x4*)(gp + 512), b1 = *(const LAS f32x4*)(gp + 516);
#pragma unroll
                                    for (int j = 0; j < 4; ++j) { f[j] = (f[j] - mu) * rstd * g0[j] + b0[j]; f[4 + j] = (f[4 + j] - mu) * rstd * g1[j] + b1[j]; }
                                    *(LAS u32x4*)(VN + sT * 520 + qd * 128 + (i0 + i) * 8) = pack8(f); }
                            }
                        }
                        asm volatile("s_waitcnt lgkmcnt(0)" ::: "memory"); __builtin_amdgcn_s_barrier(); asm volatile("" ::: "memory");
#pragma unroll 1
                        for (int gI = 0; gI < 4; ++gI) {
                            const float* wg = ap->in[14] + ((size_t)eo * 4 + gI) * 128 * 128; const float* bsg = ap->in[15] + (eo * 4 + gI) * 128;
                            f32x4 acc[4][2];
#pragma unroll
                            for (int m = 0; m < 4; ++m) { acc[m][0] = (f32x4){0.f, 0.f, 0.f, 0.f}; acc[m][1] = (f32x4){0.f, 0.f, 0.f, 0.f}; }
#pragma unroll
                            for (int k0 = 0; k0 < 128; k0 += 32) {
                                if (k0 <= wr * 64 + 63) {
                                    f32x4 wv[4][2];
#pragma unroll
                                    for (int m = 0; m < 4; ++m) { wv[m][0] = (f32x4){0.f, 0.f, 0.f, 0.f}; wv[m][1] = wv[m][0];
                                        if (k0 <= wr * 64 + m * 16 + 15) { const int t = wr * 64 + m * 16 + fr, s0 = k0 + fq * 8; wv[m][0] = *(const f32x4*)(wg + t * 128 + s0); wv[m][1] = *(const f32x4*)(wg + t * 128 + s0 + 4); } }
                                    asm volatile("" ::: "memory");
                                    bf16x8 X[2];
#pragma unroll
                                    for (int nn = 0; nn < 2; ++nn) {
                                        const LAS bf16_t* vp = VN + (k0 + fq * 8 + tr_r) * 520 + gI * 128 + wc * 32 + nn * 16 + 4 * tr_c;
                                        const v4i16_t lo = __builtin_amdgcn_ds_read_tr16_b64_v4i16((LAS v4i16_t*)vp), hi = __builtin_amdgcn_ds_read_tr16_b64_v4i16((LAS v4i16_t*)(vp + 4 * 520));
                                        X[nn] = (bf16x8){lo[0], lo[1], lo[2], lo[3], hi[0], hi[1], hi[2], hi[3]};
                                    }
#pragma unroll
                                    for (int m = 0; m < 4; ++m) {
                                        if (k0 <= wr * 64 + m * 16 + 15) {
                                            const int t = wr * 64 + m * 16 + fr, s0 = k0 + fq * 8;
                                            const f32x4 w0 = wv[m][0], w1 = wv[m][1];
                                            float wf[8] = {w0[0], w0[1], w0[2], w0[3], w1[0], w1[1], w1[2], w1[3]};
#pragma unroll
                                            for (int i = 0; i < 8; ++i) wf[i] = (s0 + i <= t) ? wf[i] : 0.f;
                                            const u32x4 yp = pack8(wf); const bf16x8 Y = __builtin_bit_cast(bf16x8, yp);
                                            acc[m][0] = __builtin_amdgcn_mfma_f32_16x16x32_bf16(X[0], Y, acc[m][0], 0, 0, 0);
                                            acc[m][1] = __builtin_amdgcn_mfma_f32_16x16x32_bf16(X[1], Y, acc[m][1], 0, 0, 0);
                                        }
                                    }
                                }
                            }
                            u32x2 uva[4][2]; float bia[4];
#pragma unroll
                            for (int m = 0; m < 4; ++m) { const int t = wr * 64 + m * 16 + fr; bia[m] = bsg[t];
#pragma unroll
                                for (int nn = 0; nn < 2; ++nn) uva[m][nn] = *(const u32x2*)(pbuf + (row0 + t) * 3328 + gI * 128 + wc * 32 + nn * 16 + 4 * fq); }
                            asm volatile("" ::: "memory");
#pragma unroll
                            for (int m = 0; m < 4; ++m) {
                                const int t = wr * 64 + m * 16 + fr; const float bias = bia[m];
#pragma unroll
                                for (int nn = 0; nn < 2; ++nn) {
                                    const int c0 = wc * 32 + nn * 16 + 4 * fq;
                                    const u32x2 uv = uva[m][nn];
                                    const float o0 = bf_lo(uv.x) * (acc[m][nn][0] + bias), o1 = bf_hi(uv.x) * (acc[m][nn][1] + bias), o2 = bf_lo(uv.y) * (acc[m][nn][2] + bias), o3 = bf_hi(uv.y) * (acc[m][nn][3] + bias);
                                    u32x2 w; w.x = pk_bf16(o0, o1); w.y = pk_bf16(o2, o3);
                                    *(u32x2*)(mix + (row0 + t) * 1280 + gI * 128 + c0) = w;
                                }
                            }
                        }
                        asm volatile("s_waitcnt lgkmcnt(0)" ::: "memory"); __builtin_amdgcn_s_barrier(); asm volatile("" ::: "memory");
                    }
                }
#endif
#if !defined(NO_ATTN)
                {
                    LAS bf16_t* QL = (LAS bf16_t*)lds; LAS bf16_t* KL = (LAS bf16_t*)(lds + 18432); LAS bf16_t* VL = (LAS bf16_t*)(lds + 55296);
                    const int fr = lane & 15, fq = lane >> 4, tr_r = (lane & 15) >> 2, tr_c = lane & 3;
                    float gq16[16], gk16[16];
#pragma unroll
                    for (int i = 0; i < 16; ++i) { gq16[i] = ap->in[16][eo * 64 + (tid & 3) * 16 + i] * 0.125f; gk16[i] = ap->in[17][eo * 64 + (tid & 3) * 16 + i]; }
                    u32x4 rq[3][2], rv[4];
#pragma unroll
                    for (int i_ = 0; i_ < 3; ++i_) { rq[i_][0] = (u32x4){0u, 0u, 0u, 0u}; rq[i_][1] = (u32x4){0u, 0u, 0u, 0u}; }
#pragma unroll
                    for (int i_ = 0; i_ < 4; ++i_) rv[i_] = (u32x4){0u, 0u, 0u, 0u};
#define ATT_DECODE(it) const int rit_ = 6143 - (it); const int bj_ = rit_ / 96, q96_ = rit_ % 96, b = bj_ >> 2, j = bj_ & 3, cfg = q96_ >> 5, qq_ = q96_ & 31; \
                        const int sh = cfg * 2, r = (cfg == 0) ? 0 : (cfg == 1 ? (qq_ >> 3) : (qq_ >> 1)), n = (cfg == 0) ? qq_ : (cfg == 1 ? (qq_ & 7) : (qq_ & 1)); \
                        const int hd = cfg * 4 + j; const size_t rowb = (size_t)b * SEQ; (void)hd; (void)rowb; (void)n; (void)r; (void)sh;
#define ATT_LOAD(it) do { ATT_DECODE(it) \
                        _Pragma("unroll") for (int r3 = 0; r3 < 3; ++r3) { const int idx = tid + 512 * r3, rowi = idx >> 2, part = idx & 3; const bool isq = rowi < 128; \
                            const int sub = isq ? (n * 128 + rowi) : ((n - 1) * 128 + (rowi - 128)); const bool valid = sub >= 0; const int tok = valid ? ((sub << sh) + r) : 0; \
                            const bf16_t* src = pbuf + (rowb + tok) * 3328 + (isq ? 1024 : 1792) + hd * 64 + part * 16; \
                            rq[r3][0] = (u32x4){0u, 0u, 0u, 0u}; rq[r3][1] = rq[r3][0]; if (valid) { rq[r3][0] = *(const u32x4*)src; rq[r3][1] = *(const u32x4*)(src + 8); } } \
                        _Pragma("unroll") for (int r4 = 0; r4 < 4; ++r4) { const int idx = tid + 512 * r4, ks = idx >> 3, c8 = idx & 7; const int sub = (n - 1) * 128 + ks; \
                            rv[r4] = (u32x4){0u, 0u, 0u, 0u}; if (sub >= 0) rv[r4] = *(const u32x4*)(pbuf + (rowb + ((sub << sh) + r)) * 3328 + 2560 + hd * 64 + c8 * 8); } } while (0)
                    if (vcu < 6144) ATT_LOAD(vcu);
                    for (int item = vcu; item < 6144; item += G) {
                        ATT_DECODE(item)
#pragma unroll
                        for (int r3 = 0; r3 < 3; ++r3) {
                            const int idx = tid + 512 * r3, rowi = idx >> 2, part = idx & 3;
                            const bool isq = rowi < 128;
                            const int sub = isq ? (n * 128 + rowi) : ((n - 1) * 128 + (rowi - 128));
                            const int tok = (sub >= 0) ? ((sub << sh) + r) : 0;
                            float f[16]; unpack8(rq[r3][0], f); unpack8(rq[r3][1], f + 8);
                            float ss = 0.f;
#pragma unroll
                            for (int i = 0; i < 16; ++i) ss += f[i] * f[i];
                            ss += __shfl_xor(ss, 1); ss += __shfl_xor(ss, 2);
                            const float rs = rsqrtf(ss * (1.0f / 64.0f) + EPSF);
#pragma unroll
                            for (int i = 0; i < 16; ++i) f[i] = f[i] * rs * (r3 == 0 ? gq16[i] : gk16[i]);
                            if (part == 0) {
                                const float tf = (float)tok;
                                const float crev[8] = {0.15915494309189535f, 0.03086376340470123f, 0.005985185712713705f, 0.001160663641240061f, 0.00022507907903927653f, 4.364795279280289e-05f, 8.464330808241401e-06f, 1.6414262627950345e-06f};
#pragma unroll
                                for (int i = 0; i < 8; ++i) { const float rev = __builtin_amdgcn_fractf(tf * crev[i]); const float c = __builtin_amdgcn_cosf(rev), sn = __builtin_amdgcn_sinf(rev), x1 = f[i], x2 = f[8 + i]; f[i] = x1 * c - x2 * sn; f[8 + i] = x2 * c + x1 * sn; }
                            }
                            LAS bf16_t* dst = isq ? (QL + rowi * 72 + part * 16) : (KL + (rowi - 128) * 72 + part * 16);
                            *(LAS u32x4*)dst = pack8(f); *(LAS u32x4*)(dst + 8) = pack8(f + 8);
                        }
#pragma unroll
                        for (int r4 = 0; r4 < 4; ++r4) { const int idx = tid + 512 * r4, ks = idx >> 3, c8 = idx & 7; *(LAS u32x4*)(VL + ks * 72 + c8 * 8) = rv[r4]; }
                        if (item + G < 6144) ATT_LOAD(item + G);
                        asm volatile("s_waitcnt lgkmcnt(0)" ::: "memory"); __builtin_amdgcn_s_barrier(); asm volatile("" ::: "memory");
                        {
                            const int w = wave, qi = w * 16 + fr;
                            const bf16x8 Y0 = *(const LAS bf16x8*)(QL + qi * 72 + fq * 8), Y1 = *(const LAS bf16x8*)(QL + qi * 72 + 32 + fq * 8);
                            f32x4 sc[10];
                            {
                                bf16x8 KX0[9], KX1[9];
#pragma unroll
                                for (int jt = 0; jt < 9; ++jt) { const LAS bf16_t* kp = KL + ((w + jt) * 16 + fr) * 72 + fq * 8; KX0[jt] = *(const LAS bf16x8*)kp; KX1[jt] = *(const LAS bf16x8*)(kp + 32); }
                                __builtin_amdgcn_sched_barrier(0);
#pragma unroll
                                for (int jt = 0; jt < 9; ++jt) {
                                    f32x4 a = (f32x4){0.f, 0.f, 0.f, 0.f};
                                    a = __builtin_amdgcn_mfma_f32_16x16x32_bf16(KX0[jt], Y0, a, 0, 0, 0);
                                    a = __builtin_amdgcn_mfma_f32_16x16x32_bf16(KX1[jt], Y1, a, 0, 0, 0);
                                    sc[jt] = a;
                                }
                            }
                            float mx = -INFINITY;
#pragma unroll
                            for (int jt = 0; jt < 9; ++jt)
#pragma unroll
                                for (int i = 0; i < 4; ++i) {
                                    const int c = 4 * fq + i;
                                    bool ok = (n > 0) || (w + jt >= 8);
                                    if (jt == 0) ok = ok && (fr <= c);
                                    if (jt == 8) ok = ok && (fr >= c);
                                    const float v = ok ? sc[jt][i] : -INFINITY; sc[jt][i] = v; mx = fmaxf(mx, v);
                                }
                            mx = fmaxf(mx, __shfl_xor(mx, 16)); mx = fmaxf(mx, __shfl_xor(mx, 32));
                            float den = 0.f;
#pragma unroll
                            for (int jt = 0; jt < 9; ++jt)
#pragma unroll
                                for (int i = 0; i < 4; ++i) { const float e = __expf(sc[jt][i] - mx); sc[jt][i] = e; den += e; }
                            sc[9] = (f32x4){0.f, 0.f, 0.f, 0.f};
                            den += __shfl_xor(den, 16); den += __shfl_xor(den, 32);
                            f32x4 oa[4];
#pragma unroll
                            for (int et = 0; et < 4; ++et) oa[et] = (f32x4){0.f, 0.f, 0.f, 0.f};
                            v4i16_t VLO[5][4], VHI[5][4];
#pragma unroll
                            for (int jj = 0; jj < 5; ++jj) {
                                const int t0r = (w + 2 * jj) * 16, t1r = (jj < 4) ? (w + 2 * jj + 1) * 16 : t0r;
#pragma unroll
                                for (int et = 0; et < 4; ++et) {
                                    VLO[jj][et] = __builtin_amdgcn_ds_read_tr16_b64_v4i16((LAS v4i16_t*)(VL + (t0r + 4 * fq + tr_r) * 72 + et * 16 + 4 * tr_c));
                                    VHI[jj][et] = __builtin_amdgcn_ds_read_tr16_b64_v4i16((LAS v4i16_t*)(VL + (t1r + 4 * fq + tr_r) * 72 + et * 16 + 4 * tr_c));
                                }
                            }
                            __builtin_amdgcn_sched_barrier(0);
#pragma unroll
                            for (int jj = 0; jj < 5; ++jj) {
                                u32x4 pp; pp.x = pk_bf16(sc[2 * jj][0], sc[2 * jj][1]); pp.y = pk_bf16(sc[2 * jj][2], sc[2 * jj][3]); pp.z = pk_bf16(sc[2 * jj + 1][0], sc[2 * jj + 1][1]); pp.w = pk_bf16(sc[2 * jj + 1][2], sc[2 * jj + 1][3]);
                                const bf16x8 Pf = __builtin_bit_cast(bf16x8, pp);
#pragma unroll
                                for (int et = 0; et < 4; ++et) {
                                    const v4i16_t lo = VLO[jj][et], hi = VHI[jj][et];
                                    const bf16x8 xv = (bf16x8){lo[0], lo[1], lo[2], lo[3], hi[0], hi[1], hi[2], hi[3]};
                                    oa[et] = __builtin_amdgcn_mfma_f32_16x16x32_bf16(xv, Pf, oa[et], 0, 0, 0);
                                }
                            }
                            const float inv = 1.0f / den;
                            const int tokq = ((n * 128 + qi) << sh) + r;
                            bf16_t* op = mix + (rowb + tokq) * 1280 + 512 + hd * 64 + 4 * fq;
#pragma unroll
                            for (int et = 0; et < 4; ++et) { u32x2 wv; wv.x = pk_bf16(oa[et][0] * inv, oa[et][1] * inv); wv.y = pk_bf16(oa[et][2] * inv, oa[et][3] * inv); *(u32x2*)(op + et * 16) = wv; }
                            if (fq == 0) lse[(rowb + tokq) * 12 + hd] = mx + __logf(den);
                        }
                        asm volatile("s_waitcnt lgkmcnt(0)" ::: "memory"); __builtin_amdgcn_s_barrier(); asm volatile("" ::: "memory");
                    }
#undef ATT_LOAD
#undef ATT_DECODE
                }
#endif
            } else if (s == 2 && odd) {
                const int gw = vcu * 8 + wave, NGW = G * 8;
                for (int m0 = gw * 2; m0 < NTOK; m0 += NGW * 2) {
                    u32x4 v[2][2]; float al[2][2];
#pragma unroll
                    for (int q = 0; q < 2; ++q)
#pragma unroll
                        for (int c2 = 0; c2 < 2; ++c2) {
                            const int ch = lane + 64 * c2; v[q][c2] = (u32x4){0u, 0u, 0u, 0u}; al[q][c2] = 0.f;
                            if (ch < 96) {
                                const size_t m = (size_t)(m0 + q);
                                const int hd = ch >> 3, cfg = hd >> 2, j = hd & 3;
                                const float l0 = lse[m * 12 + j], l1 = lse[m * 12 + 4 + j], l2 = lse[m * 12 + 8 + j];
                                v[q][c2] = *(const u32x4*)(mix + m * 1280 + 512 + ch * 8);
                                const float mxl = fmaxf(l0, fmaxf(l1, l2));
                                const float e0 = __expf(l0 - mxl), e1 = __expf(l1 - mxl), e2 = __expf(l2 - mxl);
                                al[q][c2] = ((cfg == 0) ? e0 : (cfg == 1 ? e1 : e2)) / (e0 + e1 + e2);
                            }
                        }
#pragma unroll
                    for (int q = 0; q < 2; ++q)
#pragma unroll
                        for (int c2 = 0; c2 < 2; ++c2) {
                            const int ch = lane + 64 * c2;
                            if (ch < 96) { float f[8]; unpack8(v[q][c2], f);
#pragma unroll
                                for (int i = 0; i < 8; ++i) f[i] *= al[q][c2];
                                *(u32x4*)(mix + (size_t)(m0 + q) * 1280 + 512 + ch * 8) = pack8(f); }
                        }
                }
            } else if (s == 3) {
                const bf16_t* wt = odd ? (const bf16_t*)(ws + WS_ODWOUT) + (size_t)eo * 1024 * 1280 : (const bf16_t*)(ws + WS_EVWOUT) + (size_t)eo * 1024 * 1024;
                pg8::Gemm g{mix, wt, MW, MW, MW, 256, 4, 1, 1, 0, 0, 0, 0, 0};
                pg8::EpiR E{nullptr, xb, sx_xat, 0};
                pg8::gemm_phase<pg8::EpiR>(lds, tid, g, G, bx, E);
            } else if (s == 4) {
                pg8::Gemm g{xb, (const bf16_t*)(ws + WS_WQ) + (size_t)l * 1024 * 1024, 1024, 1024, 1024, 256, 4, 1, 1, 0, 0, 0, 0, 0};
                pg8::EpiP E{(bf16_t*)(ws + WS_QX), 1024, NTOK, sx_xat, 1.0f / (1024.0f * SC_SS), 0, qst, 4, 1, 0};
                pg8::gemm_phase<pg8::EpiP>(lds, tid, g, G, bx, E);
            } else if (s == 5) {
                pg8::Gemm g{(const bf16_t*)(ws + WS_QX), (const bf16_t*)(ws + WS_KT) + (size_t)l * 4096 * 1024, 1024, 1024, 256, 16, 1, 64, 4, SEQ * 1024, 256, 256 * 1024, 256, 0};
                pg8::EpiS E{(bf16_t*)(ws + WS_PB), qst, (LAS float*)(lds + 131072)};
                pg8::gemm_phase<pg8::EpiS>(lds, tid, g, G, bx, E);
            } else if (s == 7) {
                pg8::Gemm g{(const bf16_t*)(ws + WS_PB), (const bf16_t*)(ws + WS_VP), 1024, 1024, 1024, 16, 4, 16, 1, SEQ * 1024, 0, 1024 * 1024, 0, 0};
                pg8::EpiR E{nullptr, xb, sx_mlp, SEQ};
                pg8::gemm_phase<pg8::EpiR>(lds, tid, g, G, bx, E);
            } else if (s == 8) {
                pg8::Gemm g{xb, (const bf16_t*)(ws + WS_W1) + (size_t)l * 4096 * 1024, 1024, 1024, 1024, 256, 16, 1, 1, 0, 0, 0, 0, 0};
                pg8::EpiP E{(bf16_t*)(ws + WS_HMID), 4096, NTOK, sx_mlp, 1.0f / (1024.0f * SC_SS), 2, nullptr, 0, 1, 0};
                pg8::gemm_phase<pg8::EpiP>(lds, tid, g, G, bx, E);
            } else {
                pg8::Gemm g{(const bf16_t*)(ws + WS_HMID), (const bf16_t*)(ws + WS_W2) + (size_t)l * 1024 * 4096, 4096, 4096, 4096, 256, 4, 1, 1, 0, 0, 0, 0, 1};
                pg8::EpiR E{(l == 3) ? ap->out : nullptr, xb, (l == 3) ? (u64*)(ws + ST_QST) : sx_next, 0};
                pg8::gemm_phase<pg8::EpiR>(lds, tid, g, G, bx, E);
            }
        }
        }
        if (ph + 1 < args.hi) { if (ph == 0) cg::this_grid().sync(); else xcd_barrier((unsigned*)(ws + ST_BAR), xcc, xst); }
    }
}

constexpr int N_PHASES = 43;
extern "C" void kernel_launch(void* const* d_in, const int* in_sizes, int n_in, void* d_out, int out_size, void* d_ws, size_t ws_size, hipStream_t stream) {
    static int grid = 0;
    if (grid == 0) {
        if (n_in != 29 || ws_size < WS_END) { fprintf(stderr, "kernel_launch: need 29 inputs and %zu bytes of workspace; got %d, %zu\n", (size_t)WS_END, n_in, ws_size); grid = -1; return; }
        int dev = 0, cus = 0, per_cu = 0;
        hipGetDevice(&dev); hipDeviceGetAttribute(&cus, hipDeviceAttributeMultiprocessorCount, dev);
        if (hipFuncSetAttribute((const void*)mk_fwd, hipFuncAttributeMaxDynamicSharedMemorySize, LDS_BYTES) != hipSuccess) { fprintf(stderr, "kernel_launch: hipFuncSetAttribute failed\n"); grid = -1; return; }
        if (hipOccupancyMaxActiveBlocksPerMultiprocessor(&per_cu, (const void*)mk_fwd, 512, LDS_BYTES) != hipSuccess || per_cu < 1) per_cu = 1;
        (void)hipGetLastError();
        grid = cus * per_cu;
        fprintf(stderr, "kernel_launch: grid %d (cus %d x %d)\n", grid, cus, per_cu);
    }
    if (grid < 0) return;
    Args a{};
    for (int i = 0; i < 29; ++i) a.in[i] = (const float*)d_in[i];
    a.out = (float*)d_out; a.ws = (unsigned char*)d_ws;
#if MK_MULTI
    for (int ph = 0; ph < N_PHASES; ++ph) { a.lo = ph; a.hi = ph + 1; hipLaunchKernelGGL(mk_fwd, dim3(grid), dim3(512), LDS_BYTES, stream, a); }
#else
    a.lo = 0; a.hi = N_PHASES;
    if (hipMemsetAsync((char*)d_ws + ST_BAR, 0, 16384, stream) != hipSuccess) { fprintf(stderr, "kernel_launch: memset failed\n"); return; }
    void* kargs[] = {&a};
    hipError_t e = hipLaunchCooperativeKernel((const void*)mk_fwd, dim3(grid), dim3(512), kargs, LDS_BYTES, stream);
    if (e != hipSuccess) fprintf(stderr, "cooperative launch failed: %s (grid %d)\n", hipGetErrorString(e), grid);
#endif
}
```

```cpp
#include <hip/hip_runtime.h>
#include <hip/hip_cooperative_groups.h>
#include <cstdio>
#include <cstdint>
namespace cg = cooperative_groups;

#ifndef MK_MULTI
#define MK_MULTI 0
#endif

#define LAS __attribute__((address_space(3)))
typedef unsigned short bf16_t;
typedef short bf16x8 __attribute__((ext_vector_type(8)));
typedef float f32x4 __attribute__((ext_vector_type(4)));
typedef float f32x2 __attribute__((ext_vector_type(2)));
typedef unsigned u32x4 __attribute__((ext_vector_type(4)));
typedef unsigned u32x2 __attribute__((ext_vector_type(2)));
typedef __bf16 bf16x2_t __attribute__((ext_vector_type(2)));
typedef short v4i16_t __attribute__((ext_vector_type(4)));

constexpr int NTOK = 65536, DM = 1024, SEQ = 4096, NBATCH = 16;
constexpr float EPSF = 1e-6f;
constexpr size_t MiB = 1u << 20;
typedef unsigned long long u64;
constexpr float SC_SS = 1048576.0f, SC_L = 16777216.0f;
constexpr size_t ST_SXZ = 0;
constexpr size_t ST_QST = 11 * 512 * 1024;
constexpr size_t ST_LSUM = ST_QST + 8 * MiB;
constexpr size_t ST_KST = ST_LSUM + 8 * MiB;
constexpr size_t ST_ZERO_BYTES = ST_KST + 1 * MiB;
constexpr size_t ST_SX0 = ST_ZERO_BYTES;
constexpr size_t ST_SMEM = ST_SX0 + 512 * 1024;
constexpr size_t ST_BAR = ST_SX0 + 768 * 1024;
constexpr size_t ST_LSE = 24 * MiB;
constexpr size_t ST_ROPE = 27 * MiB;
constexpr size_t WB = 16 * MiB;
constexpr size_t WS_EVWIN = WB + 16 * MiB, WS_ODWIN = WB + 28 * MiB, WS_EVWOUT = WB + 41 * MiB, WS_ODWOUT = WB + 45 * MiB, WS_WQ = WB + 50 * MiB, WS_WKV = WB + 58 * MiB,
                 WS_WO = WB + 74 * MiB, WS_W1 = WB + 82 * MiB, WS_W2 = WB + 114 * MiB, WS_MEMB = WB + 146 * MiB, WS_KT = WB + 154 * MiB, WS_VT = WB + 186 * MiB, WS_XB = WB + 218 * MiB,
                 WS_A = WB + 346 * MiB;
constexpr size_t WS_P = WS_A, WS_MIX = WS_A + 416 * MiB, WS_KVRAW = WS_A, WS_QX = WS_A, WS_PB = WS_A + 128 * MiB, WS_AO = WS_A + 256 * MiB, WS_HMID = WS_A;
constexpr size_t WS_VP = WS_A + 576 * MiB;
constexpr size_t WS_END = WS_VP + 32 * MiB;
constexpr int LDS_BYTES = 147456;

__device__ __forceinline__ unsigned pk_bf16(float lo, float hi) { f32x2 v = {lo, hi}; bf16x2_t b = __builtin_convertvector(v, bf16x2_t); return __builtin_bit_cast(unsigned, b); }
__device__ __forceinline__ float bf_lo(unsigned u) { return __uint_as_float(u << 16); }
__device__ __forceinline__ float bf_hi(unsigned u) { return __uint_as_float(u & 0xffff0000u); }
__device__ __forceinline__ void unpack8(const u32x4 v, float* f) { f[0] = bf_lo(v.x); f[1] = bf_hi(v.x); f[2] = bf_lo(v.y); f[3] = bf_hi(v.y); f[4] = bf_lo(v.z); f[5] = bf_hi(v.z); f[6] = bf_lo(v.w); f[7] = bf_hi(v.w); }
__device__ __forceinline__ u32x4 pack8(const float* f) { u32x4 w; w.x = pk_bf16(f[0], f[1]); w.y = pk_bf16(f[2], f[3]); w.z = pk_bf16(f[4], f[5]); w.w = pk_bf16(f[6], f[7]); return w; }
__device__ __forceinline__ float sigmoidf_(float x) { return __builtin_amdgcn_rcpf(1.0f + __expf(-x)); }
__device__ __forceinline__ float wave_sum(float v) {
#pragma unroll
    for (int o = 1; o < 64; o <<= 1) v += __shfl_xor(v, o);
    return v;
}
template <int CTRL> __device__ __forceinline__ float dppf(float v) { return __int_as_float(__builtin_amdgcn_update_dpp(0, __float_as_int(v), CTRL, 0xf, 0xf, true)); }
__device__ __forceinline__ float row16_sum(float v) { v += dppf<0x128>(v); v += dppf<0x124>(v); v += dppf<0x122>(v); v += dppf<0x121>(v); return v; }
__device__ __forceinline__ f32x2 gelu_pk(f32x2 v) {
    const f32x2 av = __builtin_elementwise_abs(v), d = av * 0.2316418882f + 1.0f;
    f32x2 t; t.x = __builtin_amdgcn_rcpf(d.x); t.y = __builtin_amdgcn_rcpf(d.y);
    f32x2 q = t * 0.5307027145f + (-0.7265760135f); q = q * t + 0.7107068705f; q = q * t + (-0.142248368f); q = q * t + 0.127414796f; q = q * t;
    const f32x2 s = (v * v) * (-0.72134752044f);
    f32x2 e; e.x = __builtin_amdgcn_exp2f(s.x); e.y = __builtin_amdgcn_exp2f(s.y);
    const f32x2 m = v * (q * e), r = v - m;
    f32x2 o; o.x = v.x < 0.f ? m.x : r.x; o.y = v.y < 0.f ? m.y : r.y; return o;
}

namespace pg8 {
constexpr int BM = 256, BK = 64, HALF = 128, HTB = HALF * BK * 2, STAGE_BYTES = 8 * HTB, WGM = 8;
__host__ __device__ __forceinline__ int lds_byte(int r, int c) { const int st = (r >> 4) * 2 + (c >> 5), rr = r & 15, cc = c & 31, ob = rr * 64 + cc * 2; return st * 1024 + (ob ^ (((ob >> 9) & 1) << 5)); }
__host__ __device__ __forceinline__ void stage_rc(int b, int& R, int& C) { const int st = b / 1024, sb = b % 1024, swz = sb ^ (((sb >> 9) & 1) << 5); R = (st >> 1) * 16 + swz / 64; C = (st & 1) * 32 + (swz % 64) / 2; }
__host__ __device__ __forceinline__ int perm32(int rho) { const int n = rho >> 4, i = rho & 15; return 8 * (i >> 2) + 4 * n + (i & 3); }

struct Unit { int pm, pn, z; };
struct Gemm { const bf16_t* A; const bf16_t* Bt; int lda, ldb, K, nM, nN, nZ, ZL; int sAh, sAl, sBh, sBl; int rev; };
struct Order {
    int nM, nN, per, nwg, G, c, rev;
    __device__ __forceinline__ void init(const Gemm& g, int G_, int c_) { nM = g.nM; nN = g.nN; per = nM * nN; nwg = per * g.nZ; G = G_; c = c_; rev = g.rev; }
    __device__ __forceinline__ bool next(int i, Unit& u) const {
        const long L = (long)i * G + c; if (L >= nwg) return false;
        int w = (int)L;
        if ((nwg & 7) == 0) { const int ch = nwg >> 3, off = w >> 3; w = (w & 7) * ch + (rev ? ch - 1 - off : off); }
        u.z = w / per; const int t = w % per;
        const int nig = WGM * nN, gid = t / nig, fm = gid * WGM, gsz = (nM - fm) < WGM ? (nM - fm) : WGM;
        u.pm = fm + ((t % nig) % gsz); u.pn = (t % nig) / gsz; return true;
    }
};
__device__ __forceinline__ const char* a_ptr(const Gemm& g, const Unit& u) { return (const char*)(g.A + ((u.z / g.ZL) * g.sAh + (u.z % g.ZL) * g.sAl + u.pm * BM * g.lda)); }
__device__ __forceinline__ const char* b_ptr(const Gemm& g, const Unit& u) { return (const char*)(g.Bt + ((u.z / g.ZL) * g.sBh + (u.z % g.ZL) * g.sBl + u.pn * BM * g.ldb)); }

struct EpiP {
    static constexpr bool PERM = true;
    bf16_t* O; int ldc; int Mz; const u64* rstat; float rinv; int act; u64* hstat; int hs_ld; int ZLo; int zcol;
    __device__ __forceinline__ void operator()(f32x4 (&acc)[2][2][4][2], const Unit& u, int wr, int wc, int fr, int fq) const {
        const int row0 = u.pm * BM + wr * 64 + fr, col0 = u.pn * BM + wc * 32 + 8 * fq;
        const bool do_gelu = (act == 1) && (u.pn < 4);
        float rsv[8];
#pragma unroll
        for (int q = 0; q < 8; ++q) rsv[q] = 1.f;
        if (rstat) {
            u64 sv[8];
#pragma unroll
            for (int q = 0; q < 8; ++q) sv[q] = rstat[row0 + (q >> 2) * HALF + (q & 3) * 16];
#pragma unroll
            for (int q = 0; q < 8; ++q) rsv[q] = rsqrtf((float)sv[q] * rinv + EPSF);
        }
        asm volatile("" ::: "memory");
#pragma unroll
        for (int ai = 0; ai < 2; ++ai)
#pragma unroll
            for (int m = 0; m < 4; ++m) {
                const int row = row0 + ai * HALF + m * 16;
                const float rs = rsv[ai * 4 + m];
                float hs = 0.f;
                bf16_t* rowp = O + ((long)(u.z / ZLo) * Mz + row) * ldc + (u.z % ZLo) * zcol + col0;
#pragma unroll
                for (int bj = 0; bj < 2; ++bj) {
                    f32x4 v0 = acc[ai][bj][m][0] * rs, v1 = acc[ai][bj][m][1] * rs;
                    if (do_gelu) { f32x2 a = gelu_pk((f32x2){v0[0], v0[1]}), b = gelu_pk((f32x2){v0[2], v0[3]}), c = gelu_pk((f32x2){v1[0], v1[1]}), d = gelu_pk((f32x2){v1[2], v1[3]});
                        v0 = (f32x4){a.x, a.y, b.x, b.y}; v1 = (f32x4){c.x, c.y, d.x, d.y}; }
                    else if (act == 2) {
#pragma unroll
                        for (int i = 0; i < 4; ++i) { const float a = fmaxf(v0[i], 0.f), b = fmaxf(v1[i], 0.f); v0[i] = a * a; v1[i] = b * b; } }
                    hs += (v0[0] * v0[0] + v0[1] * v0[1]) + (v0[2] * v0[2] + v0[3] * v0[3]) + (v1[0] * v1[0] + v1[1] * v1[1]) + (v1[2] * v1[2] + v1[3] * v1[3]);
                    u32x4 w; w.x = pk_bf16(v0[0], v0[1]); w.y = pk_bf16(v0[2], v0[3]); w.z = pk_bf16(v1[0], v1[1]); w.w = pk_bf16(v1[2], v1[3]);
                    *(u32x4*)(rowp + bj * HALF) = w;
                }
                if (hstat) { hs += __shfl_xor(hs, 16); hs += __shfl_xor(hs, 32); if (fq == 0) atomicAdd(hstat + ((long)u.z * Mz + row) * hs_ld + u.pn, (u64)(hs * SC_SS + 0.5f)); }
            }
    }
};
struct EpiS {
    static constexpr bool PERM = true;
    bf16_t* P; const u64* qstat; LAS float* xch;
    __device__ __forceinline__ void operator()(f32x4 (&acc)[2][2][4][2], const Unit& u, int wr, int wc, int fr, int fq) const {
        const int b = u.z >> 2, h = u.z & 3;
        const int row0 = b * SEQ + u.pm * BM + wr * 64 + fr, col0 = h * 256 + wc * 32 + 8 * fq;
        float rsv[8];
        { u64 sv[8];
#pragma unroll
          for (int q = 0; q < 8; ++q) sv[q] = qstat[(long)(row0 + (q >> 2) * HALF + (q & 3) * 16) * 4 + h];
#pragma unroll
          for (int q = 0; q < 8; ++q) rsv[q] = rsqrtf((float)sv[q] * (1.0f / (256.0f * SC_SS)) + EPSF) * 1.4426950408889634f; }
#pragma unroll
        for (int ai = 0; ai < 2; ++ai)
#pragma unroll
            for (int m = 0; m < 4; ++m) {
                const int rl = ai * HALF + wr * 64 + m * 16 + fr;
                const float rs = rsv[ai * 4 + m];
                float sum = 0.f;
#pragma unroll
                for (int bj = 0; bj < 2; ++bj)
#pragma unroll
                    for (int n = 0; n < 2; ++n)
#pragma unroll
                        for (int i = 0; i < 4; ++i) { const float e = __builtin_amdgcn_exp2f(acc[ai][bj][m][n][i] * rs); acc[ai][bj][m][n][i] = e; sum += e; }
                sum += __shfl_xor(sum, 16); sum += __shfl_xor(sum, 32);
                if (fq == 0) xch[rl * 4 + wc] = sum;
            }
        asm volatile("s_waitcnt lgkmcnt(0)" ::: "memory"); __builtin_amdgcn_s_barrier(); asm volatile("" ::: "memory");
#pragma unroll
        for (int ai = 0; ai < 2; ++ai)
#pragma unroll
            for (int m = 0; m < 4; ++m) {
                const int row = row0 + ai * HALF + m * 16, rl = ai * HALF + wr * 64 + m * 16 + fr;
                const f32x4 t = *(const LAS f32x4*)(xch + rl * 4);
                const float inv = 1.0f / ((t[0] + t[1]) + (t[2] + t[3]));
                bf16_t* rowp = P + (long)row * 1024 + col0;
#pragma unroll
                for (int bj = 0; bj < 2; ++bj) {
                    const f32x4 v0 = acc[ai][bj][m][0] * inv, v1 = acc[ai][bj][m][1] * inv;
                    u32x4 w; w.x = pk_bf16(v0[0], v0[1]); w.y = pk_bf16(v0[2], v0[3]); w.z = pk_bf16(v1[0], v1[1]); w.w = pk_bf16(v1[2], v1[3]);
                    *(u32x4*)(rowp + bj * HALF) = w;
                }
            }
    }
};
struct EpiO {
    static constexpr bool PERM = true;
    bf16_t* O; const u64* lsum;
    __device__ __forceinline__ void operator()(f32x4 (&acc)[2][2][4][2], const Unit& u, int wr, int wc, int fr, int fq) const {
        const int b = u.z >> 2, h = u.z & 3;
        const int row0 = b * SEQ + u.pm * BM + wr * 64 + fr, col0 = h * 256 + wc * 32 + 8 * fq;
#pragma unroll
        for (int ai = 0; ai < 2; ++ai)
#pragma unroll
            for (int m = 0; m < 4; ++m) {
                const int row = row0 + ai * HALF + m * 16;
                const float inv = SC_L / (float)lsum[(long)row * 4 + h];
                bf16_t* rowp = O + (long)row * 1024 + col0;
#pragma unroll
                for (int bj = 0; bj < 2; ++bj) {
                    const f32x4 v0 = acc[ai][bj][m][0] * inv, v1 = acc[ai][bj][m][1] * inv;
                    u32x4 w; w.x = pk_bf16(v0[0], v0[1]); w.y = pk_bf16(v0[2], v0[3]); w.z = pk_bf16(v1[0], v1[1]); w.w = pk_bf16(v1[2], v1[3]);
                    *(u32x4*)(rowp + bj * HALF) = w;
                }
            }
    }
};
struct EpiR {
    static constexpr bool PERM = true;
    float* out; bf16_t* xb; u64* stat; int Mz;
    __device__ __forceinline__ bool can_repeat() const { return false; }
    __device__ __forceinline__ void operator()(f32x4 (&acc)[2][2][4][2], const Unit& u, int wr, int wc, int fr, int fq) const {
        const int row0 = u.z * Mz + u.pm * BM + wr * 64 + fr, col0 = u.pn * BM + wc * 32 + 8 * fq;
        u32x4 xv[2][2][2];
#define EPIR_LOAD(q_, buf_) do { _Pragma("unroll") for (int mm = 0; mm < 2; ++mm) _Pragma("unroll") for (int bj = 0; bj < 2; ++bj) \
            xv[buf_][mm][bj] = *(const u32x4*)(xb + (size_t)(row0 + ((q_) >> 1) * HALF + (((q_) & 1) * 2 + mm) * 16) * DM + col0 + bj * HALF); } while (0)
        EPIR_LOAD(0, 0);
#pragma unroll
        for (int q = 0; q < 4; ++q) {
            if (q < 3) EPIR_LOAD(q + 1, (q + 1) & 1);
            asm volatile("" ::: "memory");
            const int ai = q >> 1;
#pragma unroll
            for (int mm = 0; mm < 2; ++mm) {
                const int m = (q & 1) * 2 + mm;
                const int row = row0 + ai * HALF + m * 16; const size_t off = (size_t)row * DM + col0;
                float ss = 0.f;
#pragma unroll
                for (int bj = 0; bj < 2; ++bj) {
                    float f[8]; unpack8(xv[q & 1][mm][bj], f);
#pragma unroll
                    for (int i = 0; i < 4; ++i) { f[i] += acc[ai][bj][m][0][i]; f[4 + i] += acc[ai][bj][m][1][i]; }
#pragma unroll
                    for (int i = 0; i < 8; ++i) ss += f[i] * f[i];
                    *(u32x4*)(xb + off + bj * HALF) = pack8(f);
                    if (out) { *(f32x4*)(out + off + bj * HALF) = (f32x4){f[0], f[1], f[2], f[3]}; *(f32x4*)(out + off + bj * HALF + 4) = (f32x4){f[4], f[5], f[6], f[7]}; }
                }
                ss += __shfl_xor(ss, 16); ss += __shfl_xor(ss, 32);
                if (fq == 0) atomicAdd(stat + row, (u64)(ss * SC_SS + 0.5f));
            }
            asm volatile("" ::: "memory");
        }
#undef EPIR_LOAD
    }
};

template <class Epi>
__device__ __forceinline__ void gemm_phase(LAS unsigned char* lds, const int tid, const Gemm g, const int G, const int cidx, const Epi& E) {
    const int wid = __builtin_amdgcn_readfirstlane(tid >> 6), lane = tid & 63, wr = wid >> 2, wc = wid & 3, fr = lane & 15, fq = lane >> 4;
    Order S; S.init(g, G, cidx);
    const int K = g.K, nt = K / BK;
    unsigned voffA[2], voffB[2];
#pragma unroll
    for (int i = 0; i < 2; ++i) { int R, C; stage_rc(tid * 16 + i * 8192, R, C); const int Rb = Epi::PERM ? ((R & ~31) + perm32(R & 31)) : R;
        voffA[i] = (unsigned)(R * g.lda + C) * 2u; voffB[i] = (unsigned)(Rb * g.ldb + C) * 2u; }
    const size_t kstep = (size_t)(BK * 2);
    const size_t hstepA = (size_t)HALF * g.lda * 2, hstepB = (size_t)HALF * g.ldb * 2;
    const unsigned ldsw = (unsigned)wid * 1024u;
    const int aoff = lds_byte(wr * 64 + fr, fq * 8), boff = lds_byte(wc * 32 + fr, fq * 8);
#define PG8_SA(b, h) (((b) * 2 + (h)) * HTB)
#define PG8_SB(b, h) ((4 + (b) * 2 + (h)) * HTB)
#define PG8_STAGE(bufoff, gbase, voff) do { _Pragma("unroll") for (int _i = 0; _i < 2; ++_i) \
        __builtin_amdgcn_global_load_lds((const unsigned*)((const char*)(gbase) + (voff)[_i]), (LAS unsigned*)(lds + (bufoff) + ldsw + _i * 8192), 16, 0, 0); } while (0)
#define PG8_LDA(dst, b, h) do { _Pragma("unroll") for (int m = 0; m < 4; ++m) _Pragma("unroll") for (int k = 0; k < 2; ++k) dst[m][k] = *(const LAS bf16x8*)(lds + PG8_SA(b, h) + aoff + m * 2048 + k * 1024); } while (0)
#define PG8_LDB(dst, b, h) do { _Pragma("unroll") for (int n = 0; n < 2; ++n) _Pragma("unroll") for (int k = 0; k < 2; ++k) dst[n][k] = *(const LAS bf16x8*)(lds + PG8_SB(b, h) + boff + n * 2048 + k * 1024); } while (0)
#define PG8_MMA(ai, bj, At, Bt) do { __builtin_amdgcn_s_setprio(1); _Pragma("unroll") for (int m = 0; m < 4; ++m) _Pragma("unroll") for (int n = 0; n < 2; ++n) _Pragma("unroll") for (int k = 0; k < 2; ++k) \
        acc[ai][bj][m][n] = __builtin_amdgcn_mfma_f32_16x16x32_bf16(Bt[n][k], At[m][k], acc[ai][bj][m][n], 0, 0, 0); __builtin_amdgcn_s_setprio(0); } while (0)
#define PG8_WAIT_V(n) asm volatile("s_waitcnt vmcnt(" #n ")" ::: "memory")
#define PG8_WAIT_L(n) asm volatile("s_waitcnt lgkmcnt(" #n ")" ::: "memory")
#define PG8_BAR __builtin_amdgcn_s_barrier()
#define PG8_SCHED __builtin_amdgcn_sched_barrier(0)
    Unit cur, nxt; int ui = 0;
    if (!S.next(0, cur)) return;
    f32x4 acc[2][2][4][2];
#pragma unroll
    for (int a = 0; a < 2; ++a)
#pragma unroll
        for (int b = 0; b < 2; ++b)
#pragma unroll
            for (int m = 0; m < 4; ++m)
#pragma unroll
                for (int n = 0; n < 2; ++n) acc[a][b][m][n] = (f32x4){0.f, 0.f, 0.f, 0.f};
    bf16x8 At[4][2], B0[2][2], B1[2][2];
    const char* cA = a_ptr(g, cur); const char* cB = b_ptr(g, cur);
    PG8_STAGE(PG8_SB(0, 0), cB, voffB); PG8_STAGE(PG8_SB(0, 1), cB + hstepB, voffB); PG8_STAGE(PG8_SA(0, 0), cA, voffA); PG8_STAGE(PG8_SA(0, 1), cA + hstepA, voffA);
    if (wr == 1) PG8_BAR;
    PG8_WAIT_V(2); PG8_BAR;
    PG8_STAGE(PG8_SB(1, 0), cB + kstep, voffB); PG8_STAGE(PG8_SA(1, 0), cA + kstep, voffA); PG8_STAGE(PG8_SB(1, 1), cB + hstepB + kstep, voffB);
    PG8_WAIT_V(6); PG8_BAR;
    for (;;) {
        const bool has_next = S.next(ui + 1, nxt);
        const char* nA = has_next ? a_ptr(g, nxt) : cA; const char* nB = has_next ? b_ptr(g, nxt) : cB;
        for (int t = 0; t < nt; t += 2) {
            const bool last = (t == nt - 2);
            const char* a1 = cA + (size_t)(t + 1) * kstep;
            const char* a2 = last ? nA : cA + (size_t)(t + 2) * kstep; const char* b2 = last ? nB : cB + (size_t)(t + 2) * kstep;
            const char* a3 = a2 + kstep; const char* b3 = b2 + kstep;
            PG8_LDB(B0, 0, 0); PG8_LDB(B1, 0, 1); PG8_SCHED; PG8_LDA(At, 0, 0); PG8_STAGE(PG8_SA(1, 1), a1 + hstepA, voffA);
            PG8_WAIT_V(8); PG8_WAIT_L(0); PG8_BAR; PG8_MMA(0, 0, At, B0); PG8_MMA(0, 1, At, B1); PG8_BAR; PG8_SCHED;
            PG8_LDA(At, 0, 1); PG8_STAGE(PG8_SB(0, 0), b2, voffB); PG8_STAGE(PG8_SB(0, 1), b2 + hstepB, voffB); PG8_STAGE(PG8_SA(0, 0), a2, voffA);
            PG8_WAIT_V(8); PG8_WAIT_L(0); PG8_BAR; PG8_MMA(1, 0, At, B0); PG8_MMA(1, 1, At, B1); PG8_BAR; PG8_SCHED;
            PG8_LDB(B0, 1, 0); PG8_LDB(B1, 1, 1); PG8_SCHED; PG8_LDA(At, 1, 0); PG8_STAGE(PG8_SA(0, 1), a2 + hstepA, voffA);
            PG8_WAIT_V(8); PG8_WAIT_L(0); PG8_BAR; PG8_MMA(0, 0, At, B0); PG8_MMA(0, 1, At, B1); PG8_BAR; PG8_SCHED;
            PG8_LDA(At, 1, 1); PG8_STAGE(PG8_SB(1, 0), b3, voffB); PG8_STAGE(PG8_SB(1, 1), b3 + hstepB, voffB); PG8_STAGE(PG8_SA(1, 0), a3, voffA);
            PG8_WAIT_V(8); PG8_WAIT_L(0); PG8_BAR; PG8_MMA(1, 0, At, B0); PG8_MMA(1, 1, At, B1); PG8_BAR; PG8_SCHED;
        }
        if (wr == 0) PG8_BAR;
        E(acc, cur, wr, wc, fr, fq);
        if (!has_next) break;
#pragma unroll
        for (int a = 0; a < 2; ++a)
#pragma unroll
            for (int b = 0; b < 2; ++b)
#pragma unroll
                for (int m = 0; m < 4; ++m)
#pragma unroll
                    for (int n = 0; n < 2; ++n) acc[a][b][m][n] = (f32x4){0.f, 0.f, 0.f, 0.f};
        cur = nxt; cA = nA; cB = nB; ++ui;
        if (wr == 1) PG8_BAR;
    }
    PG8_WAIT_V(0);
    PG8_BAR;
#undef PG8_SA
#undef PG8_SB
#undef PG8_STAGE
#undef PG8_LDA
#undef PG8_LDB
#undef PG8_MMA
#undef PG8_WAIT_V
#undef PG8_WAIT_L
#undef PG8_BAR
#undef PG8_SCHED
}
}

struct Args { const float* in[29]; float* out; unsigned char* ws; int lo, hi; };

__device__ __forceinline__ void transpose_item(const float* W, int K, int N, const float* gain, bf16_t* WT, LAS float* scr, int item, int lane) {
    const int nblk = N / 32, kb = item / nblk, nb = item % nblk, k0 = 64 * kb, n0 = 32 * nb;
    {
        float wv[32]; const float* wp = W + (size_t)(k0 + (lane >> 5)) * N + n0 + (lane & 31);
#pragma unroll
        for (int i = 0; i < 32; ++i) wv[i] = wp[(size_t)(2 * i) * N];
        if (gain) { const float* gp = gain + k0 + (lane >> 5);
#pragma unroll
            for (int i = 0; i < 32; ++i) wv[i] *= gp[2 * i]; }
#pragma unroll
        for (int i = 0; i < 32; ++i) scr[(2 * i + (lane >> 5)) * 33 + (lane & 31)] = wv[i];
    }
    asm volatile("s_waitcnt lgkmcnt(0)" ::: "memory");
    const int c = lane & 7;
#pragma unroll
    for (int j = 0; j < 4; ++j) { const int n = (lane >> 3) + 8 * j; const LAS float* s = scr + (8 * c) * 33 + n;
        u32x4 o; o.x = pk_bf16(s[0 * 33], s[1 * 33]); o.y = pk_bf16(s[2 * 33], s[3 * 33]); o.z = pk_bf16(s[4 * 33], s[5 * 33]); o.w = pk_bf16(s[6 * 33], s[7 * 33]);
        *(u32x4*)(WT + (size_t)(n0 + n) * K + k0 + 8 * c) = o; }
    asm volatile("s_waitcnt lgkmcnt(0)" ::: "memory");
}
__device__ __forceinline__ void transpose_all(const float* W, int K, int N, const float* gain, bf16_t* WT, LAS float* scr, int gw, int NGW, int lane) {
    const int nitems = (K / 64) * (N / 32);
    for (int it = gw; it < nitems; it += NGW) transpose_item(W, K, N, gain, WT, scr, it, lane);
}
__device__ __forceinline__ void row_to_bf16(const float* xrow, bf16_t* orow, u64* ss, int lane) {
    const f32x4* xr = (const f32x4*)xrow + lane; float s = 0.f; f32x4 v[4];
#pragma unroll
    for (int j = 0; j < 4; ++j) { v[j] = xr[64 * j]; s += (v[j].x * v[j].x + v[j].y * v[j].y) + (v[j].z * v[j].z + v[j].w * v[j].w); }
    s = wave_sum(s);
    u32x2* o8 = (u32x2*)orow + lane;
#pragma unroll
    for (int j = 0; j < 4; ++j) { u32x2 w; w.x = pk_bf16(v[j].x, v[j].y); w.y = pk_bf16(v[j].z, v[j].w); o8[64 * j] = w; }
    if (lane == 0) *ss = (u64)(s * SC_SS + 0.5f);
}

__device__ __forceinline__ void transpose_layer(const __attribute__((address_space(4))) Args* ap, unsigned char* ws, int l, LAS float* scr, int gw, int NGW, int lane, int part = 3) {
    const int e = l >> 1;
    if (l & 1) {
        if (part & 1) transpose_all(ap->in[11] + (size_t)e * 1024 * 3328, 1024, 3328, ap->in[2] + l * 1024, (bf16_t*)(ws + WS_ODWIN) + (size_t)e * 3328 * 1024, scr, gw, NGW, lane);
        if (part & 2) transpose_all(ap->in[18] + (size_t)e * 1280 * 1024, 1280, 1024, nullptr, (bf16_t*)(ws + WS_ODWOUT) + (size_t)e * 1024 * 1280, scr, gw, NGW, lane);
    } else {
        if (part & 1) transpose_all(ap->in[3] + (size_t)e * 1024 * 3072, 1024, 3072, ap->in[2] + l * 1024, (bf16_t*)(ws + WS_EVWIN) + (size_t)e * 3072 * 1024, scr, gw, NGW, lane);
        if (part & 2) transpose_all(ap->in[10] + (size_t)e * 1024 * 1024, 1024, 1024, nullptr, (bf16_t*)(ws + WS_EVWOUT) + (size_t)e * 1024 * 1024, scr, gw, NGW, lane);
    }
    if (part & 2) transpose_all(ap->in[21] + (size_t)l * 1024 * 1024, 1024, 1024, ap->in[19] + l * 1024, (bf16_t*)(ws + WS_WQ) + (size_t)l * 1024 * 1024, scr, gw, NGW, lane);
    if (part & 1) transpose_all(ap->in[25] + (size_t)l * 1024 * 1024, 1024, 1024, nullptr, (bf16_t*)(ws + WS_WO) + (size_t)l * 1024 * 1024, scr, gw, NGW, lane);
    if (part & 2) transpose_all(ap->in[27] + (size_t)l * 1024 * 4096, 1024, 4096, ap->in[26] + l * 1024, (bf16_t*)(ws + WS_W1) + (size_t)l * 4096 * 1024, scr, gw, NGW, lane);
    if (part & 2) transpose_all(ap->in[28] + (size_t)l * 4096 * 1024, 4096, 1024, nullptr, (bf16_t*)(ws + WS_W2) + (size_t)l * 1024 * 4096, scr, gw, NGW, lane);
}

#define XB_TMO      128
#define XB_XCNT(j)  (256  + 64 * (j))
#define XB_XSUB(j)  (1280 + 64 * (j))
#define XB_XGEN(j)  (2304 + 64 * (j))
#define XB_TOP      3328
#define XB_TOPGEN   3392
#define XCD_BAR_WORDS 3456
#define XB_SPIN_CAP (1u << 22)
__device__ __forceinline__ unsigned xb_ld(unsigned* p)              { return __hip_atomic_load(p, __ATOMIC_RELAXED, __HIP_MEMORY_SCOPE_AGENT); }
__device__ __forceinline__ unsigned xb_add(unsigned* p, unsigned v) { return __hip_atomic_fetch_add(p, v, __ATOMIC_RELAXED, __HIP_MEMORY_SCOPE_AGENT); }
__device__ __forceinline__ unsigned xb_xcc_id() { return (unsigned)__builtin_amdgcn_s_getreg((3 << 11) | 20) & 0xFu; }
#define XB_SPIN(cond, bar) do { unsigned _sp = 0; while (cond) { __builtin_amdgcn_s_sleep(1); \
    if ((++_sp & 255u) == 0u) { if (xb_ld(&(bar)[XB_TMO])) break; if (_sp > XB_SPIN_CAP) { atomicAdd(&(bar)[XB_TMO], 1u); break; } } } } while (0)
__device__ __forceinline__ void xcd_barrier_complete(unsigned* bar, unsigned x, unsigned& nloc, unsigned& nx) {
    const unsigned G = gridDim.x * gridDim.y * gridDim.z;
    unsigned sum, cnt, mine, sp = 0u;
    for (;;) {
        sum = 0u; cnt = 0u; mine = 0u;
#pragma unroll
        for (unsigned j = 0; j < 16; ++j) { const unsigned c = xb_ld(&bar[XB_XCNT(j)]); sum += c; cnt += (c > 0u) ? 1u : 0u; mine = (j == x) ? c : mine; }
        if (sum == G) break;
        __builtin_amdgcn_s_sleep(1);
        if ((++sp & 255u) == 0u) { if (xb_ld(&bar[XB_TMO])) break; if (sp > XB_SPIN_CAP) { atomicAdd(&bar[XB_TMO], 1u); break; } }
    }
    nloc = mine > 0u ? mine : 1u; nx = cnt > 0u ? cnt : 1u;
}
__device__ __forceinline__ void xcd_barrier(unsigned* bar, unsigned x, volatile LAS unsigned* st) {
    asm volatile("s_waitcnt vmcnt(0)" ::: "memory");
    __syncthreads();
    if (threadIdx.x == 0) {
        __builtin_amdgcn_s_waitcnt(0);
        unsigned nloc = st[0], nx = st[1];
        if (nloc == 0u) { xcd_barrier_complete(bar, x, nloc, nx); st[0] = nloc; st[1] = nx; }
        const unsigned old = xb_add(&bar[XB_XSUB(x)], 1u);
        const unsigned gen = old / nloc;
        if (old + 1u == (gen + 1u) * nloc) {
            __builtin_amdgcn_fence(__ATOMIC_RELEASE, "agent");
            asm volatile("s_waitcnt vmcnt(0)" ::: "memory");
            const unsigned og = xb_add(&bar[XB_TOP], 1u);
            const unsigned tg = og / nx;
            if (og + 1u == (tg + 1u) * nx) xb_add(&bar[XB_TOPGEN], 1u);
            else XB_SPIN(xb_ld(&bar[XB_TOPGEN]) == tg, bar);
            __builtin_amdgcn_fence(__ATOMIC_ACQUIRE, "agent");
            xb_add(&bar[XB_XGEN(x)], 1u);
            asm volatile("s_waitcnt vmcnt(0)" ::: "memory");
        } else {
            XB_SPIN(xb_ld(&bar[XB_XGEN(x)]) == gen, bar);
            __builtin_amdgcn_fence(__ATOMIC_ACQUIRE, "agent");
            asm volatile("s_waitcnt vmcnt(0)" ::: "memory");
        }
    }
    __syncthreads();
}

__global__ void __launch_bounds__(512, 2) mk_fwd(Args args) {
    extern __shared__ __attribute__((aligned(16))) unsigned char lds_raw[];
    LAS unsigned char* lds = (LAS unsigned char*)lds_raw;
    volatile LAS unsigned* const xst = (volatile LAS unsigned*)((LAS unsigned char*)lds_raw + LDS_BYTES - 64);
    if (threadIdx.x < 2) xst[threadIdx.x] = 0u;
    const unsigned xcc = xb_xcc_id();
    if (args.hi - args.lo > 1 && threadIdx.x == 0) (void)xb_add((unsigned*)(args.ws + ST_BAR) + XB_XCNT(xcc), 1u);
    __syncthreads();
    const __attribute__((address_space(4))) Args* const ap0 = (const __attribute__((address_space(4))) Args*)__builtin_amdgcn_kernarg_segment_ptr();
#ifdef REP_MASK
    for (int ph2 = args.lo * 2; ph2 < args.hi * 2; ++ph2) { const int ph = ph2 >> 1;
    if ((ph2 & 1) && !(ph >= 3 && ((REP_MASK >> ((ph - 3) % 10)) & 1) && ((REP_ODD >> (((ph - 3) / 10) & 1)) & 1))) continue;
#else
    for (int ph = args.lo; ph < args.hi; ++ph) {
#endif
    const __attribute__((address_space(4))) Args* ap = ap0; asm volatile("" : "+s"(ap));
    int tid = threadIdx.x; asm volatile("" : "+v"(tid));
    const int lane = tid & 63, wave = __builtin_amdgcn_readfirstlane(tid >> 6);
    int G = gridDim.x, bx = blockIdx.x; asm volatile("" : "+s"(G), "+s"(bx));
    const int vcu = (G % 8 == 0) ? (bx % 8) * (G / 8) + bx / 8 : bx;
    unsigned char* ws = ap->ws;
    u64* const st_sxz = (u64*)(ws + ST_SXZ); u64* const st_sx0 = (u64*)(ws + ST_SX0);
    bf16_t* const xb = (bf16_t*)(ws + WS_XB);
    bf16_t* const pbuf = (bf16_t*)(ws + WS_P); bf16_t* const mix = (bf16_t*)(ws + WS_MIX);
    float* const rope = (float*)(ws + ST_ROPE); float* const lse = (float*)(ws + ST_LSE);
    {
#ifdef ONLY_S
        if (ph < 0) {
#else
        if (ph == 0) {
#endif
            const int gw = vcu * 8 + wave, NGW = G * 8;
            { u32x4* z = (u32x4*)ws; const size_t n16 = ST_ZERO_BYTES / 16; for (size_t i = (size_t)bx * 512 + tid; i < n16; i += (size_t)G * 512) z[i] = (u32x4){0u, 0u, 0u, 0u}; }
            for (int m = gw * 2; m < NTOK; m += NGW * 2) {
                const f32x4* x0 = (const f32x4*)(ap->in[0] + (size_t)m * DM) + lane; const f32x4* x1 = x0 + DM / 4;
                f32x4 v[8];
#pragma unroll
                for (int j = 0; j < 4; ++j) { v[j] = x0[64 * j]; v[4 + j] = x1[64 * j]; }
                float s0 = 0.f, s1 = 0.f;
#pragma unroll
                for (int j = 0; j < 4; ++j) { s0 += (v[j].x * v[j].x + v[j].y * v[j].y) + (v[j].z * v[j].z + v[j].w * v[j].w); s1 += (v[4 + j].x * v[4 + j].x + v[4 + j].y * v[4 + j].y) + (v[4 + j].z * v[4 + j].z + v[4 + j].w * v[4 + j].w); }
                s0 = wave_sum(s0); s1 = wave_sum(s1);
                u32x2* o0 = (u32x2*)(xb + (size_t)m * DM) + lane; u32x2* o1 = o0 + DM / 4;
#pragma unroll
                for (int j = 0; j < 4; ++j) { u32x2 w; w.x = pk_bf16(v[j].x, v[j].y); w.y = pk_bf16(v[j].z, v[j].w); o0[64 * j] = w; u32x2 w1; w1.x = pk_bf16(v[4 + j].x, v[4 + j].y); w1.y = pk_bf16(v[4 + j].z, v[4 + j].w); o1[64 * j] = w1; }
                if (lane == 0) { st_sx0[m] = (u64)(s0 * SC_SS + 0.5f); st_sx0[m + 1] = (u64)(s1 * SC_SS + 0.5f); }
            }
            { bf16_t* memb = (bf16_t*)(ws + WS_MEMB); u64* smem = (u64*)(ws + ST_SMEM);
              for (int m = gw; m < 4096; m += NGW) row_to_bf16(ap->in[1] + (size_t)m * DM, memb + (size_t)m * DM, smem + m, lane); }
            LAS float* scr = (LAS float*)(lds + wave * 16384);
            for (int l = 0; l < 4; ++l)
                transpose_all(ap->in[22] + (size_t)l * 1024 * 2048, 1024, 2048, ap->in[20] + l * 1024, (bf16_t*)(ws + WS_WKV) + (size_t)l * 2048 * 1024, scr, gw, NGW, lane);
            for (int l = 0; l < ((G >= 128) ? 1 : 4); ++l) transpose_layer(ap, ws, l, scr, gw, NGW, lane);
            for (int i = bx * 512 + tid; i < 4096 * 8; i += G * 512) {
                const int t = i >> 3, j = i & 7;
                const float invf[8] = {1.0f, 0.19392274474868576f, 0.03760603093086393f, 0.007292664737217109f, 0.001414213562373095f, 0.0002742481756762073f, 5.318295896944988e-05f, 1.031338537721246e-05f};
                float fj = invf[0];
#pragma unroll
                for (int q = 1; q < 8; ++q) fj = (j == q) ? invf[q] : fj;
                const float ang = (float)t * fj;
                const double a = (double)ang; const double k = __builtin_rint(a * 0.15915494309189535); const float r = (float)(a - k * 6.283185307179586);
                rope[t * 16 + j] = __cosf(r); rope[t * 16 + 8 + j] = __sinf(r);
            }
#ifdef ONLY_S
        } else if (ph < 0) {
#else
        } else if (ph == 1) {
#endif
            pg8::Gemm g{(const bf16_t*)(ws + WS_MEMB), (const bf16_t*)(ws + WS_WKV), 1024, 1024, 1024, 16, 8, 4, 1, 0, 0, 2048 * 1024, 0, 0};
            pg8::EpiP E{(bf16_t*)(ws + WS_KVRAW), 2048, 4096, (const u64*)(ws + ST_SMEM), 1.0f / (1024.0f * SC_SS), 0, (u64*)(ws + ST_KST), 8, 1, 0};
            pg8::gemm_phase<pg8::EpiP>(lds, tid, g, G, bx, E);
#ifdef ONLY_S
        } else if (ph < 0) {
#else
        } else if (ph == 2) {
#endif
            const int gw = vcu * 8 + wave, NGW = G * 8;
            const bf16_t* kvraw = (const bf16_t*)(ws + WS_KVRAW); bf16_t* kt = (bf16_t*)(ws + WS_KT); bf16_t* vt = (bf16_t*)(ws + WS_VT); const u64* kst = (const u64*)(ws + ST_KST);
            for (int r = gw; r < 4 * 4096; r += NGW) {
                const int l = r >> 12;
                const float* gk = ap->in[24] + l * 256; const float* gq = ap->in[23] + l * 256;
#pragma unroll
                for (int c2 = 0; c2 < 2; ++c2) {
                    const int ch = lane + 64 * c2, h = ch >> 5, e0 = (ch & 31) * 8;
                    const float rs = rsqrtf((float)kst[(size_t)r * 8 + h] * (1.0f / (256.0f * SC_SS)) + EPSF) * 0.0625f;
                    const u32x4 raw = *(const u32x4*)(kvraw + (size_t)r * 2048 + ch * 8); float f[8]; unpack8(raw, f);
#pragma unroll
                    for (int i = 0; i < 8; ++i) f[i] = f[i] * rs * gk[e0 + i] * gq[e0 + i];
                    *(u32x4*)(kt + (size_t)r * 1024 + ch * 8) = pack8(f);
                }
            }
            for (int idx0 = bx * 512 + tid; idx0 < 4 * 4096 * 128; idx0 += G * 512 * 4) {
                u32x4 cv[4];
#pragma unroll
                for (int q = 0; q < 4; ++q) { const int idx = idx0 + q * G * 512; cv[q] = (u32x4){0u, 0u, 0u, 0u}; if (idx < 4 * 4096 * 128) cv[q] = *(const u32x4*)(kvraw + (size_t)(idx >> 7) * 2048 + 1024 + (idx & 127) * 8); }
#pragma unroll
                for (int q = 0; q < 4; ++q) { const int idx = idx0 + q * G * 512; if (idx < 4 * 4096 * 128) *(u32x4*)(vt + (size_t)(idx >> 7) * 1024 + (idx & 127) * 8) = cv[q]; }
            }
        } else {
            #ifdef ONLY_S
            const int l = (ph - 3) / 10, s = ONLY_S, odd = ONLY_ODD, eo = l >> 1;
#else
            const int l = (ph - 3) / 10, s = (ph - 3) % 10, odd = l & 1, eo = l >> 1;
#endif
            u64* const sx_mix = (l == 0) ? st_sx0 : st_sxz + (size_t)(3 * l - 1) * NTOK;
            u64* const sx_xat = st_sxz + (size_t)(3 * l) * NTOK;
            u64* const sx_mlp = st_sxz + (size_t)(3 * l + 1) * NTOK;
            u64* const sx_next = st_sxz + (size_t)(3 * l + 2) * NTOK;
            u64* const qst = (u64*)(ws + ST_QST) + (size_t)l * NTOK * 4;
            u64* const lsum = (u64*)(ws + ST_LSUM) + (size_t)l * NTOK * 4;
            const int PW = odd ? 3328 : 3072, MW = odd ? 1280 : 1024;
            if (s == 6) continue;
            if (s == 0) {
                const bf16_t* wt = odd ? (const bf16_t*)(ws + WS_ODWIN) + (size_t)eo * 3328 * 1024 : (const bf16_t*)(ws + WS_EVWIN) + (size_t)eo * 3072 * 1024;
                pg8::Gemm g{xb, wt, 1024, 1024, 1024, 256, PW / 256, 1, 1, 0, 0, 0, 0, 0};
                pg8::EpiP E{pbuf, PW, NTOK, sx_mix, 1.0f / (1024.0f * SC_SS), odd ? 1 : 0, nullptr, 0, 1, 0};
                pg8::Gemm gv{(const bf16_t*)(ws + WS_WO) + (size_t)l * 1024 * 1024, (const bf16_t*)(ws + WS_VT) + (size_t)l * 4096 * 1024, 1024, 1024, 256, 4, 1, 64, 4, 0, 256, 256 * 1024, 256, 0};
                pg8::EpiP Ev{(bf16_t*)(ws + WS_VP), 1024, 1024, nullptr, 0.f, 0, nullptr, 0, 4, 256};
#pragma unroll 1
                for (int pass = 0; pass < 2; ++pass)
                    pg8::gemm_phase<pg8::EpiP>(lds, tid, pass ? gv : g, G, bx, pass ? Ev : E);
            } else if (s == 1 && !odd) {
#if !defined(NO_HGRN)
                {
                    const int fr = lane & 15, fq = lane >> 4, tr_r = (lane & 15) >> 2, tr_c = lane & 3;
                    const int kch = tid >> 2, tq = tid & 3;
                    constexpr int HB = 17920;
                    for (int item = vcu; item < 64; item += G) {
                        const int b = item >> 2, h = item & 3;
                        float lbv = 0.f; if (eo == 1) { const int c = h * 128 + kch; lbv = sigmoidf_(ap->in[8][512 + c] - ap->in[8][c]); }
                        f32x4 Sacc[8];
#pragma unroll
                        for (int kt = 0; kt < 8; ++kt) Sacc[kt] = (f32x4){0.f, 0.f, 0.f, 0.f};
                        const bf16_t* pq = pbuf + ((size_t)b * SEQ + 4 * tq) * 3072 + 1024 + h * 128 + kch;
                        const bf16_t* pi = pbuf + ((size_t)b * SEQ + (tid >> 5)) * 3072 + 2048 + h * 128 + (tid & 31) * 4;
                        unsigned rqr[4], rfr[4]; u32x2 rir;
#define HG_LOAD(blk_) do { const bf16_t* p_ = pq + (size_t)(blk_) * 16 * 3072; \
                            _Pragma("unroll") for (int j = 0; j < 4; ++j) { rqr[j] = p_[(size_t)j * 3072]; rfr[j] = p_[(size_t)j * 3072 + 512]; } \
                            rir = *(const u32x2*)(pi + (size_t)(blk_) * 16 * 3072); } while (0)
#define HG_ELEM(buf_) do { LAS bf16_t* QT_ = (LAS bf16_t*)(lds + (buf_) * HB); LAS bf16_t* KT_ = QT_ + 2176; LAS bf16_t* KB_ = QT_ + 4352; LAS bf16_t* IV_ = QT_ + 6528; LAS float* EL_ = (LAS float*)(lds + (buf_) * HB + 17408); \
                            float cj[4], fk[4], qv[4]; float c_ = 0.f; \
                            _Pragma("unroll") for (int j = 0; j < 4; ++j) { const float fp = __uint_as_float(rfr[j] << 16); const float f = lbv + (1.0f - lbv) * sigmoidf_(fp); c_ += __logf(f); cj[j] = c_; fk[j] = 1.0f - f; qv[j] = __uint_as_float(rqr[j] << 16); } \
                            const float T0 = dppf<0x00>(c_), T1 = dppf<0x55>(c_), T2 = dppf<0xAA>(c_), T3 = dppf<0xFF>(c_); \
                            const float P_ = (tq > 0 ? T0 : 0.f) + (tq > 1 ? T1 : 0.f) + (tq > 2 ? T2 : 0.f); \
                            const float ELv = __expf(fmaxf((T0 + T1) + (T2 + T3), -80.f)); \
                            _Pragma("unroll") for (int j = 0; j < 4; ++j) { const float Bv = fmaxf(P_ + cj[j], -80.f); const float E = __expf(Bv), Ei = __expf(-Bv); const float kt_ = fk[j] * Ei; const int t_ = 4 * tq + j; \
                                QT_[t_ * 136 + kch] = (bf16_t)(pk_bf16(qv[j] * E, 0.f) & 0xffffu); KT_[t_ * 136 + kch] = (bf16_t)(pk_bf16(kt_, 0.f) & 0xffffu); KB_[t_ * 136 + kch] = (bf16_t)(pk_bf16(kt_ * ELv, 0.f) & 0xffffu); } \
                            if (tq == 0) EL_[kch] = ELv; \
                            *(LAS u32x2*)(IV_ + (tid >> 5) * 136 + (tid & 31) * 4) = rir; } while (0)
                        HG_LOAD(0);
                        {
                            LAS float* fL = (LAS float*)(lds + 40960); LAS float* qL = fL + 2048; LAS float* iL = fL + 4096; LAS float* SD = (LAS float*)(lds + 65536);
#pragma unroll
                            for (int j = 0; j < 4; ++j) { const float fp = __uint_as_float(rfr[j] << 16); fL[(4 * tq + j) * 128 + kch] = lbv + (1.0f - lbv) * sigmoidf_(fp); qL[(4 * tq + j) * 128 + kch] = __uint_as_float(rqr[j] << 16); }
                            *(LAS f32x4*)(iL + (tid >> 5) * 128 + (tid & 31) * 4) = (f32x4){bf_lo(rir.x), bf_hi(rir.x), bf_lo(rir.y), bf_hi(rir.y)};
                            asm volatile("s_waitcnt lgkmcnt(0)" ::: "memory"); __builtin_amdgcn_s_barrier(); asm volatile("" ::: "memory");
                            const int kg = lane & 15, vq = wave * 4 + (lane >> 4);
                            float S0[8][4];
#pragma unroll
                            for (int j = 0; j < 8; ++j)
#pragma unroll
                                for (int c = 0; c < 4; ++c) S0[j][c] = 0.f;
#pragma unroll 2
                            for (int t = 0; t < 16; ++t) {
                                const f32x4 fa = *(const LAS f32x4*)(fL + t * 128 + kg * 8), fb = *(const LAS f32x4*)(fL + t * 128 + kg * 8 + 4);
                                const f32x4 qa = *(const LAS f32x4*)(qL + t * 128 + kg * 8), qb = *(const LAS f32x4*)(qL + t * 128 + kg * 8 + 4);
                                const f32x4 iv = *(const LAS f32x4*)(iL + t * 128 + vq * 4);
                                float a[4] = {0.f, 0.f, 0.f, 0.f};
#pragma unroll
                                for (int j = 0; j < 8; ++j) { const float fj = j < 4 ? fa[j] : fb[j - 4], qj = j < 4 ? qa[j] : qb[j - 4];
#pragma unroll
                                    for (int c = 0; c < 4; ++c) { const float d0 = S0[j][c] - iv[c]; S0[j][c] = __builtin_fmaf(fj, d0, iv[c]); a[c] = __builtin_fmaf(qj, S0[j][c], a[c]); } }
#pragma unroll
                                for (int c = 0; c < 4; ++c) a[c] = row16_sum(a[c]);
                                if (kg == 0) { u32x2 wv; wv.x = pk_bf16(a[0], a[1]); wv.y = pk_bf16(a[2], a[3]); *(u32x2*)(mix + ((size_t)b * SEQ + t) * 1024 + 512 + h * 128 + vq * 4) = wv; }
                            }
#pragma unroll
                            for (int j = 0; j < 8; ++j) *(LAS f32x4*)(SD + (kg * 8 + j) * 128 + vq * 4) = (f32x4){S0[j][0], S0[j][1], S0[j][2], S0[j][3]};
                            asm volatile("s_waitcnt lgkmcnt(0)" ::: "memory"); __builtin_amdgcn_s_barrier(); asm volatile("" ::: "memory");
#pragma unroll
                            for (int kt = 0; kt < 8; ++kt)
#pragma unroll
                                for (int i = 0; i < 4; ++i) Sacc[kt][i] = SD[(16 * kt + 4 * fq + i) * 128 + 16 * wave + fr];
                        }
                        HG_LOAD(1); HG_ELEM(1); HG_LOAD(2);
                        asm volatile("s_waitcnt lgkmcnt(0)" ::: "memory"); __builtin_amdgcn_s_barrier(); asm volatile("" ::: "memory");
                        for (int blk = 1; blk < 256; ++blk) {
                            const int cur = blk & 1;
                            if (wave < 4 && blk + 1 < 256) { HG_ELEM(cur ^ 1); if (blk + 2 < 256) HG_LOAD(blk + 2); }
                            const LAS bf16_t* QT = (const LAS bf16_t*)(lds + cur * HB); const LAS bf16_t* KT = QT + 2176; const LAS bf16_t* KB = QT + 4352; const LAS bf16_t* IV = QT + 6528; const LAS float* EL = (const LAS float*)(lds + cur * HB + 17408);
                            const v4i16_t itv = __builtin_amdgcn_ds_read_tr16_b64_v4i16((LAS v4i16_t*)(IV + (4 * fq + tr_r) * 136 + 16 * wave + 4 * tr_c));
                            bf16x8 AX[4], AY[4]; u32x2 QY0[4], QY1[4]; f32x4 ELv4[8]; v4i16_t KX[8];
#pragma unroll
                            for (int ks = 0; ks < 4; ++ks) { AX[ks] = *(const LAS bf16x8*)(KT + fr * 136 + ks * 32 + fq * 8); AY[ks] = *(const LAS bf16x8*)(QT + fr * 136 + ks * 32 + fq * 8); }
#pragma unroll
                            for (int p = 0; p < 4; ++p) { QY0[p] = *(const LAS u32x2*)(QT + fr * 136 + 32 * p + 4 * fq); QY1[p] = *(const LAS u32x2*)(QT + fr * 136 + 32 * p + 16 + 4 * fq); }
#pragma unroll
                            for (int kt = 0; kt < 8; ++kt) { ELv4[kt] = *(const LAS f32x4*)(EL + 16 * kt + 4 * fq); KX[kt] = __builtin_amdgcn_ds_read_tr16_b64_v4i16((LAS v4i16_t*)(KB + (4 * fq + tr_r) * 136 + kt * 16 + 4 * tr_c)); }
                            __builtin_amdgcn_sched_barrier(0);
                            const bf16x8 IT = (bf16x8){itv[0], itv[1], itv[2], itv[3], 0, 0, 0, 0};
                            f32x4 A = (f32x4){0.f, 0.f, 0.f, 0.f};
#pragma unroll
                            for (int ks = 0; ks < 4; ++ks) A = __builtin_amdgcn_mfma_f32_16x16x32_bf16(AX[ks], AY[ks], A, 0, 0, 0);
#pragma unroll
                            for (int i = 0; i < 4; ++i) A[i] = (4 * fq + i > fr) ? 0.f : A[i];
                            const u32x4 apk = (u32x4){pk_bf16(A[0], A[1]), pk_bf16(A[2], A[3]), 0u, 0u};
                            f32x4 o = __builtin_amdgcn_mfma_f32_16x16x32_bf16(IT, __builtin_bit_cast(bf16x8, apk), (f32x4){0.f, 0.f, 0.f, 0.f}, 0, 0, 0);
#pragma unroll
                            for (int p = 0; p < 4; ++p) {
                                const u32x4 sx = (u32x4){pk_bf16(Sacc[2 * p][0], Sacc[2 * p][1]), pk_bf16(Sacc[2 * p][2], Sacc[2 * p][3]), pk_bf16(Sacc[2 * p + 1][0], Sacc[2 * p + 1][1]), pk_bf16(Sacc[2 * p + 1][2], Sacc[2 * p + 1][3])};
                                const u32x4 yy = (u32x4){QY0[p].x, QY0[p].y, QY1[p].x, QY1[p].y};
                                o = __builtin_amdgcn_mfma_f32_16x16x32_bf16(__builtin_bit_cast(bf16x8, sx), __builtin_bit_cast(bf16x8, yy), o, 0, 0, 0);
                            }
                            { u32x2 wv; wv.x = pk_bf16(o[0], o[1]); wv.y = pk_bf16(o[2], o[3]);
                              *(u32x2*)(mix + ((size_t)b * SEQ + blk * 16 + fr) * 1024 + 512 + h * 128 + 16 * wave + 4 * fq) = wv; }
#pragma unroll
                            for (int kt = 0; kt < 8; ++kt) {
                                const bf16x8 X = (bf16x8){KX[kt][0], KX[kt][1], KX[kt][2], KX[kt][3], 0, 0, 0, 0};
                                Sacc[kt] = __builtin_amdgcn_mfma_f32_16x16x32_bf16(X, IT, Sacc[kt] * ELv4[kt], 0, 0, 0);
                            }
                            if (wave >= 4 && blk + 1 < 256) { HG_ELEM(cur ^ 1); if (blk + 2 < 256) HG_LOAD(blk + 2); }
                            asm volatile("s_waitcnt lgkmcnt(0)" ::: "memory"); __builtin_amdgcn_s_barrier(); asm volatile("" ::: "memory");
                        }
#undef HG_LOAD
#undef HG_ELEM
                    }
                }
#endif
#if !defined(NO_CONV)
                {
                    LAS unsigned* hL32 = (LAS unsigned*)lds; LAS float* yL = (LAS float*)(lds + 65536);
                    const float* cw = ap->in[4] + (size_t)eo * 31 * 512; const float* cb = ap->in[5] + eo * 512;
                    const float* lng = ap->in[6] + eo * 512; const float* lnb = ap->in[7] + eo * 512;
                    const int cp = tid & 255, th = tid >> 8;
                    const bool split_ = (G >= 128);
                    for (int item = split_ ? vcu - 64 : vcu; item < 2048; item += split_ ? G - 64 : G) {
                        if (item < 0) break;
                        const int ritem = 2047 - item;
                        const int b = ritem >> 7, t0 = (ritem & 127) * 32;
                        {
                            u32x4 av[8], gv[8];
#pragma unroll
                            for (int q = 0; q < 8; ++q) {
                                const int idx = tid + 512 * q, r = idx >> 6, c8 = idx & 63, t = t0 - 30 + r;
                                av[q] = (u32x4){0u, 0u, 0u, 0u}; gv[q] = av[q];
                                if (idx < 62 * 64 && t >= 0) { const bf16_t* pr = pbuf + ((size_t)b * SEQ + t) * 3072 + c8 * 8; av[q] = *(const u32x4*)pr; gv[q] = *(const u32x4*)(pr + 512); }
                            }
#pragma unroll
                            for (int q = 0; q < 8; ++q) {
                                const int idx = tid + 512 * q, r = idx >> 6, c8 = idx & 63;
                                float a[8], g8[8]; unpack8(av[q], a); unpack8(gv[q], g8);
#pragma unroll
                                for (int i = 0; i < 8; ++i) a[i] *= sigmoidf_(g8[i]);
                                if (idx < 62 * 64) *(LAS u32x4*)(hL32 + r * 256 + c8 * 4) = pack8(a);
                            }
                        }
                        __syncthreads();
#pragma unroll 1
                        for (int sb = 0; sb < 2; ++sb) {
                            float y0[8], y1[8];
                            const float b0 = cb[2 * cp], b1 = cb[2 * cp + 1];
#pragma unroll
                            for (int t = 0; t < 8; ++t) { y0[t] = b0; y1[t] = b1; }
                            unsigned in[38];
#pragma unroll
                            for (int r = 0; r < 38; ++r) in[r] = hL32[(th * 16 + sb * 8 + r) * 256 + cp];
#pragma unroll
                            for (int j = 0; j < 31; ++j) {
                                const f32x2 wj = *(const f32x2*)(cw + j * 512 + 2 * cp);
#pragma unroll
                                for (int t = 0; t < 8; ++t) { y0[t] = __builtin_fmaf(wj.x, bf_lo(in[t + j]), y0[t]); y1[t] = __builtin_fmaf(wj.y, bf_hi(in[t + j]), y1[t]); }
                            }
#pragma unroll
                            for (int t = 0; t < 8; ++t) *(LAS f32x2*)(yL + (th * 16 + sb * 8 + t) * 512 + 2 * cp) = (f32x2){y0[t], y1[t]};
                        }
                        __syncthreads();
                        u32x4 lnres[4];
#pragma unroll
                        for (int q = 0; q < 4; ++q) {
                            const int tok = wave * 4 + q;
                            const f32x4 v0 = *(const LAS f32x4*)(yL + tok * 512 + lane * 8), v1 = *(const LAS f32x4*)(yL + tok * 512 + lane * 8 + 4);
                            float sm = (v0[0] + v0[1]) + (v0[2] + v0[3]) + (v1[0] + v1[1]) + (v1[2] + v1[3]);
                            sm = wave_sum(sm); const float mu = sm * (1.0f / 512.0f);
                            float f[8] = {v0[0] - mu, v0[1] - mu, v0[2] - mu, v0[3] - mu, v1[0] - mu, v1[1] - mu, v1[2] - mu, v1[3] - mu};
                            float sq = 0.f;
#pragma unroll
                            for (int i = 0; i < 8; ++i) sq += f[i] * f[i];
                            sq = wave_sum(sq); const float rstd = rsqrtf(sq * (1.0f / 512.0f) + EPSF);
#pragma unroll
                            for (int i = 0; i < 8; ++i) { const float yv = f[i] * rstd * lng[lane * 8 + i] + lnb[lane * 8 + i]; f[i] = yv * sigmoidf_(yv); }
                            lnres[q] = pack8(f);
                        }
#pragma unroll
                        for (int q = 0; q < 4; ++q) *(u32x4*)(mix + ((size_t)b * SEQ + t0 + wave * 4 + q) * 1024 + lane * 8) = lnres[q];
                        __syncthreads();
                    }
                    if (split_ && vcu >= 64) {
                        LAS float* scr = (LAS float*)(lds + wave * 16384);
                        const int gw2 = (vcu - 64) * 8 + wave, NGW2 = (G - 64) * 8;
                        if (l == 0) { transpose_layer(ap, ws, 1, scr, gw2, NGW2, lane); transpose_layer(ap, ws, 2, scr, gw2, NGW2, lane, 1); }
                        else { transpose_layer(ap, ws, 2, scr, gw2, NGW2, lane, 2); transpose_layer(ap, ws, 3, scr, gw2, NGW2, lane); }
                    }
                }
#endif
            } else if (s == 2 && !odd) {
                const int gw = vcu * 8 + wave, NGW = G * 8;
                const float* og = ap->in[9] + eo * 128;
                float ogr[8];
#pragma unroll
                for (int i = 0; i < 8; ++i) ogr[i] = og[(lane & 15) * 8 + i];
                for (int m0 = gw * 4; m0 < NTOK; m0 += NGW * 4) {
                    u32x4 ov[4], gv[4];
#pragma unroll
                    for (int q = 0; q < 4; ++q) { ov[q] = *(const u32x4*)(mix + (size_t)(m0 + q) * 1024 + 512 + lane * 8); gv[q] = *(const u32x4*)(pbuf + (size_t)(m0 + q) * 3072 + 2560 + lane * 8); }
#pragma unroll
                    for (int q = 0; q < 4; ++q) {
                        float o[8], g8[8]; unpack8(ov[q], o); unpack8(gv[q], g8);
                        float ss = 0.f;
#pragma unroll
                        for (int i = 0; i < 8; ++i) ss += o[i] * o[i];
                        ss = row16_sum(ss);
                        const float rs = rsqrtf(ss * (1.0f / 128.0f) + EPSF);
                        const int c0 = (lane & 15) * 8;
#pragma unroll
                        for (int i = 0; i < 8; ++i) o[i] = o[i] * rs * ogr[i] * (g8[i] * sigmoidf_(g8[i]));
                        *(u32x4*)(mix + (size_t)(m0 + q) * 1024 + 512 + lane * 8) = pack8(o);
                    }
                }
            } else if (s == 1 && odd) {
#if !defined(NO_SGU)
                {
                    LAS bf16_t* VN = (LAS bf16_t*)lds;
                    const float* lng = ap->in[12] + eo * 512; const float* lnb = ap->in[13] + eo * 512;
                    const int wr = wave >> 2, wc = wave & 3, fr = lane & 15, fq = lane >> 4, tr_r = (lane & 15) >> 2, tr_c = lane & 3;
                    LAS float* LNP = (LAS float*)(lds + 133120);
                    if (tid < 128) *(LAS f32x4*)(LNP + tid * 4) = *(const f32x4*)(lng + tid * 4); else if (tid < 256) *(LAS f32x4*)(LNP + 512 + (tid - 128) * 4) = *(const f32x4*)(lnb + (tid - 128) * 4);
                    __syncthreads();
                    for (int item = vcu; item < 512; item += G) {
                        const int ritem = 511 - item;
                        const int b = ritem >> 5, n = ritem & 31;
                        const size_t row0 = (size_t)b * SEQ + n * 128;
                        const int sT = tid >> 2, qd = tid & 3;
                        {
                            const bf16_t* pr = pbuf + (row0 + sT) * 3328 + 512 + qd * 128;
                            float sm = 0.f, sq = 0.f;
#pragma unroll 4
                            for (int i = 0; i < 16; ++i) { const u32x4 rawv = *(const u32x4*)(pr + i * 8); float f[8]; unpack8(rawv, f);
#pragma unroll
                                for (int j = 0; j < 8; ++j) { sm += f[j]; sq += f[j] * f[j]; } }
                            sm += __shfl_xor(sm, 1); sm += __shfl_xor(sm, 2); sq += __shfl_xor(sq, 1); sq += __shfl_xor(sq, 2);
                            const float mu = sm * (1.0f / 512.0f); const float var = fmaxf(sq * (1.0f / 512.0f) - mu * mu, 0.f); const float rstd = rsqrtf(var + EPSF);
#pragma unroll 1
                            for (int i0 = 0; i0 < 16; i0 += 8) {
                                u32x4 rawb[8];
#pragma unroll
                                for (int i = 0; i < 8; ++i) rawb[i] = *(const u32x4*)(pr + (i0 + i) * 8);
#pragma unroll
                                for (int i = 0; i < 8; ++i) { float f[8]; unpack8(rawb[i], f);
                                    const LAS float* gp = LNP + qd * 128 + (i0 + i) * 8;
                                    const f32x4 g0 = *(const LAS f32x4*)gp, g1 = *(const LAS f32x4*)(gp + 4), b0 = *(const LAS f32x4*)(gp + 512), b1 = *(const LAS f32x4*)(gp + 516);
#pragma unroll
                                    for (int j = 0; j < 4; ++j) { f[j] = (f[j] - mu) * rstd * g0[j] + b0[j]; f[4 + j] = (f[4 + j] - mu) * rstd * g1[j] + b1[j]; }
                                    *(LAS u32x4*)(VN + sT * 520 + qd * 128 + (i0 + i) * 8) = pack8(f); }
                            }
                        }
                        asm volatile("s_waitcnt lgkmcnt(0)" ::: "memory"); __builtin_amdgcn_s_barrier(); asm volatile("" ::: "memory");
#pragma unroll 1
                        for (int gI = 0; gI < 4; ++gI) {
                            const float* wg = ap->in[14] + ((size_t)eo * 4 + gI) * 128 * 128; const float* bsg = ap->in[15] + (eo * 4 + gI) * 128;
                            f32x4 acc[4][2];
#pragma unroll
                            for (int m = 0; m < 4; ++m) { acc[m][0] = (f32x4){0.f, 0.f, 0.f, 0.f}; acc[m][1] = (f32x4){0.f, 0.f, 0.f, 0.f}; }
#pragma unroll
                            for (int k0 = 0; k0 < 128; k0 += 32) {
                                if (k0 <= wr * 64 + 63) {
                                    f32x4 wv[4][2];
#pragma unroll
                                    for (int m = 0; m < 4; ++m) { wv[m][0] = (f32x4){0.f, 0.f, 0.f, 0.f}; wv[m][1] = wv[m][0];
                                        if (k0 <= wr * 64 + m * 16 + 15) { const int t = wr * 64 + m * 16 + fr, s0 = k0 + fq * 8; wv[m][0] = *(const f32x4*)(wg + t * 128 + s0); wv[m][1] = *(const f32x4*)(wg + t * 128 + s0 + 4); } }
                                    asm volatile("" ::: "memory");
                                    bf16x8 X[2];
#pragma unroll
                                    for (int nn = 0; nn < 2; ++nn) {
                                        const LAS bf16_t* vp = VN + (k0 + fq * 8 + tr_r) * 520 + gI * 128 + wc * 32 + nn * 16 + 4 * tr_c;
                                        const v4i16_t lo = __builtin_amdgcn_ds_read_tr16_b64_v4i16((LAS v4i16_t*)vp), hi = __builtin_amdgcn_ds_read_tr16_b64_v4i16((LAS v4i16_t*)(vp + 4 * 520));
                                        X[nn] = (bf16x8){lo[0], lo[1], lo[2], lo[3], hi[0], hi[1], hi[2], hi[3]};
                                    }
#pragma unroll
                                    for (int m = 0; m < 4; ++m) {
                                        if (k0 <= wr * 64 + m * 16 + 15) {
                                            const int t = wr * 64 + m * 16 + fr, s0 = k0 + fq * 8;
                                            const f32x4 w0 = wv[m][0], w1 = wv[m][1];
                                            float wf[8] = {w0[0], w0[1], w0[2], w0[3], w1[0], w1[1], w1[2], w1[3]};
#pragma unroll
                                            for (int i = 0; i < 8; ++i) wf[i] = (s0 + i <= t) ? wf[i] : 0.f;
                                            const u32x4 yp = pack8(wf); const bf16x8 Y = __builtin_bit_cast(bf16x8, yp);
                                            acc[m][0] = __builtin_amdgcn_mfma_f32_16x16x32_bf16(X[0], Y, acc[m][0], 0, 0, 0);
                                            acc[m][1] = __builtin_amdgcn_mfma_f32_16x16x32_bf16(X[1], Y, acc[m][1], 0, 0, 0);
                                        }
                                    }
                                }
                            }
                            u32x2 uva[4][2]; float bia[4];
#pragma unroll
                            for (int m = 0; m < 4; ++m) { const int t = wr * 64 + m * 16 + fr; bia[m] = bsg[t];
#pragma unroll
                                for (int nn = 0; nn < 2; ++nn) uva[m][nn] = *(const u32x2*)(pbuf + (row0 + t) * 3328 + gI * 128 + wc * 32 + nn * 16 + 4 * fq); }
                            asm volatile("" ::: "memory");
#pragma unroll
                            for (int m = 0; m < 4; ++m) {
                                const int t = wr * 64 + m * 16 + fr; const float bias = bia[m];
#pragma unroll
                                for (int nn = 0; nn < 2; ++nn) {
                                    const int c0 = wc * 32 + nn * 16 + 4 * fq;
                                    const u32x2 uv = uva[m][nn];
                                    const float o0 = bf_lo(uv.x) * (acc[m][nn][0] + bias), o1 = bf_hi(uv.x) * (acc[m][nn][1] + bias), o2 = bf_lo(uv.y) * (acc[m][nn][2] + bias), o3 = bf_hi(uv.y) * (acc[m][nn][3] + bias);
                                    u32x2 w; w.x = pk_bf16(o0, o1); w.y = pk_bf16(o2, o3);
                                    *(u32x2*)(mix + (row0 + t) * 1280 + gI * 128 + c0) = w;
                                }
                            }
                        }
                        asm volatile("s_waitcnt lgkmcnt(0)" ::: "memory"); __builtin_amdgcn_s_barrier(); asm volatile("" ::: "memory");
                    }
                }
#endif
#if !defined(NO_ATTN)
                {
                    LAS bf16_t* QL = (LAS bf16_t*)lds; LAS bf16_t* KL = (LAS bf16_t*)(lds + 18432); LAS bf16_t* VL = (LAS bf16_t*)(lds + 55296);
                    const int fr = lane & 15, fq = lane >> 4, tr_r = (lane & 15) >> 2, tr_c = lane & 3;
                    float gq16[16], gk16[16];
#pragma unroll
                    for (int i = 0; i < 16; ++i) { gq16[i] = ap->in[16][eo * 64 + (tid & 3) * 16 + i] * 0.125f; gk16[i] = ap->in[17][eo * 64 + (tid & 3) * 16 + i]; }
                    u32x4 rq[3][2], rv[4];
#pragma unroll
                    for (int i_ = 0; i_ < 3; ++i_) { rq[i_][0] = (u32x4){0u, 0u, 0u, 0u}; rq[i_][1] = (u32x4){0u, 0u, 0u, 0u}; }
#pragma unroll
                    for (int i_ = 0; i_ < 4; ++i_) rv[i_] = (u32x4){0u, 0u, 0u, 0u};
#define ATT_DECODE(it) const int rit_ = 6143 - (it); const int bj_ = rit_ / 96, q96_ = rit_ % 96, b = bj_ >> 2, j = bj_ & 3, cfg = q96_ >> 5, qq_ = q96_ & 31; \
                        const int sh = cfg * 2, r = (cfg == 0) ? 0 : (cfg == 1 ? (qq_ >> 3) : (qq_ >> 1)), n = (cfg == 0) ? qq_ : (cfg == 1 ? (qq_ & 7) : (qq_ & 1)); \
                        const int hd = cfg * 4 + j; const size_t rowb = (size_t)b * SEQ; (void)hd; (void)rowb; (void)n; (void)r; (void)sh;
#define ATT_LOAD(it) do { ATT_DECODE(it) \
                        _Pragma("unroll") for (int r3 = 0; r3 < 3; ++r3) { const int idx = tid + 512 * r3, rowi = idx >> 2, part = idx & 3; const bool isq = rowi < 128; \
                            const int sub = isq ? (n * 128 + rowi) : ((n - 1) * 128 + (rowi - 128)); const bool valid = sub >= 0; const int tok = valid ? ((sub << sh) + r) : 0; \
                            const bf16_t* src = pbuf + (rowb + tok) * 3328 + (isq ? 1024 : 1792) + hd * 64 + part * 16; \
                            rq[r3][0] = (u32x4){0u, 0u, 0u, 0u}; rq[r3][1] = rq[r3][0]; if (valid) { rq[r3][0] = *(const u32x4*)src; rq[r3][1] = *(const u32x4*)(src + 8); } } \
                        _Pragma("unroll") for (int r4 = 0; r4 < 4; ++r4) { const int idx = tid + 512 * r4, ks = idx >> 3, c8 = idx & 7; const int sub = (n - 1) * 128 + ks; \
                            rv[r4] = (u32x4){0u, 0u, 0u, 0u}; if (sub >= 0) rv[r4] = *(const u32x4*)(pbuf + (rowb + ((sub << sh) + r)) * 3328 + 2560 + hd * 64 + c8 * 8); } } while (0)
                    if (vcu < 6144) ATT_LOAD(vcu);
                    for (int item = vcu; item < 6144; item += G) {
                        ATT_DECODE(item)
#pragma unroll
                        for (int r3 = 0; r3 < 3; ++r3) {
                            const int idx = tid + 512 * r3, rowi = idx >> 2, part = idx & 3;
                            const bool isq = rowi < 128;
                            const int sub = isq ? (n * 128 + rowi) : ((n - 1) * 128 + (rowi - 128));
                            const int tok = (sub >= 0) ? ((sub << sh) + r) : 0;
                            float f[16]; unpack8(rq[r3][0], f); unpack8(rq[r3][1], f + 8);
                            float ss = 0.f;
#pragma unroll
                            for (int i = 0; i < 16; ++i) ss += f[i] * f[i];
                            ss += __shfl_xor(ss, 1); ss += __shfl_xor(ss, 2);
                            const float rs = rsqrtf(ss * (1.0f / 64.0f) + EPSF);
#pragma unroll
                            for (int i = 0; i < 16; ++i) f[i] = f[i] * rs * (r3 == 0 ? gq16[i] : gk16[i]);
                            if (part == 0) {
                                const float tf = (float)tok;
                                const float crev[8] = {0.15915494309189535f, 0.03086376340470123f, 0.005985185712713705f, 0.001160663641240061f, 0.00022507907903927653f, 4.364795279280289e-05f, 8.464330808241401e-06f, 1.6414262627950345e-06f};
#pragma unroll
                                for (int i = 0; i < 8; ++i) { const float rev = __builtin_amdgcn_fractf(tf * crev[i]); const float c = __builtin_amdgcn_cosf(rev), sn = __builtin_amdgcn_sinf(rev), x1 = f[i], x2 = f[8 + i]; f[i] = x1 * c - x2 * sn; f[8 + i] = x2 * c + x1 * sn; }
                            }
                            LAS bf16_t* dst = isq ? (QL + rowi * 72 + part * 16) : (KL + (rowi - 128) * 72 + part * 16);
                            *(LAS u32x4*)dst = pack8(f); *(LAS u32x4*)(dst + 8) = pack8(f + 8);
                        }
#pragma unroll
                        for (int r4 = 0; r4 < 4; ++r4) { const int idx = tid + 512 * r4, ks = idx >> 3, c8 = idx & 7; *(LAS u32x4*)(VL + ks * 72 + c8 * 8) = rv[r4]; }
                        if (item + G < 6144) ATT_LOAD(item + G);
                        asm volatile("s_waitcnt lgkmcnt(0)" ::: "memory"); __builtin_amdgcn_s_barrier(); asm volatile("" ::: "memory");
                        {
                            const int w = wave, qi = w * 16 + fr;
                            const bf16x8 Y0 = *(const LAS bf16x8*)(QL + qi * 72 + fq * 8), Y1 = *(const LAS bf16x8*)(QL + qi * 72 + 32 + fq * 8);
                            f32x4 sc[10];
                            {
                                bf16x8 KX0[9], KX1[9];
#pragma unroll
                                for (int jt = 0; jt < 9; ++jt) { const LAS bf16_t* kp = KL + ((w + jt) * 16 + fr) * 72 + fq * 8; KX0[jt] = *(const LAS bf16x8*)kp; KX1[jt] = *(const LAS bf16x8*)(kp + 32); }
                                __builtin_amdgcn_sched_barrier(0);
#pragma unroll
                                for (int jt = 0; jt < 9; ++jt) {
                                    f32x4 a = (f32x4){0.f, 0.f, 0.f, 0.f};
                                    a = __builtin_amdgcn_mfma_f32_16x16x32_bf16(KX0[jt], Y0, a, 0, 0, 0);
                                    a = __builtin_amdgcn_mfma_f32_16x16x32_bf16(KX1[jt], Y1, a, 0, 0, 0);
                                    sc[jt] = a;
                                }
                            }
                            float mx = -INFINITY;
#pragma unroll
                            for (int jt = 0; jt < 9; ++jt)
#pragma unroll
                                for (int i = 0; i < 4; ++i) {
                                    const int c = 4 * fq + i;
                                    bool ok = (n > 0) || (w + jt >= 8);
                                    if (jt == 0) ok = ok && (fr <= c);
                                    if (jt == 8) ok = ok && (fr >= c);
                                    const float v = ok ? sc[jt][i] : -INFINITY; sc[jt][i] = v; mx = fmaxf(mx, v);
                                }
                            mx = fmaxf(mx, __shfl_xor(mx, 16)); mx = fmaxf(mx, __shfl_xor(mx, 32));
                            float den = 0.f;
#pragma unroll
                            for (int jt = 0; jt < 9; ++jt)
#pragma unroll
                                for (int i = 0; i < 4; ++i) { const float e = __expf(sc[jt][i] - mx); sc[jt][i] = e; den += e; }
                            sc[9] = (f32x4){0.f, 0.f, 0.f, 0.f};
                            den += __shfl_xor(den, 16); den += __shfl_xor(den, 32);
                            f32x4 oa[4];
#pragma unroll
                            for (int et = 0; et < 4; ++et) oa[et] = (f32x4){0.f, 0.f, 0.f, 0.f};
                            v4i16_t VLO[5][4], VHI[5][4];
#pragma unroll
                            for (int jj = 0; jj < 5; ++jj) {
                                const int t0r = (w + 2 * jj) * 16, t1r = (jj < 4) ? (w + 2 * jj + 1) * 16 : t0r;
#pragma unroll
                                for (int et = 0; et < 4; ++et) {
                                    VLO[jj][et] = __builtin_amdgcn_ds_read_tr16_b64_v4i16((LAS v4i16_t*)(VL + (t0r + 4 * fq + tr_r) * 72 + et * 16 + 4 * tr_c));
                                    VHI[jj][et] = __builtin_amdgcn_ds_read_tr16_b64_v4i16((LAS v4i16_t*)(VL + (t1r + 4 * fq + tr_r) * 72 + et * 16 + 4 * tr_c));
                                }
                            }
                            __builtin_amdgcn_sched_barrier(0);
#pragma unroll
                            for (int jj = 0; jj < 5; ++jj) {
                                u32x4 pp; pp.x = pk_bf16(sc[2 * jj][0], sc[2 * jj][1]); pp.y = pk_bf16(sc[2 * jj][2], sc[2 * jj][3]); pp.z = pk_bf16(sc[2 * jj + 1][0], sc[2 * jj + 1][1]); pp.w = pk_bf16(sc[2 * jj + 1][2], sc[2 * jj + 1][3]);
                                const bf16x8 Pf = __builtin_bit_cast(bf16x8, pp);
#pragma unroll
                                for (int et = 0; et < 4; ++et) {
                                    const v4i16_t lo = VLO[jj][et], hi = VHI[jj][et];
                                    const bf16x8 xv = (bf16x8){lo[0], lo[1], lo[2], lo[3], hi[0], hi[1], hi[2], hi[3]};
                                    oa[et] = __builtin_amdgcn_mfma_f32_16x16x32_bf16(xv, Pf, oa[et], 0, 0, 0);
                                }
                            }
                            const float inv = 1.0f / den;
                            const int tokq = ((n * 128 + qi) << sh) + r;
                            bf16_t* op = mix + (rowb + tokq) * 1280 + 512 + hd * 64 + 4 * fq;
#pragma unroll
                            for (int et = 0; et < 4; ++et) { u32x2 wv; wv.x = pk_bf16(oa[et][0] * inv, oa[et][1] * inv); wv.y = pk_bf16(oa[et][2] * inv, oa[et][3] * inv); *(u32x2*)(op + et * 16) = wv; }
                            if (fq == 0) lse[(rowb + tokq) * 12 + hd] = mx + __logf(den);
                        }
                        asm volatile("s_waitcnt lgkmcnt(0)" ::: "memory"); __builtin_amdgcn_s_barrier(); asm volatile("" ::: "memory");
                    }
#undef ATT_LOAD
#undef ATT_DECODE
                }
#endif
            } else if (s == 2 && odd) {
                const int gw = vcu * 8 + wave, NGW = G * 8;
                for (int m0 = gw * 2; m0 < NTOK; m0 += NGW * 2) {
                    u32x4 v[2][2]; float al[2][2];
#pragma unroll
                    for (int q = 0; q < 2; ++q)
#pragma unroll
                        for (int c2 = 0; c2 < 2; ++c2) {
                            const int ch = lane + 64 * c2; v[q][c2] = (u32x4){0u, 0u, 0u, 0u}; al[q][c2] = 0.f;
                            if (ch < 96) {
                                const size_t m = (size_t)(m0 + q);
                                const int hd = ch >> 3, cfg = hd >> 2, j = hd & 3;
                                const float l0 = lse[m * 12 + j], l1 = lse[m * 12 + 4 + j], l2 = lse[m * 12 + 8 + j];
                                v[q][c2] = *(const u32x4*)(mix + m * 1280 + 512 + ch * 8);
                                const float mxl = fmaxf(l0, fmaxf(l1, l2));
                                const float e0 = __expf(l0 - mxl), e1 = __expf(l1 - mxl), e2 = __expf(l2 - mxl);
                                al[q][c2] = ((cfg == 0) ? e0 : (cfg == 1 ? e1 : e2)) / (e0 + e1 + e2);
                            }
                        }
#pragma unroll
                    for (int q = 0; q < 2; ++q)
#pragma unroll
                        for (int c2 = 0; c2 < 2; ++c2) {
                            const int ch = lane + 64 * c2;
                            if (ch < 96) { float f[8]; unpack8(v[q][c2], f);
#pragma unroll
                                for (int i = 0; i < 8; ++i) f[i] *= al[q][c2];
                                *(u32x4*)(mix + (size_t)(m0 + q) * 1280 + 512 + ch * 8) = pack8(f); }
                        }
                }
            } else if (s == 3) {
                const bf16_t* wt = odd ? (const bf16_t*)(ws + WS_ODWOUT) + (size_t)eo * 1024 * 1280 : (const bf16_t*)(ws + WS_EVWOUT) + (size_t)eo * 1024 * 1024;
                pg8::Gemm g{mix, wt, MW, MW, MW, 256, 4, 1, 1, 0, 0, 0, 0, 0};
                pg8::EpiR E{nullptr, xb, sx_xat, 0};
                pg8::gemm_phase<pg8::EpiR>(lds, tid, g, G, bx, E);
            } else if (s == 4) {
                pg8::Gemm g{xb, (const bf16_t*)(ws + WS_WQ) + (size_t)l * 1024 * 1024, 1024, 1024, 1024, 256, 4, 1, 1, 0, 0, 0, 0, 0};
                pg8::EpiP E{(bf16_t*)(ws + WS_QX), 1024, NTOK, sx_xat, 1.0f / (1024.0f * SC_SS), 0, qst, 4, 1, 0};
                pg8::gemm_phase<pg8::EpiP>(lds, tid, g, G, bx, E);
            } else if (s == 5) {
                pg8::Gemm g{(const bf16_t*)(ws + WS_QX), (const bf16_t*)(ws + WS_KT) + (size_t)l * 4096 * 1024, 1024, 1024, 256, 16, 1, 64, 4, SEQ * 1024, 256, 256 * 1024, 256, 0};
                pg8::EpiS E{(bf16_t*)(ws + WS_PB), qst, (LAS float*)(lds + 131072)};
                pg8::gemm_phase<pg8::EpiS>(lds, tid, g, G, bx, E);
            } else if (s == 7) {
                pg8::Gemm g{(const bf16_t*)(ws + WS_PB), (const bf16_t*)(ws + WS_VP), 1024, 1024, 1024, 16, 4, 16, 1, SEQ * 1024, 0, 1024 * 1024, 0, 0};
                pg8::EpiR E{nullptr, xb, sx_mlp, SEQ};
                pg8::gemm_phase<pg8::EpiR>(lds, tid, g, G, bx, E);
            } else if (s == 8) {
                pg8::Gemm g{xb, (const bf16_t*)(ws + WS_W1) + (size_t)l * 4096 * 1024, 1024, 1024, 1024, 256, 16, 1, 1, 0, 0, 0, 0, 0};
                pg8::EpiP E{(bf16_t*)(ws + WS_HMID), 4096, NTOK, sx_mlp, 1.0f / (1024.0f * SC_SS), 2, nullptr, 0, 1, 0};
                pg8::gemm_phase<pg8::EpiP>(lds, tid, g, G, bx, E);
            } else {
                pg8::Gemm g{(const bf16_t*)(ws + WS_HMID), (const bf16_t*)(ws + WS_W2) + (size_t)l * 1024 * 4096, 4096, 4096, 4096, 256, 4, 1, 1, 0, 0, 0, 0, 1};
                pg8::EpiR E{(l == 3) ? ap->out : nullptr, xb, (l == 3) ? (u64*)(ws + ST_QST) : sx_next, 0};
                pg8::gemm_phase<pg8::EpiR>(lds, tid, g, G, bx, E);
            }
        }
        }
        if (ph + 1 < args.hi) { if (ph == 0) cg::this_grid().sync(); else xcd_barrier((unsigned*)(ws + ST_BAR), xcc, xst); }
    }
}

constexpr int N_PHASES = 43;
extern "C" void kernel_launch(void* const* d_in, const int* in_sizes, int n_in, void* d_out, int out_size, void* d_ws, size_t ws_size, hipStream_t stream) {
    static int grid = 0;
    if (grid == 0) {
        if (n_in != 29 || ws_size < WS_END) { fprintf(stderr, "kernel_launch: need 29 inputs and %zu bytes of workspace; got %d, %zu\n", (size_t)WS_END, n_in, ws_size); grid = -1; return; }
        int dev = 0, cus = 0, per_cu = 0;
        hipGetDevice(&dev); hipDeviceGetAttribute(&cus, hipDeviceAttributeMultiprocessorCount, dev);
        if (hipFuncSetAttribute((const void*)mk_fwd, hipFuncAttributeMaxDynamicSharedMemorySize, LDS_BYTES) != hipSuccess) { fprintf(stderr, "kernel_launch: hipFuncSetAttribute failed\n"); grid = -1; return; }
        if (hipOccupancyMaxActiveBlocksPerMultiprocessor(&per_cu, (const void*)mk_fwd, 512, LDS_BYTES) != hipSuccess || per_cu < 1) per_cu = 1;
        (void)hipGetLastError();
        grid = cus * per_cu;
        fprintf(stderr, "kernel_launch: grid %d (cus %d x %d)\n", grid, cus, per_cu);
    }
    if (grid < 0) return;
    Args a{};
    for (int i = 0; i < 29; ++i) a.in[i] = (const float*)d_in[i];
    a.out = (float*)d_out; a.ws = (unsigned char*)d_ws;
#if MK_MULTI
    for (int ph = 0; ph < N_PHASES; ++ph) { a.lo = ph; a.hi = ph + 1; hipLaunchKernelGGL(mk_fwd, dim3(grid), dim3(512), LDS_BYTES, stream, a); }
#else
    a.lo = 0; a.hi = N_PHASES;
    if (hipMemsetAsync((char*)d_ws + ST_BAR, 0, 16384, stream) != hipSuccess) { fprintf(stderr, "kernel_launch: memset failed\n"); return; }
    void* kargs[] = {&a};
    hipError_t e = hipLaunchCooperativeKernel((const void*)mk_fwd, dim3(grid), dim3(512), kargs, LDS_BYTES, stream);
    if (e != hipSuccess) fprintf(stderr, "cooperative launch failed: %s (grid %d)\n", hipGetErrorString(e), grid);
#endif
}
```
